# Optimizing an MI355X kernel written in HIP

```python
import math
import jax, jax.numpy as jnp
from jax import lax
import numpy as np

D_MODEL = 4096
BATCH = 4
SEQ = 2048
DEPTH = 2
DEC_BATCH = 16
DEC_SEQ = 32
PAST_LEN = 1024

CHUNK = 64
D_INNER = 2 * D_MODEL
W_POOL = D_INNER // 4
POOL_WINDOWS = (2, 4, 8, 16)
N_POOL_GROUPS = len(POOL_WINDOWS)
POOL_GW = W_POOL // N_POOL_GROUPS
POOL_HIST = max(POOL_WINDOWS) - 1
W_SSD = D_INNER - W_POOL
SSD_HEAD_DIM = 64
SSD_HEADS = W_SSD // SSD_HEAD_DIM
SSD_GROUPS = 8
SSD_HPG = SSD_HEADS // SSD_GROUPS
SSD_STATE = 128
CONV_W = 4
CONV_DIM = W_SSD + 2 * SSD_GROUPS * SSD_STATE
IN_DIM = 2 * W_POOL + W_SSD + CONV_DIM + SSD_HEADS
ALPHA = (2 * DEPTH) ** 0.25
BETA = (8 * DEPTH) ** -0.25
LN_EPS = 1e-5
RMS_EPS = 1e-5

kernel_name = "pool_ssd_hymba_stream_step"


def layer_norm(x):
    x32 = x.astype(jnp.float32)
    mu = jnp.mean(x32, axis=-1, keepdims=True)
    var = jnp.mean(jnp.square(x32 - mu), axis=-1, keepdims=True)
    return (x32 - mu) * lax.rsqrt(var + LN_EPS)


def pool_mixer(u, prev, start_pos, w_pool, pool_scale):
    b, L, _ = u.shape
    full = jnp.concatenate([prev.astype(u.dtype), u], axis=1)
    new_prev = full[:, -POOL_HIST:]
    f32 = full.astype(jnp.float32).reshape(b, POOL_HIST + L, N_POOL_GROUPS, POOL_GW)
    cs = jnp.concatenate([jnp.zeros_like(f32[:, :1]), jnp.cumsum(f32, axis=1)], axis=1)
    end = cs[:, POOL_HIST + 1:]
    pos = start_pos + jnp.arange(L)
    means = []
    for g, w in enumerate(POOL_WINDOWS):
        s = end[:, :, g] - cs[:, POOL_HIST + 1 - w: POOL_HIST + 1 - w + L, g]
        cnt = jnp.minimum(pos + 1, w).astype(jnp.float32)
        means.append(s / cnt[None, :, None])
    mean = jnp.stack(means, axis=2)
    pooled = mean - f32[:, POOL_HIST:]
    out = jnp.einsum('blgc,gcd->blgd', pooled, w_pool.astype(jnp.float32)).reshape(b, L, W_POOL)
    return out * pool_scale.astype(jnp.float32), new_prev


def causal_conv(u, prev, w, bias):
    L = u.shape[1]
    full = jnp.concatenate([prev.astype(u.dtype), u], axis=1)
    new_prev = full[:, -(CONV_W - 1):]
    f32 = full.astype(jnp.float32)
    w32 = w.astype(jnp.float32)
    out = sum(f32[:, k:k + L] * w32[k] for k in range(CONV_W)) + bias.astype(jnp.float32)
    return jax.nn.silu(out), new_prev


def ssd_scan(xh, dt, A, Bm, Cm, h0):
    b, L = xh.shape[:2]
    nc = -(-L // CHUNK)
    pad = nc * CHUNK - L
    padt = lambda t: jnp.pad(t, [(0, 0), (0, pad)] + [(0, 0)] * (t.ndim - 2))
    a = padt(dt * A)
    xdt = padt(xh * dt[..., None])
    Bp, Cp = padt(Bm), padt(Cm)
    chunk = lambda t: t.reshape((b, nc, CHUNK) + t.shape[2:])
    a, xdt, Bc, Cc = chunk(a), chunk(xdt), chunk(Bp), chunk(Cp)
    a_cs = jnp.cumsum(a, axis=2)
    seg = a_cs[:, :, :, None] - a_cs[:, :, None, :]
    tril = jnp.tril(jnp.ones((CHUNK, CHUNK), dtype=bool))[None, None, :, :, None, None]
    Lmat = jnp.exp(jnp.where(tril, seg, -jnp.inf))
    CB = jnp.einsum('bclgn,bcsgn->bclsg', Cc, Bc)
    y_diag = jnp.einsum('bclsg,bclsgk,bcsgkp->bclgkp', CB, Lmat, xdt)
    decay = jnp.exp(a_cs[:, :, -1:] - a_cs)
    states = jnp.einsum('bcsgn,bcsgk,bcsgkp->bcgkpn', Bc, decay, xdt)
    chunk_decay = jnp.exp(a_cs[:, :, -1])

    def step(h, inp):
        dec, st = inp
        return dec[..., None, None] * h + st, h

    h_final, h_prev = lax.scan(step, h0.astype(jnp.float32),
                               (jnp.moveaxis(chunk_decay, 1, 0), jnp.moveaxis(states, 1, 0)))
    h_prev = jnp.moveaxis(h_prev, 0, 1)
    y_off = jnp.einsum('bclgn,bcgkpn,bclgk->bclgkp', Cc, h_prev, jnp.exp(a_cs))
    y = (y_diag + y_off).reshape((b, nc * CHUNK) + xh.shape[2:])[:, :L]
    return y, h_final


def trunk_layer(x, c, pool_prev, conv_prev, ssm_prev, start_pos,
                w_ada, b_ada, w_in, w_pool, pool_scale, conv_w, conv_b,
                dt_bias, a_log, d_skip, ssd_norm_w, w_out, ln_g, ln_b):
    b, L, _ = x.shape
    mod = (jnp.einsum('bd,de->be', jax.nn.silu(c), w_ada) + b_ada).astype(jnp.float32)
    shift, scale, gate = jnp.split(mod, 3, axis=-1)
    h = (layer_norm(x) * (1.0 + scale[:, None]) + shift[:, None]).astype(x.dtype)
    proj = jnp.einsum('bld,de->ble', h, w_in)
    u_pool, g_pool, z, xbc, dt_raw = jnp.split(
        proj, [W_POOL, 2 * W_POOL, 2 * W_POOL + W_SSD, 2 * W_POOL + W_SSD + CONV_DIM], axis=-1)
    pool_out, new_pool = pool_mixer(u_pool, pool_prev, start_pos, w_pool, pool_scale)
    pool_out = pool_out * jax.nn.silu(g_pool.astype(jnp.float32))
    xbc_c, new_conv = causal_conv(xbc, conv_prev, conv_w, conv_b)
    xs, Bm, Cm = jnp.split(xbc_c, [W_SSD, W_SSD + SSD_GROUPS * SSD_STATE], axis=-1)
    dt = jax.nn.softplus(dt_raw.astype(jnp.float32) + dt_bias.astype(jnp.float32))
    A = -jnp.exp(a_log.astype(jnp.float32))
    xh = xs.reshape(b, L, SSD_GROUPS, SSD_HPG, SSD_HEAD_DIM)
    y, new_ssm = ssd_scan(xh, dt.reshape(b, L, SSD_GROUPS, SSD_HPG), A.reshape(SSD_GROUPS, SSD_HPG),
                          Bm.reshape(b, L, SSD_GROUPS, SSD_STATE), Cm.reshape(b, L, SSD_GROUPS, SSD_STATE),
                          ssm_prev.reshape(b, SSD_GROUPS, SSD_HPG, SSD_HEAD_DIM, SSD_STATE))
    y = y + d_skip.astype(jnp.float32).reshape(SSD_GROUPS, SSD_HPG)[:, :, None] * xh
    y = y.reshape(b, L, W_SSD) * jax.nn.silu(z.astype(jnp.float32))
    yg = y.reshape(b, L, SSD_GROUPS, W_SSD // SSD_GROUPS)
    yg = yg * lax.rsqrt(jnp.mean(jnp.square(yg), axis=-1, keepdims=True) + RMS_EPS)
    ssd_out = yg.reshape(b, L, W_SSD) * ssd_norm_w.astype(jnp.float32)
    mixed = jnp.concatenate([pool_out, ssd_out], axis=-1).astype(x.dtype)
    o = jnp.einsum('ble,ed->bld', mixed, w_out).astype(jnp.float32)
    r = ALPHA * x.astype(jnp.float32) + gate[:, None] * o
    x_new = (layer_norm(r) * ln_g.astype(jnp.float32) + ln_b.astype(jnp.float32)).astype(x.dtype)
    return x_new, new_pool, new_conv, new_ssm.reshape(b, SSD_HEADS, SSD_HEAD_DIM, SSD_STATE)


def setup_inputs(seed: int = 0) -> dict:
    key = jax.random.key(seed)
    ks = jax.random.split(key, 24)
    f32 = jnp.float32
    nrm = lambda k, s, sc: jax.random.normal(k, s, f32) * sc
    dt0 = jnp.exp(jax.random.uniform(ks[15], (DEPTH, SSD_HEADS), f32) * (math.log(0.1) - math.log(0.001))
                  + math.log(0.001))
    return {
        "x_prompt": nrm(ks[0], (BATCH, SEQ, D_MODEL), 1.0),
        "x_sample": nrm(ks[1], (DEC_BATCH, DEC_SEQ, D_MODEL), 1.0),
        "state_pool": nrm(ks[2], (DEPTH, DEC_BATCH, POOL_HIST, W_POOL), 1.0),
        "state_conv": nrm(ks[3], (DEPTH, DEC_BATCH, CONV_W - 1, CONV_DIM), 1.0),
        "state_ssm": nrm(ks[4], (DEPTH, DEC_BATCH, SSD_HEADS, SSD_HEAD_DIM, SSD_STATE), 0.1),
        "c_prompt": nrm(ks[5], (BATCH, D_MODEL), 1.0),
        "c_sample": nrm(ks[6], (DEC_BATCH, D_MODEL), 1.0),
        "w_ada": nrm(ks[7], (DEPTH, D_MODEL, 3 * D_MODEL), 0.5 * D_MODEL ** -0.5),
        "b_ada": nrm(ks[8], (DEPTH, 3 * D_MODEL), 0.01),
        "w_in": nrm(ks[9], (DEPTH, D_MODEL, IN_DIM), D_MODEL ** -0.5),
        "w_pool": nrm(ks[10], (DEPTH, N_POOL_GROUPS, POOL_GW, POOL_GW), POOL_GW ** -0.5),
        "pool_scale": 1.0 + nrm(ks[11], (DEPTH, W_POOL), 0.02),
        "conv_w": nrm(ks[12], (DEPTH, CONV_W, CONV_DIM), 0.4),
        "conv_b": nrm(ks[13], (DEPTH, CONV_DIM), 0.01),
        "dt_bias": dt0 + jnp.log(-jnp.expm1(-dt0)),
        "a_log": jnp.log(jax.random.uniform(ks[16], (DEPTH, SSD_HEADS), f32, 1.0, 16.0)),
        "d_skip": 1.0 + nrm(ks[17], (DEPTH, SSD_HEADS), 0.1),
        "ssd_norm_w": 1.0 + nrm(ks[18], (DEPTH, W_SSD), 0.02),
        "w_out": nrm(ks[19], (DEPTH, D_INNER, D_MODEL), BETA * D_INNER ** -0.5),
        "ln_g": 1.0 + nrm(ks[20], (DEPTH, D_MODEL), 0.02),
        "ln_b": nrm(ks[21], (DEPTH, D_MODEL), 0.01),
    }


def reference(x_prompt, x_sample, state_pool, state_conv, state_ssm, c_prompt, c_sample,
              w_ada, b_ada, w_in, w_pool, pool_scale, conv_w, conv_b,
              dt_bias, a_log, d_skip, ssd_norm_w, w_out, ln_g, ln_b):
    nb = x_prompt.shape[0]
    yp, ys = x_prompt, x_sample
    pp, pc, psm, sp, sc, ssm = [], [], [], [], [], []
    for l in range(DEPTH):
        params = (w_ada[l], b_ada[l], w_in[l], w_pool[l], pool_scale[l], conv_w[l], conv_b[l],
                  dt_bias[l], a_log[l], d_skip[l], ssd_norm_w[l], w_out[l], ln_g[l], ln_b[l])
        yp, a1, a2, a3 = trunk_layer(
            yp, c_prompt,
            jnp.zeros((nb, POOL_HIST, W_POOL), x_prompt.dtype),
            jnp.zeros((nb, CONV_W - 1, CONV_DIM), x_prompt.dtype),
            jnp.zeros((nb, SSD_HEADS, SSD_HEAD_DIM, SSD_STATE), jnp.float32),
            0, *params)
        ys, b1, b2, b3 = trunk_layer(ys, c_sample, state_pool[l], state_conv[l], state_ssm[l],
                                     PAST_LEN, *params)
        pp.append(a1); pc.append(a2); psm.append(a3)
        sp.append(b1); sc.append(b2); ssm.append(b3)
    return (yp, ys, jnp.stack(pp), jnp.stack(pc), jnp.stack(psm),
            jnp.stack(sp), jnp.stack(sc), jnp.stack(ssm))
```

```cpp
#include <hip/hip_runtime.h>
#include <cstdio>
#include <cstdint>
namespace pg8 {
#define PG8_LAS __attribute__((address_space(3)))
typedef unsigned short bf16_t;
typedef short bf16x8 __attribute__((ext_vector_type(8)));
typedef float f32x4 __attribute__((ext_vector_type(4)));
typedef unsigned u32x4 __attribute__((ext_vector_type(4)));
constexpr int BM = 256, BK = 64, HALF = 128, HTB = HALF * BK * 2  , STAGE_BYTES = 8 * HTB, NXCD = 8, WGM = 8;

__host__ __device__ __forceinline__ int lds_byte(int r, int c) { const int st = (r >> 4) * 2 + (c >> 5), rr = r & 15, cc = c & 31, ob = rr * 64 + cc * 2; return st * 1024 + (ob ^ (((ob >> 9) & 1) << 5)); }
__host__ __device__ __forceinline__ void stage_rc(int b, int& R, int& C) { const int st = b / 1024, sb = b % 1024, swz = sb ^ (((sb >> 9) & 1) << 5); R = (st >> 1) * 16 + swz / 64; C = (st & 1) * 32 + (swz % 64) / 2; }
__host__ __device__ __forceinline__ int perm32(int rho) { const int n = rho >> 4, i = rho & 15; return 8 * (i >> 2) + 4 * n + (i & 3); }

struct Unit { int pm, pn, g; };
struct Gemm { const bf16_t* A; const bf16_t* Bt; int M, N, K, lda, ldb; size_t a_goff, b_goff; };

struct StaticOrder {
    int nM, nN, nwg, G, c;
    __host__ __device__ void init(int M, int N, int G_, int c_) { nM = M / BM; nN = N / BM; nwg = nM * nN; G = G_; c = c_; }
    __host__ __device__ bool next(int i, Unit& u) const {
        const long L = (long)i * G + c; if (L >= nwg) return false;
        int wgid = (int)L; { const int q = nwg / NXCD, r = nwg % NXCD, xcd = wgid % NXCD, off = wgid / NXCD; wgid = (xcd < r ? xcd * (q + 1) : r * (q + 1) + (xcd - r) * q) + off; }
        const int nig = WGM * nN, gid = wgid / nig, fm = gid * WGM, gsz = (nM - fm) < WGM ? (nM - fm) : WGM;
        u.pm = fm + ((wgid % nig) % gsz); u.pn = (wgid % nig) / gsz; u.g = 0; return true;
    }
    __device__ __forceinline__ void a_ready(const Unit&) const {}
    __device__ __forceinline__ void done(const Unit&) const {}
};
struct GroupOrder {
    int nM, nN, ng, G, c;
    __host__ __device__ void init(int M, int N, int ng_, int G_, int c_) { nM = M / BM; nN = N / BM; ng = ng_; G = G_; c = c_; }
    __host__ __device__ bool next(int i, Unit& u) const {
        const long L = (long)i * G + c; if (L >= (long)nM * nN * ng) return false;
        const int per = nM * nN, l = (int)L; u.g = l / per; const int r = l % per; u.pm = r % nM; u.pn = r / nM; return true;
    }
    __device__ __forceinline__ void a_ready(const Unit&) const {}
    __device__ __forceinline__ void done(const Unit&) const {}
};

__device__ __forceinline__ unsigned cvt_pk_bf16(float lo, float hi) { unsigned r; asm volatile("v_cvt_pk_bf16_f32 %0, %1, %2" : "=v"(r) : "v"(lo), "v"(hi)); return r; }
__device__ __forceinline__ float silu_f(float x) { return x * __builtin_amdgcn_rcpf(1.0f + __expf(-x)); }

struct EpiF32 {
    static constexpr bool PERM = false, AFTER_DRAIN = false;
    float* C; int ldc;
    __device__ __forceinline__ void operator()(const f32x4 (&acc)[2][2][4][2], const Unit& u, int wr, int wc, int fr, int fq) const {
        const int row0 = u.pm * BM + wr * 64 + fr, col0 = u.pn * BM + wc * 32 + 4 * fq;
#pragma unroll
        for (int ai = 0; ai < 2; ++ai)
#pragma unroll
            for (int m = 0; m < 4; ++m) { float* rowp = C + (size_t)(row0 + ai * HALF + m * 16) * ldc + col0;
#pragma unroll
                for (int bj = 0; bj < 2; ++bj)
#pragma unroll
                    for (int n = 0; n < 2; ++n) *(f32x4*)(rowp + bj * HALF + n * 16) = acc[ai][bj][m][n]; }
    }
};
struct EpiPool {
    static constexpr bool PERM = true, AFTER_DRAIN = false;
    bf16_t* O; int ldo; const float* gp; int ldp; const float* pscale;
    __device__ __forceinline__ void operator()(const f32x4 (&acc)[2][2][4][2], const Unit& u, int wr, int wc, int fr, int fq) const {
        const int row0 = u.pm * BM + wr * 64 + fr, col0 = u.g * 512 + u.pn * BM + wc * 32 + 8 * fq;
        f32x4 ps[2][2];
#pragma unroll
        for (int bj = 0; bj < 2; ++bj)
#pragma unroll
            for (int n = 0; n < 2; ++n) ps[bj][n] = *(const f32x4*)(pscale + col0 + bj * HALF + 4 * n);
#pragma unroll
        for (int ai = 0; ai < 2; ++ai)
#pragma unroll
            for (int m = 0; m < 4; ++m) { const size_t row = (size_t)(row0 + ai * HALF + m * 16);
#pragma unroll
                for (int bj = 0; bj < 2; ++bj) { const int c = col0 + bj * HALF;
                    const f32x4 g0 = *(const f32x4*)(gp + row * ldp + c), g1 = *(const f32x4*)(gp + row * ldp + c + 4);
                    f32x4 v0 = acc[ai][bj][m][0] * ps[bj][0], v1 = acc[ai][bj][m][1] * ps[bj][1];
#pragma unroll
                    for (int j = 0; j < 4; ++j) { v0[j] *= silu_f(g0[j]); v1[j] *= silu_f(g1[j]); }
                    u32x4 w; w.x = cvt_pk_bf16(v0[0], v0[1]); w.y = cvt_pk_bf16(v0[2], v0[3]); w.z = cvt_pk_bf16(v1[0], v1[1]); w.w = cvt_pk_bf16(v1[2], v1[3]);
                    *(u32x4*)(O + row * ldo + c) = w; } }
    }
};
struct EpiResid {
    static constexpr bool PERM = false, AFTER_DRAIN = false;
    float* R; int ldr; const float* xp; const float* xs; const float* gate; int ldg; float alpha;
    __device__ __forceinline__ void operator()(const f32x4 (&acc)[2][2][4][2], const Unit& u, int wr, int wc, int fr, int fq) const {
        const int row0 = u.pm * BM + wr * 64 + fr, col0 = u.pn * BM + wc * 32 + 4 * fq;
#pragma unroll
        for (int ai = 0; ai < 2; ++ai)
#pragma unroll
            for (int m = 0; m < 4; ++m) { const int row = row0 + ai * HALF + m * 16;
                const int b = row < 8192 ? (row >> 11) : 4 + ((row - 8192) >> 5);
                const float* xr = row < 8192 ? xp + (size_t)row * 4096 : xs + (size_t)(row - 8192) * 4096;
                const float* gr = gate + (size_t)b * ldg; float* rr = R + (size_t)row * ldr;
#pragma unroll
                for (int bj = 0; bj < 2; ++bj)
#pragma unroll
                    for (int n = 0; n < 2; ++n) { const int c = col0 + bj * HALF + n * 16;
                        const f32x4 xv = *(const f32x4*)(xr + c), gv = *(const f32x4*)(gr + c);
                        *(f32x4*)(rr + c) = xv * alpha + gv * acc[ai][bj][m][n]; } }
    }
};

template <class Epi, class Sched, bool ALIGN_EPI = false, bool SP2 = false>
__device__ __forceinline__ void gemm_phase(PG8_LAS unsigned char* lds, const Gemm g, const Sched& S, const Epi& E, const int tid) {
    const int wid = __builtin_amdgcn_readfirstlane(tid >> 6), lane = tid & 63, wr = wid >> 2, wc = wid & 3, fr = lane & 15, fq = lane >> 4;
    const int K = g.K, nt = K / BK;
    unsigned voffA[2], voffB[2];
#pragma unroll
    for (int i = 0; i < 2; ++i) { int R, C; stage_rc(tid * 16 + i * 8192, R, C); const int Rb = Epi::PERM ? ((R & ~31) + perm32(R & 31)) : R;
        voffA[i] = (unsigned)(R * g.lda + C) * 2u; voffB[i] = (unsigned)(Rb * g.ldb + C) * 2u; }
    const size_t kstep = (size_t)(BK * 2);
    const size_t hstepA = (size_t)HALF * g.lda * 2, hstepB = (size_t)HALF * g.ldb * 2;
    const size_t tstepA = 2 * hstepA, tstepB = 2 * hstepB;
    const unsigned ldsw = (unsigned)wid * 1024u;
    const int aoff = lds_byte(wr * 64 + fr, fq * 8), boff = lds_byte(wc * 32 + fr, fq * 8);
#define PG8_SA(b, h) (((b) * 2 + (h)) * HTB)
#define PG8_SB(b, h) ((4 + (b) * 2 + (h)) * HTB)
#define PG8_STAGE(bufoff, gbase, voff) do { _Pragma("unroll") for (int _i = 0; _i < 2; ++_i) \
        __builtin_amdgcn_global_load_lds((const unsigned*)((const char*)(gbase) + (voff)[_i]), (PG8_LAS unsigned*)(lds + (bufoff) + ldsw + _i * 8192), 16, 0, 0); } while (0)
#define PG8_LDA(dst, b, h) do { _Pragma("unroll") for (int m = 0; m < 4; ++m) _Pragma("unroll") for (int k = 0; k < 2; ++k) dst[m][k] = *(const PG8_LAS bf16x8*)(lds + PG8_SA(b, h) + aoff + m * 2048 + k * 1024); } while (0)
#define PG8_LDB(dst, b, h) do { _Pragma("unroll") for (int n = 0; n < 2; ++n) _Pragma("unroll") for (int k = 0; k < 2; ++k) dst[n][k] = *(const PG8_LAS bf16x8*)(lds + PG8_SB(b, h) + boff + n * 2048 + k * 1024); } while (0)
#define PG8_MMA(ai, bj, At, Bt) do { __builtin_amdgcn_s_setprio(1); _Pragma("unroll") for (int m = 0; m < 4; ++m) _Pragma("unroll") for (int n = 0; n < 2; ++n) _Pragma("unroll") for (int k = 0; k < 2; ++k) \
        acc[ai][bj][m][n] = __builtin_amdgcn_mfma_f32_16x16x32_bf16(Bt[n][k], At[m][k], acc[ai][bj][m][n], 0, 0, 0); __builtin_amdgcn_s_setprio(0); } while (0)
#define PG8_WAIT_V(n) asm volatile("s_waitcnt vmcnt(" #n ")" ::: "memory")
#define PG8_WAIT_L(n) asm volatile("s_waitcnt lgkmcnt(" #n ")" ::: "memory")
#define PG8_BAR __builtin_amdgcn_s_barrier()
#define PG8_SCHED __builtin_amdgcn_sched_barrier(0)
    Unit cur, nxt; int ui = 0;
    if (!S.next(0, cur)) return;
    f32x4 acc[2][2][4][2];
#pragma unroll
    for (int a = 0; a < 2; ++a)
#pragma unroll
        for (int b = 0; b < 2; ++b)
#pragma unroll
            for (int m = 0; m < 4; ++m)
#pragma unroll
                for (int n = 0; n < 2; ++n) acc[a][b][m][n] = (f32x4){0.f, 0.f, 0.f, 0.f};
    bf16x8 At[4][2], B0[2][2], B1[2][2];
    const char* cA = (const char*)g.A + (size_t)cur.g * g.a_goff * 2 + (size_t)cur.pm * tstepA; const char* cB = (const char*)g.Bt + (size_t)cur.g * g.b_goff * 2 + (size_t)cur.pn * tstepB;
    S.a_ready(cur);
    if constexpr (SP2) {
        PG8_STAGE(PG8_SB(0, 0), cB, voffB); PG8_STAGE(PG8_SB(0, 1), cB + hstepB, voffB); PG8_STAGE(PG8_SA(0, 0), cA, voffA); PG8_STAGE(PG8_SA(0, 1), cA + hstepA, voffA);
        if (wr == 1) PG8_BAR;
        PG8_WAIT_V(2); PG8_BAR;
        PG8_STAGE(PG8_SB(1, 0), cB + kstep, voffB); PG8_STAGE(PG8_SA(1, 0), cA + kstep, voffA); PG8_STAGE(PG8_SB(1, 1), cB + hstepB + kstep, voffB);
        PG8_WAIT_V(6); PG8_BAR;
    } else {
        PG8_STAGE(PG8_SB(0, 0), cB, voffB); PG8_STAGE(PG8_SA(0, 0), cA, voffA); PG8_STAGE(PG8_SB(0, 1), cB + hstepB, voffB); PG8_STAGE(PG8_SA(0, 1), cA + hstepA, voffA);
        if (wr == 1) PG8_BAR;
        PG8_WAIT_V(4); PG8_BAR;
        PG8_STAGE(PG8_SB(1, 0), cB + kstep, voffB); PG8_STAGE(PG8_SA(1, 0), cA + kstep, voffA); PG8_STAGE(PG8_SB(1, 1), cB + hstepB + kstep, voffB);
        PG8_WAIT_V(6); PG8_BAR;
    }
    for (;;) {
        const bool has_next = S.next(ui + 1, nxt);
        const char* nA = has_next ? (const char*)g.A + (size_t)nxt.g * g.a_goff * 2 + (size_t)nxt.pm * tstepA : cA; const char* nB = has_next ? (const char*)g.Bt + (size_t)nxt.g * g.b_goff * 2 + (size_t)nxt.pn * tstepB : cB;
        for (int t = 0; t < nt; t += 2) {
            const bool last = (t == nt - 2);
            const char* a1 = cA + (size_t)(t + 1) * kstep;
            const char* a2 = last ? nA : cA + (size_t)(t + 2) * kstep; const char* b2 = last ? nB : cB + (size_t)(t + 2) * kstep;
            const char* a3 = a2 + kstep; const char* b3 = b2 + kstep;
            if (last && has_next) S.a_ready(nxt);
            if constexpr (SP2) {
            PG8_LDB(B0, 0, 0); PG8_LDB(B1, 0, 1); PG8_SCHED; PG8_LDA(At, 0, 0); PG8_STAGE(PG8_SA(1, 1), a1 + hstepA, voffA);
            PG8_WAIT_V(8); PG8_WAIT_L(0); PG8_BAR; PG8_MMA(0, 0, At, B0); PG8_MMA(0, 1, At, B1); PG8_BAR; PG8_SCHED;
            PG8_LDA(At, 0, 1); PG8_STAGE(PG8_SB(0, 0), b2, voffB); PG8_STAGE(PG8_SB(0, 1), b2 + hstepB, voffB); PG8_STAGE(PG8_SA(0, 0), a2, voffA);
            PG8_WAIT_V(8); PG8_WAIT_L(0); PG8_BAR; PG8_MMA(1, 0, At, B0); PG8_MMA(1, 1, At, B1); PG8_BAR; PG8_SCHED;
            PG8_LDB(B0, 1, 0); PG8_LDB(B1, 1, 1); PG8_SCHED; PG8_LDA(At, 1, 0); PG8_STAGE(PG8_SA(0, 1), a2 + hstepA, voffA);
            PG8_WAIT_V(8); PG8_WAIT_L(0); PG8_BAR; PG8_MMA(0, 0, At, B0); PG8_MMA(0, 1, At, B1); PG8_BAR; PG8_SCHED;
            PG8_LDA(At, 1, 1); PG8_STAGE(PG8_SB(1, 0), b3, voffB); PG8_STAGE(PG8_SB(1, 1), b3 + hstepB, voffB); PG8_STAGE(PG8_SA(1, 0), a3, voffA);
            PG8_WAIT_V(8); PG8_WAIT_L(0); PG8_BAR; PG8_MMA(1, 0, At, B0); PG8_MMA(1, 1, At, B1); PG8_BAR; PG8_SCHED;
            } else {
            PG8_LDB(B0, 0, 0); PG8_SCHED; PG8_LDA(At, 0, 0); PG8_STAGE(PG8_SA(1, 1), a1 + hstepA, voffA);
            PG8_WAIT_L(8); PG8_BAR; PG8_WAIT_L(0); PG8_MMA(0, 0, At, B0); PG8_BAR; PG8_SCHED;
            PG8_LDB(B1, 0, 1); PG8_STAGE(PG8_SB(0, 0), b2, voffB);
            PG8_BAR; PG8_WAIT_L(0); PG8_MMA(0, 1, At, B1); PG8_BAR;
            PG8_LDA(At, 0, 1); PG8_STAGE(PG8_SA(0, 0), a2, voffA);
            PG8_BAR; PG8_WAIT_L(0); PG8_MMA(1, 0, At, B0); PG8_BAR; PG8_SCHED;
            PG8_STAGE(PG8_SB(0, 1), b2 + hstepB, voffB);
            PG8_WAIT_V(6); PG8_BAR; PG8_MMA(1, 1, At, B1); PG8_BAR;
            PG8_LDB(B0, 1, 0); PG8_SCHED; PG8_LDA(At, 1, 0); PG8_STAGE(PG8_SA(0, 1), a2 + hstepA, voffA);
            PG8_WAIT_L(8); PG8_BAR; PG8_WAIT_L(0); PG8_MMA(0, 0, At, B0); PG8_BAR; PG8_SCHED;
            PG8_LDB(B1, 1, 1); PG8_STAGE(PG8_SB(1, 0), b3, voffB);
            PG8_BAR; PG8_WAIT_L(0); PG8_MMA(0, 1, At, B1); PG8_BAR;
            PG8_LDA(At, 1, 1); PG8_STAGE(PG8_SA(1, 0), a3, voffA);
            PG8_BAR; PG8_WAIT_L(0); PG8_MMA(1, 0, At, B0); PG8_BAR; PG8_SCHED;
            PG8_STAGE(PG8_SB(1, 1), b3 + hstepB, voffB);
            PG8_WAIT_V(6); PG8_BAR; PG8_MMA(1, 1, At, B1); PG8_BAR;
            }
        }
        if constexpr (ALIGN_EPI) { if (wr == 0) PG8_BAR; }
        if constexpr (!Epi::AFTER_DRAIN) { E(acc, cur, wr, wc, fr, fq); S.done(cur); }
        if (!has_next) break;
#pragma unroll
        for (int a = 0; a < 2; ++a)
#pragma unroll
            for (int b = 0; b < 2; ++b)
#pragma unroll
                for (int m = 0; m < 4; ++m)
#pragma unroll
                    for (int n = 0; n < 2; ++n) acc[a][b][m][n] = (f32x4){0.f, 0.f, 0.f, 0.f};
        cur = nxt; cA = nA; cB = nB; ++ui;
        if constexpr (ALIGN_EPI) { if (wr == 1) PG8_BAR; }
    }
    PG8_WAIT_V(0);
    if constexpr (!ALIGN_EPI) { if (wr == 0) PG8_BAR; }
    PG8_BAR;
    if constexpr (Epi::AFTER_DRAIN) { E.fused(acc, cur, wr, wc, fr, fq, lds, wid, lane); S.done(cur); }
#undef PG8_SA
#undef PG8_SB
#undef PG8_STAGE
#undef PG8_LDA
#undef PG8_LDB
#undef PG8_MMA
#undef PG8_WAIT_V
#undef PG8_WAIT_L
#undef PG8_BAR
#undef PG8_SCHED
}
}

constexpr int DM = 4096, NBP = 4, SEQ = 2048, NBS = 16, DSEQ = 32, PAST = 1024;
constexpr int MP = NBP * SEQ, MS = NBS * DSEQ, M = MP + MS, NBT = NBP + NBS;
constexpr int WPOOL = 2048, WSSD = 6144, HD = 64, NH = 96, NS = 128, CONVD = 8192, IN_DIM = 18528, NPAD = 18688, DIN = 8192;
constexpr int C_U = 0, C_G = 2048, C_Z = 4096, C_X = 10240, C_B = C_X + 6144, C_C = C_B + 1024, C_DT = 18432;
constexpr float LN_EPS = 1e-5f, RMS_EPS = 1e-5f, ALPHA = 1.41421356237f;
constexpr size_t O_Y = 0, O_PP = 35651584, O_CP = 35897344, O_SP = 36093952, O_PS = 42385408, O_CS = 43368448, O_SS = 44154880, O_END = 69320704;
constexpr size_t MiB = 1u << 20;
constexpr size_t WS_CTL = 0, CTL_ZERO_BYTES = 1 * MiB, WS_MODF = 1 * MiB, WS_WIN = 4 * MiB, WIN_L = 146 * MiB, WS_WOUT = 296 * MiB, WOUT_L = 64 * MiB, WS_WP = 424 * MiB,
                 WS_H = 428 * MiB, WS_PROJ = 496 * MiB, WS_XBC = 1117 * MiB, WS_POOLED = 1253 * MiB, WS_DTV = 1287 * MiB, WS_YG = 1291 * MiB, WS_MIXED = 1495 * MiB,
                 WS_R = 1631 * MiB, WS_X1 = 1767 * MiB, WS_END = 1903 * MiB;
static_assert((size_t)NPAD * DM * 2 == WIN_L && (size_t)DM * DIN * 2 == WOUT_L && WS_PROJ + (size_t)M * NPAD * 4 <= WS_XBC, "ws map");
constexpr int CW_BAR = 4096;
constexpr int RING_BYTES = 131072, LDSCTL_OFF = RING_BYTES, MISC_OFF = LDSCTL_OFF + 320, LDS_BYTES = 147456;
constexpr int NWAVES = 8;
constexpr int NPHASE = 14;

#define GAS __attribute__((address_space(1)))
#define LAS __attribute__((address_space(3)))
typedef unsigned short bf16;
typedef unsigned v4u __attribute__((ext_vector_type(4)));
typedef unsigned v2u __attribute__((ext_vector_type(2)));
typedef float f32x4 __attribute__((ext_vector_type(4)));
typedef float f32x2 __attribute__((ext_vector_type(2)));
#define LDS_WAIT() asm volatile("s_waitcnt lgkmcnt(0)" ::: "memory")
#define VM_WAIT() asm volatile("s_waitcnt vmcnt(0)" ::: "memory")
__device__ __forceinline__ unsigned f2bf(float f) { unsigned u = __builtin_bit_cast(unsigned, f); return (u + 0x7fffu + ((u >> 16) & 1u)) >> 16; }
__device__ __forceinline__ unsigned pk2(float lo, float hi) { return f2bf(lo) | (f2bf(hi) << 16); }
__device__ __forceinline__ float bf2f(unsigned short b) { return __builtin_bit_cast(float, ((unsigned)b) << 16); }
__device__ __forceinline__ float silu(float x) { return x / (1.0f + __expf(-x)); }
__device__ __forceinline__ float wave_sum(float v) {
#pragma unroll
    for (int o = 1; o < 64; o <<= 1) v += __shfl_xor(v, o);
    return v;
}

#define XB_TMO      128
#define XB_XCNT(j)  (256  + 64 * (j))
#define XB_XSUB(j)  (1280 + 64 * (j))
#define XB_XGEN(j)  (2304 + 64 * (j))
#define XB_TOP      3328
#define XB_TOPGEN   3392
#define XCD_BAR_WORDS 3456
#define XB_SPIN_CAP (1u << 18)
__device__ __forceinline__ unsigned xb_ld(unsigned* p)              { return __hip_atomic_load(p, __ATOMIC_RELAXED, __HIP_MEMORY_SCOPE_AGENT); }
__device__ __forceinline__ unsigned xb_add(unsigned* p, unsigned v) { return __hip_atomic_fetch_add(p, v, __ATOMIC_RELAXED, __HIP_MEMORY_SCOPE_AGENT); }
__device__ __forceinline__ unsigned xb_xcc_id() { return (unsigned)__builtin_amdgcn_s_getreg((3 << 11) | 20) & 0xFu; }
#define XB_SPIN(cond, bar) do { unsigned _sp = 0; while (cond) { __builtin_amdgcn_s_sleep(1); \
    if ((++_sp & 255u) == 0u) { if (xb_ld(&(bar)[XB_TMO])) break; if (_sp > XB_SPIN_CAP) { atomicAdd(&(bar)[XB_TMO], 1u); break; } } } } while (0)
struct XcdBarrier { unsigned* bar; unsigned x; volatile LAS unsigned* st; };
__device__ __forceinline__ XcdBarrier xcd_barrier_post(unsigned* bar, volatile LAS unsigned* st) {
    XcdBarrier b; b.bar = bar; b.x = xb_xcc_id(); b.st = st;
    if (threadIdx.x == 0) (void)xb_add(&bar[XB_XCNT(b.x)], 1u);
    return b;
}
__device__ __forceinline__ void xcd_barrier_complete(unsigned* bar, unsigned x, unsigned& nloc, unsigned& nx) {
    const unsigned G = gridDim.x * gridDim.y * gridDim.z;
    unsigned sum, cnt, mine, sp = 0u;
    for (;;) {
        sum = 0u; cnt = 0u; mine = 0u;
#pragma unroll
        for (unsigned j = 0; j < 16; ++j) { const unsigned c = xb_ld(&bar[XB_XCNT(j)]); sum += c; cnt += (c > 0u) ? 1u : 0u; mine = (j == x) ? c : mine; }
        if (sum == G) break;
        __builtin_amdgcn_s_sleep(1);
        if ((++sp & 255u) == 0u) { if (xb_ld(&bar[XB_TMO])) break; if (sp > XB_SPIN_CAP) { atomicAdd(&bar[XB_TMO], 1u); break; } }
    }
    nloc = mine > 0u ? mine : 1u; nx = cnt > 0u ? cnt : 1u;
}
__device__ __forceinline__ void xcd_barrier(const XcdBarrier& b) {
    asm volatile("s_waitcnt vmcnt(0)" ::: "memory");
    __syncthreads();
    if (threadIdx.x == 0) {
        unsigned* bar = b.bar;
        __builtin_amdgcn_s_waitcnt(0);
        unsigned nloc = b.st[0], nx = b.st[1];
        if (nloc == 0u) { xcd_barrier_complete(bar, b.x, nloc, nx); b.st[0] = nloc; b.st[1] = nx; }
        const unsigned old = xb_add(&bar[XB_XSUB(b.x)], 1u);
        const unsigned gen = old / nloc;
        if (old + 1u == (gen + 1u) * nloc) {
            __builtin_amdgcn_fence(__ATOMIC_RELEASE, "agent");
            asm volatile("s_waitcnt vmcnt(0)" ::: "memory");
            const unsigned og = xb_add(&bar[XB_TOP], 1u);
            const unsigned tg = og / nx;
            if (og + 1u == (tg + 1u) * nx) xb_add(&bar[XB_TOPGEN], 1u);
            else XB_SPIN(xb_ld(&bar[XB_TOPGEN]) == tg, bar);
            __builtin_amdgcn_fence(__ATOMIC_ACQUIRE, "agent");
            xb_add(&bar[XB_XGEN(b.x)], 1u);
            asm volatile("s_waitcnt vmcnt(0)" ::: "memory");
        } else {
            XB_SPIN(xb_ld(&bar[XB_XGEN(b.x)]) == gen, bar);
            __builtin_amdgcn_fence(__ATOMIC_ACQUIRE, "agent");
            asm volatile("s_waitcnt vmcnt(0)" ::: "memory");
        }
    }
    __syncthreads();
}

struct Args { const float* in[21]; float* out; unsigned char* ws; int ph_lo, ph_hi; };

__device__ __forceinline__ void p0_transpose_item(const float* W, int N, bf16* WT, int ldt, LAS float* scr, int kb, int nb, int lane) {
    const int k0 = 64 * kb, n0 = 32 * nb;
#pragma unroll 8
    for (int i = 0; i < 32; ++i) { const int kk = 2 * i + (lane >> 5); scr[kk * 33 + (lane & 31)] = W[(size_t)(k0 + kk) * N + n0 + (lane & 31)]; }
    LDS_WAIT(); asm volatile("" ::: "memory");
    const int c = lane & 7;
#pragma unroll
    for (int j = 0; j < 4; ++j) { const int n = (lane >> 3) + 8 * j; const LAS float* s = scr + (8 * c) * 33 + n;
        v4u o; o.x = pk2(s[0 * 33], s[1 * 33]); o.y = pk2(s[2 * 33], s[3 * 33]); o.z = pk2(s[4 * 33], s[5 * 33]); o.w = pk2(s[6 * 33], s[7 * 33]);
        *(GAS v4u*)(WT + (size_t)(n0 + n) * ldt + k0 + 8 * c) = o; }
    LDS_WAIT(); asm volatile("" ::: "memory");
}
__device__ __forceinline__ void p0_mod_item(const Args& a, LAS unsigned char* lds, int item, int tid, int lane, int wave) {
    const int l = item >> 7, cb = item & 127, e0 = cb * 96;
    const float* W = a.in[7] + (size_t)l * DM * 3 * DM;
    const float* cp = a.in[5]; const float* cs = a.in[6];
    LAS float* sl = (LAS float*)(lds + wave * 8192);
    f32x2 acc[20];
#pragma unroll
    for (int b = 0; b < 20; ++b) acc[b] = (f32x2){0.f, 0.f};
    const bool act = lane < 48;
    for (int ch = 0; ch < 8; ++ch) {
        const int d0 = wave * 512 + ch * 64;
#pragma unroll
        for (int b = 0; b < 20; ++b) { const float c = b < 4 ? cp[b * DM + d0 + lane] : cs[(b - 4) * DM + d0 + lane]; sl[lane * 20 + b] = c / (1.0f + expf(-c)); }
        LDS_WAIT(); asm volatile("" ::: "memory");
        for (int r = 0; r < 64; r += 8) {
            f32x2 wv[8];
#pragma unroll
            for (int j = 0; j < 8; ++j) wv[j] = act ? *(const f32x2*)(W + (size_t)(d0 + r + j) * (3 * DM) + e0 + 2 * lane) : (f32x2){0.f, 0.f};
#pragma unroll
            for (int j = 0; j < 8; ++j) { const LAS f32x4* sp = (const LAS f32x4*)(sl + (r + j) * 20);
#pragma unroll
                for (int q = 0; q < 5; ++q) { const f32x4 s4 = sp[q];
#pragma unroll
                    for (int c = 0; c < 4; ++c) acc[q * 4 + c] += wv[j] * s4[c]; } }
        }
        LDS_WAIT(); asm volatile("" ::: "memory");
    }
    LAS float* red = (LAS float*)(lds + 65536 + wave * 7680);
    if (act) {
#pragma unroll
        for (int b = 0; b < 20; ++b) *(LAS f32x2*)(red + b * 96 + 2 * lane) = acc[b]; }
    __syncthreads();
    float* modf = (float*)(a.ws + WS_MODF);
    for (int idx = tid; idx < 20 * 96; idx += NWAVES * 64) { float s = 0.f;
#pragma unroll
        for (int w = 0; w < 8; ++w) s += ((LAS float*)(lds + 65536 + w * 7680))[idx];
        const int b = idx / 96, e = idx % 96; modf[(size_t)(l * 20 + b) * (3 * DM) + e0 + e] = s + a.in[8][(size_t)l * 3 * DM + e0 + e]; }
    __syncthreads();
}
__device__ __forceinline__ void p0_prologue(const Args& a, LAS unsigned char* lds, int G, int bid, int tid, int lane, int wave) {
    for (int it = bid; it < 256; it += G) p0_mod_item(a, lds, it, tid, lane, wave);
    LAS float* scr = (LAS float*)(lds + wave * 16384);
    const int gw = bid * NWAVES + wave, NGW = G * NWAVES;
    constexpr int I_IN = 64 * 579, I_OUT = 128 * 128, I_P = 8 * 16;
    constexpr int NITEMS = 2 * I_IN + 2 * I_OUT + 8 * I_P;
    for (int it = gw; it < NITEMS; it += NGW) {
        int r = it;
        if (r < 2 * I_IN) { const int l = r / I_IN; r -= l * I_IN; p0_transpose_item(a.in[9] + (size_t)l * DM * IN_DIM, IN_DIM, (bf16*)(a.ws + WS_WIN + l * WIN_L), DM, scr, r / 579, r % 579, lane); continue; } r -= 2 * I_IN;
        if (r < 2 * I_OUT) { const int l = r / I_OUT; r -= l * I_OUT; p0_transpose_item(a.in[18] + (size_t)l * DIN * DM, DM, (bf16*)(a.ws + WS_WOUT + l * WOUT_L), DIN, scr, r / 128, r % 128, lane); continue; } r -= 2 * I_OUT;
        { const int lg = r / I_P; r -= lg * I_P; p0_transpose_item(a.in[10] + (size_t)lg * 512 * 512, 512, (bf16*)(a.ws + WS_WP) + (size_t)lg * 512 * 512, 512, scr, r / 16, r % 16, lane); }
    }
    for (int i = bid * NWAVES * 64 + tid; i < 2 * (NPAD - IN_DIM) * (DM / 8); i += G * NWAVES * 64) { const int l = i / ((NPAD - IN_DIM) * (DM / 8)), r = i % ((NPAD - IN_DIM) * (DM / 8));
        *(GAS v4u*)((bf16*)(a.ws + WS_WIN + l * WIN_L) + (size_t)IN_DIM * DM + (size_t)r * 8) = (v4u){0u, 0u, 0u, 0u}; }
}

__device__ __forceinline__ void row_stats(const f32x4 (&v)[16], float& mean, float& rstd) {
    float s = 0.f;
#pragma unroll
    for (int j = 0; j < 16; ++j) s += (v[j].x + v[j].y) + (v[j].z + v[j].w);
    mean = wave_sum(s) * (1.f / DM); float q = 0.f;
#pragma unroll
    for (int j = 0; j < 16; ++j) { const f32x4 d = v[j] - mean; q += (d.x * d.x + d.y * d.y) + (d.z * d.z + d.w * d.w); }
    rstd = 1.f / sqrtf(wave_sum(q) * (1.f / DM) + LN_EPS);
}
__device__ __forceinline__ int batch_of(int m) { return m < MP ? (m >> 11) : NBP + ((m - MP) >> 5); }
__device__ __forceinline__ void mod_row_to_bf16(const f32x4 (&v)[16], const float* md, bf16* hrow, int lane) {
    float mean, rstd; row_stats(v, mean, rstd);
#pragma unroll
    for (int j = 0; j < 16; ++j) { const f32x4 sh = ((const f32x4*)md)[lane + 64 * j], sc = ((const f32x4*)(md + DM))[lane + 64 * j];
        const f32x4 o = (v[j] - mean) * rstd * (sc + 1.0f) + sh;
        ((GAS v2u*)hrow)[lane + 64 * j] = (v2u){pk2(o.x, o.y), pk2(o.z, o.w)}; }
}
__device__ __forceinline__ void phase_a(const Args& a, int G, int bid, int lane, int wave) {
    const int gw = bid * NWAVES + wave, NGW = G * NWAVES;
    const float* modf = (const float*)(a.ws + WS_MODF); bf16* H = (bf16*)(a.ws + WS_H);
    for (int m = gw; m < M; m += NGW) {
        const float* xr = m < MP ? a.in[0] + (size_t)m * DM : a.in[1] + (size_t)(m - MP) * DM;
        f32x4 v[16];
#pragma unroll
        for (int j = 0; j < 16; ++j) v[j] = ((const f32x4*)xr)[lane + 64 * j];
        mod_row_to_bf16(v, modf + (size_t)batch_of(m) * 3 * DM, H + (size_t)m * DM, lane);
    }
}
__device__ __forceinline__ void phase_g(const Args& a, int l, int G, int bid, int lane, int wave) {
    const int gw = bid * NWAVES + wave, NGW = G * NWAVES;
    const float* modf = (const float*)(a.ws + WS_MODF); bf16* H = (bf16*)(a.ws + WS_H);
    const float* R = (const float*)(a.ws + WS_R); float* xo = l == 0 ? (float*)(a.ws + WS_X1) : a.out + O_Y;
    const float* lg = a.in[19] + (size_t)l * DM; const float* lb = a.in[20] + (size_t)l * DM;
    for (int m = gw; m < M; m += NGW) {
        f32x4 v[16];
#pragma unroll
        for (int j = 0; j < 16; ++j) v[j] = ((const f32x4*)(R + (size_t)m * DM))[lane + 64 * j];
        float mean, rstd; row_stats(v, mean, rstd);
#pragma unroll
        for (int j = 0; j < 16; ++j) { v[j] = (v[j] - mean) * rstd * ((const f32x4*)lg)[lane + 64 * j] + ((const f32x4*)lb)[lane + 64 * j];
            ((GAS f32x4*)(xo + (size_t)m * DM))[lane + 64 * j] = v[j]; }
        if (l == 0) mod_row_to_bf16(v, modf + (size_t)(NBT + batch_of(m)) * 3 * DM, H + (size_t)m * DM, lane);
    }
}
__device__ __forceinline__ f32x4 pool_hist(const float* pc, const float* st, bool samp, int t) {
    if (t >= 0) return *(const f32x4*)(pc + (size_t)t * NPAD);
    if (samp) return *(const f32x4*)(st + (size_t)(15 + t) * WPOOL);
    return (f32x4){0.f, 0.f, 0.f, 0.f};
}
__device__ __forceinline__ void phase_c(const Args& a, int l, int G, int bid, int tid) {
    const float* proj = (const float*)(a.ws + WS_PROJ);
    for (int it = bid; it < 272 * 5; it += G) {
        const int seg = it / 5, cblk = it % 5, m0 = seg * 32;
        const bool samp = m0 >= MP; const int b = samp ? (m0 - MP) >> 5 : m0 >> 11, t0 = samp ? 0 : (m0 & 2047), L = samp ? DSEQ : SEQ;
        if (cblk == 0) {
            const int j0 = 4 * tid, w = 2 << (j0 >> 9);
            const float* pc = proj + (size_t)(m0 - t0) * NPAD + C_U + j0;
            const float* st = a.in[2] + (size_t)(l * NBS + b) * 15 * WPOOL + j0;
            bf16* po = (bf16*)(a.ws + WS_POOLED) + (size_t)m0 * WPOOL + j0;
            float* no = a.out + (samp ? O_PS : O_PP) + (size_t)(l * (samp ? NBS : NBP) + b) * 15 * WPOOL + j0;
            f32x4 S = (f32x4){0.f, 0.f, 0.f, 0.f};
            for (int i = 1; i < w; ++i) S += pool_hist(pc, st, samp, t0 - i);
            for (int r = 0; r < 32; ++r) { const int t = t0 + r; const f32x4 u = pool_hist(pc, st, samp, t); S += u;
                const int pos = (samp ? PAST : 0) + t; const float cnt = (float)(pos + 1 < w ? pos + 1 : w);
                const f32x4 p = S / cnt - u;
                *(GAS v2u*)(po + (size_t)r * WPOOL) = (v2u){pk2(p.x, p.y), pk2(p.z, p.w)};
                S -= pool_hist(pc, st, samp, t - w + 1);
                if (t >= L - 15) *(GAS f32x4*)(no + (size_t)(t - (L - 15)) * WPOOL) = u; }
        } else {
            const int j0 = (cblk - 1) * 2048 + 4 * tid;
            const float* cw = a.in[12] + (size_t)l * 4 * CONVD + j0;
            const f32x4 w0 = *(const f32x4*)cw, w1 = *(const f32x4*)(cw + CONVD), w2 = *(const f32x4*)(cw + 2 * CONVD), w3 = *(const f32x4*)(cw + 3 * CONVD), bs = *(const f32x4*)(a.in[13] + (size_t)l * CONVD + j0);
            const float* pc = proj + (size_t)m0 * NPAD + C_X + j0;
            f32x4 p3 = (f32x4){0.f, 0.f, 0.f, 0.f}, p2 = p3, p1 = p3;
            if (samp) { const float* st = a.in[3] + (size_t)(l * NBS + b) * 3 * CONVD + j0; p3 = *(const f32x4*)st; p2 = *(const f32x4*)(st + CONVD); p1 = *(const f32x4*)(st + 2 * CONVD); }
            else if (t0 != 0) { p3 = *(const f32x4*)(pc - 3 * (size_t)NPAD); p2 = *(const f32x4*)(pc - 2 * (size_t)NPAD); p1 = *(const f32x4*)(pc - (size_t)NPAD); }
            bf16* xo = (bf16*)(a.ws + WS_XBC) + (size_t)m0 * CONVD + j0;
            float* no = a.out + (samp ? O_CS : O_CP) + (size_t)(l * (samp ? NBS : NBP) + b) * 3 * CONVD + j0;
            for (int r = 0; r < 32; ++r) { const f32x4 cur = *(const f32x4*)(pc + (size_t)r * NPAD);
                f32x4 o = w0 * p3 + w1 * p2 + w2 * p1 + w3 * cur + bs;
                o.x = silu(o.x); o.y = silu(o.y); o.z = silu(o.z); o.w = silu(o.w);
                *(GAS v2u*)(xo + (size_t)r * CONVD) = (v2u){pk2(o.x, o.y), pk2(o.z, o.w)};
                const int t = t0 + r; if (t >= L - 3) *(GAS f32x4*)(no + (size_t)(t - (L - 3)) * CONVD) = cur;
                p3 = p2; p2 = p1; p1 = cur; }
        }
    }
    float* dtv = (float*)(a.ws + WS_DTV);
    for (int i = bid * NWAVES * 64 + tid; i < M * NH; i += G * NWAVES * 64) { const int m = i / NH, h = i % NH;
        const float x = proj[(size_t)m * NPAD + C_DT + h] + a.in[14][l * NH + h];
        dtv[i] = fmaxf(x, 0.f) + log1pf(expf(-fabsf(x))); }
}
__device__ __forceinline__ void ssd_naive_unit(const Args& a, LAS unsigned char* lds, int l, int unit, int tid) {
    const bool samp = unit >= NBP * NH; const int u2 = samp ? unit - NBP * NH : unit; const int b = u2 / NH, h = u2 % NH, g = h / 12;
    const int T = samp ? DSEQ : SEQ, mbase = samp ? MP + b * DSEQ : b * SEQ;
    const int p = tid >> 3, nq = tid & 7;
    float hs[16];
    if (samp) { const float* s0 = a.in[4] + ((size_t)((l * NBS + b) * NH + h) * HD + p) * NS + nq * 16;
#pragma unroll
        for (int i = 0; i < 4; ++i) { const f32x4 t4 = ((const f32x4*)s0)[i]; hs[4 * i] = t4.x; hs[4 * i + 1] = t4.y; hs[4 * i + 2] = t4.z; hs[4 * i + 3] = t4.w; } }
    else {
#pragma unroll
        for (int i = 0; i < 16; ++i) hs[i] = 0.f; }
    const float A = -expf(a.in[15][l * NH + h]), Dk = a.in[16][l * NH + h];
    LAS float* xs = (LAS float*)lds; LAS float* Bs = (LAS float*)(lds + 16384); LAS float* Cs = (LAS float*)(lds + 49152); LAS float* zs = (LAS float*)(lds + 81920);
    LAS float* ys = (LAS float*)(lds + 98304); LAS float* dts = (LAS float*)(lds + 114688);
    const bf16* xbc = (const bf16*)(a.ws + WS_XBC); const float* proj = (const float*)(a.ws + WS_PROJ); const float* dtv = (const float*)(a.ws + WS_DTV); float* yg = (float*)(a.ws + WS_YG);
    for (int c0 = 0; c0 < T; c0 += 64) {
        const int CL = (T - c0) < 64 ? (T - c0) : 64;
        __syncthreads();
        { const int t = tid >> 3, c8 = (tid & 7) * 8;
          if (t < CL) { const v4u q = *(const v4u*)(xbc + (size_t)(mbase + c0 + t) * CONVD + h * HD + c8); LAS float* d = xs + t * 64 + c8;
              d[0] = bf2f(q.x & 0xffff); d[1] = bf2f(q.x >> 16); d[2] = bf2f(q.y & 0xffff); d[3] = bf2f(q.y >> 16); d[4] = bf2f(q.z & 0xffff); d[5] = bf2f(q.z >> 16); d[6] = bf2f(q.w & 0xffff); d[7] = bf2f(q.w >> 16); } }
#pragma unroll
        for (int ps = 0; ps < 2; ++ps) { const int t = (tid >> 4) + 32 * ps, c8 = (tid & 15) * 8;
          if (t < CL) { const bf16* rp = xbc + (size_t)(mbase + c0 + t) * CONVD + WSSD + g * NS + c8; const v4u qb = *(const v4u*)rp, qc = *(const v4u*)(rp + 1024);
              LAS float* d = Bs + t * 128 + c8; LAS float* e = Cs + t * 128 + c8;
              d[0] = bf2f(qb.x & 0xffff); d[1] = bf2f(qb.x >> 16); d[2] = bf2f(qb.y & 0xffff); d[3] = bf2f(qb.y >> 16); d[4] = bf2f(qb.z & 0xffff); d[5] = bf2f(qb.z >> 16); d[6] = bf2f(qb.w & 0xffff); d[7] = bf2f(qb.w >> 16);
              e[0] = bf2f(qc.x & 0xffff); e[1] = bf2f(qc.x >> 16); e[2] = bf2f(qc.y & 0xffff); e[3] = bf2f(qc.y >> 16); e[4] = bf2f(qc.z & 0xffff); e[5] = bf2f(qc.z >> 16); e[6] = bf2f(qc.w & 0xffff); e[7] = bf2f(qc.w >> 16); } }
#pragma unroll
        for (int ps = 0; ps < 2; ++ps) { const int t = (tid >> 4) + 32 * ps, c4 = (tid & 15) * 4;
          if (t < CL) *(LAS f32x4*)(zs + t * 64 + c4) = *(const f32x4*)(proj + (size_t)(mbase + c0 + t) * NPAD + C_Z + h * HD + c4); }
        if (tid < CL) dts[tid] = dtv[(size_t)(mbase + c0 + tid) * NH + h];
        __syncthreads();
        for (int t = 0; t < CL; ++t) {
            const float dt = dts[t], dA = __expf(dt * A), xv = xs[t * 64 + p], xdt = dt * xv;
            float yp = 0.f;
#pragma unroll
            for (int i4 = 0; i4 < 4; ++i4) { const f32x4 bv = *(const LAS f32x4*)(Bs + t * 128 + nq * 16 + 4 * i4), cv = *(const LAS f32x4*)(Cs + t * 128 + nq * 16 + 4 * i4);
#pragma unroll
                for (int k = 0; k < 4; ++k) { hs[4 * i4 + k] = dA * hs[4 * i4 + k] + xdt * bv[k]; yp += cv[k] * hs[4 * i4 + k]; } }
            yp += __shfl_xor(yp, 1); yp += __shfl_xor(yp, 2); yp += __shfl_xor(yp, 4);
            if (nq == 0) ys[t * 64 + p] = (yp + Dk * xv) * silu(zs[t * 64 + p]);
        }
        __syncthreads();
#pragma unroll
        for (int ps = 0; ps < 2; ++ps) { const int t = (tid >> 4) + 32 * ps, c4 = (tid & 15) * 4;
          if (t < CL) *(GAS f32x4*)(yg + (size_t)(mbase + c0 + t) * WSSD + h * HD + c4) = *(const LAS f32x4*)(ys + t * 64 + c4); }
    }
    float* so = a.out + (samp ? O_SS : O_SP) + ((size_t)((l * (samp ? NBS : NBP) + b) * NH + h) * HD + p) * NS + nq * 16;
#pragma unroll
    for (int i = 0; i < 4; ++i) ((GAS f32x4*)so)[i] = (f32x4){hs[4 * i], hs[4 * i + 1], hs[4 * i + 2], hs[4 * i + 3]};
    __syncthreads();
}
__device__ __forceinline__ void phase_e(const Args& a, int l, int G, int bid, int lane, int wave) {
    const int gw = bid * NWAVES + wave, NGW = G * NWAVES;
    const float* yg = (const float*)(a.ws + WS_YG); bf16* mx = (bf16*)(a.ws + WS_MIXED);
    for (int it = gw; it < M * 8; it += NGW) { const int m = it >> 3, g = it & 7;
        const f32x4* yr = (const f32x4*)(yg + (size_t)m * WSSD + g * 768); f32x4 v[3]; float ss = 0.f;
#pragma unroll
        for (int j = 0; j < 3; ++j) { v[j] = yr[lane + 64 * j]; ss += (v[j].x * v[j].x + v[j].y * v[j].y) + (v[j].z * v[j].z + v[j].w * v[j].w); }
        const float rstd = 1.f / sqrtf(wave_sum(ss) * (1.f / 768.f) + RMS_EPS);
        const f32x4* nw = (const f32x4*)(a.in[17] + (size_t)l * WSSD + g * 768);
#pragma unroll
        for (int j = 0; j < 3; ++j) { const f32x4 o = v[j] * rstd * nw[lane + 64 * j];
            ((GAS v2u*)(mx + (size_t)m * DIN + WPOOL + g * 768))[lane + 64 * j] = (v2u){pk2(o.x, o.y), pk2(o.z, o.w)}; }
    }
}

__global__ void __launch_bounds__(NWAVES * 64, 2) trunk_fwd(Args args) {
    extern __shared__ __attribute__((aligned(16))) unsigned char lds_raw[];
    LAS unsigned char* lds = (LAS unsigned char*)lds_raw;
    volatile LAS unsigned* MISC = (volatile LAS unsigned*)(lds + MISC_OFF);
    const int tid = threadIdx.x, lane = tid & 63, wave = __builtin_amdgcn_readfirstlane(tid >> 6);
    const int G = gridDim.x, bid = blockIdx.x;
    unsigned* ctl = (unsigned*)(args.ws + WS_CTL);
    for (int u = tid; u < (LDS_BYTES - LDSCTL_OFF) / 4; u += NWAVES * 64) ((LAS unsigned*)(lds + LDSCTL_OFF))[u] = 0u;
    __syncthreads();
    const int lo = args.ph_lo, hi = args.ph_hi;
    XcdBarrier bar; bar.bar = ctl + CW_BAR; bar.x = 0; bar.st = MISC + 8;
    if (hi - lo > 1) bar = xcd_barrier_post(ctl + CW_BAR, MISC + 8);
#define IN(k) (lo <= (k) && (k) < hi)
#define BOTH(k) (IN(k) && IN((k) + 1))
#define SEAM(k) do { if (BOTH(k)) xcd_barrier(bar); } while (0)

    if (IN(0)) { p0_prologue(args, lds, G, bid, tid, lane, wave); SEAM(0); }
    if (IN(1)) { phase_a(args, G, bid, lane, wave); SEAM(1); }
    for (int l = 0; l < 2; ++l) {
        const int pb = 2 + 6 * l;
        int tl = threadIdx.x; asm volatile("" : "+v"(tl));
        const int lanel = tl & 63, wavel = __builtin_amdgcn_readfirstlane(tl >> 6);
        if (IN(pb)) {
            pg8::Gemm g{(const pg8::bf16_t*)(args.ws + WS_H), (const pg8::bf16_t*)(args.ws + WS_WIN + (size_t)l * WIN_L), M, NPAD, DM, DM, DM, 0, 0};
            pg8::StaticOrder S; S.init(M, NPAD, G, bid);
            pg8::EpiF32 E{(float*)(args.ws + WS_PROJ), NPAD};
            pg8::gemm_phase<pg8::EpiF32, pg8::StaticOrder, true, true>(lds, g, S, E, tl);
            SEAM(pb);
        }
        if (IN(pb + 1)) { phase_c(args, l, G, bid, tl); SEAM(pb + 1); }
        if (IN(pb + 2)) {
            { pg8::Gemm g{(const pg8::bf16_t*)(args.ws + WS_POOLED), (const pg8::bf16_t*)(args.ws + WS_WP) + (size_t)l * 4 * 512 * 512, M, 512, 512, WPOOL, 512, 512, (size_t)512 * 512};
              pg8::GroupOrder S; S.init(M, 512, 4, G, bid);
              pg8::EpiPool E{(pg8::bf16_t*)(args.ws + WS_MIXED), DIN, (const float*)(args.ws + WS_PROJ) + C_G, NPAD, args.in[11] + (size_t)l * WPOOL};
              pg8::gemm_phase<pg8::EpiPool, pg8::GroupOrder, true, true>(lds, g, S, E, tl); }
            __syncthreads();
            for (int u = bid; u < (NBP + NBS) * NH; u += G) ssd_naive_unit(args, lds, l, u, tl);
            SEAM(pb + 2);
        }
        if (IN(pb + 3)) { phase_e(args, l, G, bid, lanel, wavel); SEAM(pb + 3); }
        if (IN(pb + 4)) {
            pg8::Gemm g{(const pg8::bf16_t*)(args.ws + WS_MIXED), (const pg8::bf16_t*)(args.ws + WS_WOUT + (size_t)l * WOUT_L), M, DM, DIN, DIN, DIN, 0, 0};
            pg8::StaticOrder S; S.init(M, DM, G, bid);
            const float* xp = l == 0 ? args.in[0] : (const float*)(args.ws + WS_X1); const float* xs = l == 0 ? args.in[1] : (const float*)(args.ws + WS_X1) + (size_t)MP * DM;
            pg8::EpiResid E{(float*)(args.ws + WS_R), DM, xp, xs, (const float*)(args.ws + WS_MODF) + (size_t)l * NBT * 3 * DM + 2 * DM, 3 * DM, ALPHA};
            pg8::gemm_phase<pg8::EpiResid, pg8::StaticOrder, true, true>(lds, g, S, E, tl);
            SEAM(pb + 4);
        }
        if (IN(pb + 5)) { phase_g(args, l, G, bid, lanel, wavel); if (pb + 5 < NPHASE - 1) SEAM(pb + 5); }
    }
#undef IN
#undef BOTH
#undef SEAM
}

#ifndef MK_SPLIT
#define MK_SPLIT 1
#endif
extern "C" void kernel_launch(void* const* d_in, const int* in_sizes, int n_in, void* d_out, int out_size, void* d_ws, size_t ws_size, hipStream_t stream) {
    static int grid = 0;
    if (grid == 0) {
        if (n_in != 21 || (size_t)out_size != O_END || ws_size < WS_END) { fprintf(stderr, "kernel_launch: unexpected shapes: n_in %d out %d ws %zu; nothing launched\n", n_in, out_size, ws_size); grid = -1; return; }
        int dev = 0, cus = 0, per_cu = 0;
        if (hipGetDevice(&dev) != hipSuccess || hipDeviceGetAttribute(&cus, hipDeviceAttributeMultiprocessorCount, dev) != hipSuccess) { grid = -1; return; }
        if (hipFuncSetAttribute((const void*)trunk_fwd, hipFuncAttributeMaxDynamicSharedMemorySize, LDS_BYTES) != hipSuccess) { fprintf(stderr, "kernel_launch: hipFuncSetAttribute failed\n"); grid = -1; return; }
        if (hipOccupancyMaxActiveBlocksPerMultiprocessor(&per_cu, (const void*)trunk_fwd, NWAVES * 64, LDS_BYTES) != hipSuccess || per_cu < 1) { fprintf(stderr, "kernel_launch: occupancy query says %d blocks per CU\n", per_cu); (void)hipGetLastError(); grid = -1; return; }
        grid = cus;
    }
    if (grid < 0) return;
    if (hipMemsetAsync((char*)d_ws + WS_CTL, 0, CTL_ZERO_BYTES, stream) != hipSuccess) return;
    Args a{};
    for (int i = 0; i < 21; ++i) a.in[i] = (const float*)d_in[i];
    a.out = (float*)d_out; a.ws = (unsigned char*)d_ws;
#if MK_SPLIT
    for (int ph = 0; ph < NPHASE; ++ph) { a.ph_lo = ph; a.ph_hi = ph + 1; hipLaunchKernelGGL(trunk_fwd, dim3(grid), dim3(NWAVES * 64), LDS_BYTES, stream, a); }
#else
    a.ph_lo = 0; a.ph_hi = NPHASE; hipLaunchKernelGGL(trunk_fwd, dim3(grid), dim3(NWAVES * 64), LDS_BYTES, stream, a);
#endif
}
```

```cpp
#include <hip/hip_runtime.h>
#include <cstdio>
#include <cstdint>
namespace pg8 {
#define PG8_LAS __attribute__((address_space(3)))
typedef unsigned short bf16_t;
typedef short bf16x8 __attribute__((ext_vector_type(8)));
typedef float f32x4 __attribute__((ext_vector_type(4)));
typedef unsigned u32x4 __attribute__((ext_vector_type(4)));
constexpr int BM = 256, BK = 64, HALF = 128, HTB = HALF * BK * 2  , STAGE_BYTES = 8 * HTB, NXCD = 8, WGM = 8;

__host__ __device__ __forceinline__ int lds_byte(int r, int c) { const int st = (r >> 4) * 2 + (c >> 5), rr = r & 15, cc = c & 31, ob = rr * 64 + cc * 2; return st * 1024 + (ob ^ (((ob >> 9) & 1) << 5)); }
__host__ __device__ __forceinline__ void stage_rc(int b, int& R, int& C) { const int st = b / 1024, sb = b % 1024, swz = sb ^ (((sb >> 9) & 1) << 5); R = (st >> 1) * 16 + swz / 64; C = (st & 1) * 32 + (swz % 64) / 2; }
__host__ __device__ __forceinline__ int perm32(int rho) { const int n = rho >> 4, i = rho & 15; return 8 * (i >> 2) + 4 * n + (i & 3); }

struct Unit { int pm, pn, g; };
struct Gemm { const bf16_t* A; const bf16_t* Bt; int M, N, K, lda, ldb; size_t a_goff, b_goff; };

struct StaticOrder {
    int nM, nN, nwg, G, c;
    __host__ __device__ void init(int M, int N, int G_, int c_) { nM = M / BM; nN = N / BM; nwg = nM * nN; G = G_; c = c_; }
    __host__ __device__ bool next(int i, Unit& u) const {
        const long L = (long)i * G + c; if (L >= nwg) return false;
        int wgid = (int)L; { const int q = nwg / NXCD, r = nwg % NXCD, xcd = wgid % NXCD, off = wgid / NXCD; wgid = (xcd < r ? xcd * (q + 1) : r * (q + 1) + (xcd - r) * q) + off; }
        const int nig = WGM * nN, gid = wgid / nig, fm = gid * WGM, gsz = (nM - fm) < WGM ? (nM - fm) : WGM;
        u.pm = fm + ((wgid % nig) % gsz); u.pn = (wgid % nig) / gsz; u.g = 0; return true;
    }
    __device__ __forceinline__ void a_ready(const Unit&) const {}
    __device__ __forceinline__ void done(const Unit&) const {}
};
struct GroupOrder {
    int nM, nN, ng, G, c;
    __host__ __device__ void init(int M, int N, int ng_, int G_, int c_) { nM = M / BM; nN = N / BM; ng = ng_; G = G_; c = c_; }
    __host__ __device__ bool next(int i, Unit& u) const {
        const long L = (long)i * G + c; if (L >= (long)nM * nN * ng) return false;
        const int per = nM * nN, l = (int)L; u.g = l / per; const int r = l % per; u.pm = r % nM; u.pn = r / nM; return true;
    }
    __device__ __forceinline__ void a_ready(const Unit&) const {}
    __device__ __forceinline__ void done(const Unit&) const {}
};

__device__ __forceinline__ unsigned cvt_pk_bf16(float lo, float hi) { unsigned r; asm volatile("v_cvt_pk_bf16_f32 %0, %1, %2" : "=v"(r) : "v"(lo), "v"(hi)); return r; }
__device__ __forceinline__ float silu_f(float x) { return x * __builtin_amdgcn_rcpf(1.0f + __expf(-x)); }

struct EpiF32 {
    static constexpr bool PERM = false, AFTER_DRAIN = false;
    float* C; int ldc;
    __device__ __forceinline__ void operator()(const f32x4 (&acc)[2][2][4][2], const Unit& u, int wr, int wc, int fr, int fq) const {
        const int row0 = u.pm * BM + wr * 64 + fr, col0 = u.pn * BM + wc * 32 + 4 * fq;
#pragma unroll
        for (int ai = 0; ai < 2; ++ai)
#pragma unroll
            for (int m = 0; m < 4; ++m) { float* rowp = C + (size_t)(row0 + ai * HALF + m * 16) * ldc + col0;
#pragma unroll
                for (int bj = 0; bj < 2; ++bj)
#pragma unroll
                    for (int n = 0; n < 2; ++n) *(f32x4*)(rowp + bj * HALF + n * 16) = acc[ai][bj][m][n]; }
    }
};
struct EpiPool {
    static constexpr bool PERM = true, AFTER_DRAIN = false;
    bf16_t* O; int ldo; const float* gp; int ldp; const float* pscale;
    __device__ __forceinline__ void operator()(const f32x4 (&acc)[2][2][4][2], const Unit& u, int wr, int wc, int fr, int fq) const {
        const int row0 = u.pm * BM + wr * 64 + fr, col0 = u.g * 512 + u.pn * BM + wc * 32 + 8 * fq;
        f32x4 ps[2][2];
#pragma unroll
        for (int bj = 0; bj < 2; ++bj)
#pragma unroll
            for (int n = 0; n < 2; ++n) ps[bj][n] = *(const f32x4*)(pscale + col0 + bj * HALF + 4 * n);
#pragma unroll
        for (int ai = 0; ai < 2; ++ai)
#pragma unroll
            for (int m = 0; m < 4; ++m) { const size_t row = (size_t)(row0 + ai * HALF + m * 16);
#pragma unroll
                for (int bj = 0; bj < 2; ++bj) { const int c = col0 + bj * HALF;
                    const f32x4 g0 = *(const f32x4*)(gp + row * ldp + c), g1 = *(const f32x4*)(gp + row * ldp + c + 4);
                    f32x4 v0 = acc[ai][bj][m][0] * ps[bj][0], v1 = acc[ai][bj][m][1] * ps[bj][1];
#pragma unroll
                    for (int j = 0; j < 4; ++j) { v0[j] *= silu_f(g0[j]); v1[j] *= silu_f(g1[j]); }
                    u32x4 w; w.x = cvt_pk_bf16(v0[0], v0[1]); w.y = cvt_pk_bf16(v0[2], v0[3]); w.z = cvt_pk_bf16(v1[0], v1[1]); w.w = cvt_pk_bf16(v1[2], v1[3]);
                    *(u32x4*)(O + row * ldo + c) = w; } }
    }
};
struct EpiResid {
    static constexpr bool PERM = false, AFTER_DRAIN = false;
    float* R; int ldr; const float* xp; const float* xs; const float* gate; int ldg; float alpha;
    __device__ __forceinline__ void operator()(const f32x4 (&acc)[2][2][4][2], const Unit& u, int wr, int wc, int fr, int fq) const {
        const int row0 = u.pm * BM + wr * 64 + fr, col0 = u.pn * BM + wc * 32 + 4 * fq;
#pragma unroll
        for (int ai = 0; ai < 2; ++ai)
#pragma unroll
            for (int m = 0; m < 4; ++m) { const int row = row0 + ai * HALF + m * 16;
                const int b = row < 8192 ? (row >> 11) : 4 + ((row - 8192) >> 5);
                const float* xr = row < 8192 ? xp + (size_t)row * 4096 : xs + (size_t)(row - 8192) * 4096;
                const float* gr = gate + (size_t)b * ldg; float* rr = R + (size_t)row * ldr;
#pragma unroll
                for (int bj = 0; bj < 2; ++bj)
#pragma unroll
                    for (int n = 0; n < 2; ++n) { const int c = col0 + bj * HALF + n * 16;
                        const f32x4 xv = *(const f32x4*)(xr + c), gv = *(const f32x4*)(gr + c);
                        *(f32x4*)(rr + c) = xv * alpha + gv * acc[ai][bj][m][n]; } }
    }
};

template <class Epi, class Sched, bool ALIGN_EPI = false, bool SP2 = false>
__device__ __forceinline__ void gemm_phase(PG8_LAS unsigned char* lds, const Gemm g, const Sched& S, const Epi& E, const int tid) {
    const int wid = __builtin_amdgcn_readfirstlane(tid >> 6), lane = tid & 63, wr = wid >> 2, wc = wid & 3, fr = lane & 15, fq = lane >> 4;
    const int K = g.K, nt = K / BK;
    unsigned voffA[2], voffB[2];
#pragma unroll
    for (int i = 0; i < 2; ++i) { int R, C; stage_rc(tid * 16 + i * 8192, R, C); const int Rb = Epi::PERM ? ((R & ~31) + perm32(R & 31)) : R;
        voffA[i] = (unsigned)(R * g.lda + C) * 2u; voffB[i] = (unsigned)(Rb * g.ldb + C) * 2u; }
    const size_t kstep = (size_t)(BK * 2);
    const size_t hstepA = (size_t)HALF * g.lda * 2, hstepB = (size_t)HALF * g.ldb * 2;
    const size_t tstepA = 2 * hstepA, tstepB = 2 * hstepB;
    const unsigned ldsw = (unsigned)wid * 1024u;
    const int aoff = lds_byte(wr * 64 + fr, fq * 8), boff = lds_byte(wc * 32 + fr, fq * 8);
#define PG8_SA(b, h) (((b) * 2 + (h)) * HTB)
#define PG8_SB(b, h) ((4 + (b) * 2 + (h)) * HTB)
#define PG8_STAGE(bufoff, gbase, voff) do { _Pragma("unroll") for (int _i = 0; _i < 2; ++_i) \
        __builtin_amdgcn_global_load_lds((const unsigned*)((const char*)(gbase) + (voff)[_i]), (PG8_LAS unsigned*)(lds + (bufoff) + ldsw + _i * 8192), 16, 0, 0); } while (0)
#define PG8_LDA(dst, b, h) do { _Pragma("unroll") for (int m = 0; m < 4; ++m) _Pragma("unroll") for (int k = 0; k < 2; ++k) dst[m][k] = *(const PG8_LAS bf16x8*)(lds + PG8_SA(b, h) + aoff + m * 2048 + k * 1024); } while (0)
#define PG8_LDB(dst, b, h) do { _Pragma("unroll") for (int n = 0; n < 2; ++n) _Pragma("unroll") for (int k = 0; k < 2; ++k) dst[n][k] = *(const PG8_LAS bf16x8*)(lds + PG8_SB(b, h) + boff + n * 2048 + k * 1024); } while (0)
#define PG8_MMA(ai, bj, At, Bt) do { __builtin_amdgcn_s_setprio(1); _Pragma("unroll") for (int m = 0; m < 4; ++m) _Pragma("unroll") for (int n = 0; n < 2; ++n) _Pragma("unroll") for (int k = 0; k < 2; ++k) \
        acc[ai][bj][m][n] = __builtin_amdgcn_mfma_f32_16x16x32_bf16(Bt[n][k], At[m][k], acc[ai][bj][m][n], 0, 0, 0); __builtin_amdgcn_s_setprio(0); } while (0)
#define PG8_WAIT_V(n) asm volatile("s_waitcnt vmcnt(" #n ")" ::: "memory")
#define PG8_WAIT_L(n) asm volatile("s_waitcnt lgkmcnt(" #n ")" ::: "memory")
#define PG8_BAR __builtin_amdgcn_s_barrier()
#define PG8_SCHED __builtin_amdgcn_sched_barrier(0)
    Unit cur, nxt; int ui = 0;
    if (!S.next(0, cur)) return;
    f32x4 acc[2][2][4][2];
#pragma unroll
    for (int a = 0; a < 2; ++a)
#pragma unroll
        for (int b = 0; b < 2; ++b)
#pragma unroll
            for (int m = 0; m < 4; ++m)
#pragma unroll
                for (int n = 0; n < 2; ++n) acc[a][b][m][n] = (f32x4){0.f, 0.f, 0.f, 0.f};
    bf16x8 At[4][2], B0[2][2], B1[2][2];
    const char* cA = (const char*)g.A + (size_t)cur.g * g.a_goff * 2 + (size_t)cur.pm * tstepA; const char* cB = (const char*)g.Bt + (size_t)cur.g * g.b_goff * 2 + (size_t)cur.pn * tstepB;
    S.a_ready(cur);
    if constexpr (SP2) {
        PG8_STAGE(PG8_SB(0, 0), cB, voffB); PG8_STAGE(PG8_SB(0, 1), cB + hstepB, voffB); PG8_STAGE(PG8_SA(0, 0), cA, voffA); PG8_STAGE(PG8_SA(0, 1), cA + hstepA, voffA);
        if (wr == 1) PG8_BAR;
        PG8_WAIT_V(2); PG8_BAR;
        PG8_STAGE(PG8_SB(1, 0), cB + kstep, voffB); PG8_STAGE(PG8_SA(1, 0), cA + kstep, voffA); PG8_STAGE(PG8_SB(1, 1), cB + hstepB + kstep, voffB);
        PG8_WAIT_V(6); PG8_BAR;
    } else {
        PG8_STAGE(PG8_SB(0, 0), cB, voffB); PG8_STAGE(PG8_SA(0, 0), cA, voffA); PG8_STAGE(PG8_SB(0, 1), cB + hstepB, voffB); PG8_STAGE(PG8_SA(0, 1), cA + hstepA, voffA);
        if (wr == 1) PG8_BAR;
        PG8_WAIT_V(4); PG8_BAR;
        PG8_STAGE(PG8_SB(1, 0), cB + kstep, voffB); PG8_STAGE(PG8_SA(1, 0), cA + kstep, voffA); PG8_STAGE(PG8_SB(1, 1), cB + hstepB + kstep, voffB);
        PG8_WAIT_V(6); PG8_BAR;
    }
    for (;;) {
        const bool has_next = S.next(ui + 1, nxt);
        const char* nA = has_next ? (const char*)g.A + (size_t)nxt.g * g.a_goff * 2 + (size_t)nxt.pm * tstepA : cA; const char* nB = has_next ? (const char*)g.Bt + (size_t)nxt.g * g.b_goff * 2 + (size_t)nxt.pn * tstepB : cB;
        for (int t = 0; t < nt; t += 2) {
            const bool last = (t == nt - 2);
            const char* a1 = cA + (size_t)(t + 1) * kstep;
            const char* a2 = last ? nA : cA + (size_t)(t + 2) * kstep; const char* b2 = last ? nB : cB + (size_t)(t + 2) * kstep;
            const char* a3 = a2 + kstep; const char* b3 = b2 + kstep;
            if (last && has_next) S.a_ready(nxt);
            if constexpr (SP2) {
            PG8_LDB(B0, 0, 0); PG8_LDB(B1, 0, 1); PG8_SCHED; PG8_LDA(At, 0, 0); PG8_STAGE(PG8_SA(1, 1), a1 + hstepA, voffA);
            PG8_WAIT_V(8); PG8_WAIT_L(0); PG8_BAR; PG8_MMA(0, 0, At, B0); PG8_MMA(0, 1, At, B1); PG8_BAR; PG8_SCHED;
            PG8_LDA(At, 0, 1); PG8_STAGE(PG8_SB(0, 0), b2, voffB); PG8_STAGE(PG8_SB(0, 1), b2 + hstepB, voffB); PG8_STAGE(PG8_SA(0, 0), a2, voffA);
            PG8_WAIT_V(8); PG8_WAIT_L(0); PG8_BAR; PG8_MMA(1, 0, At, B0); PG8_MMA(1, 1, At, B1); PG8_BAR; PG8_SCHED;
            PG8_LDB(B0, 1, 0); PG8_LDB(B1, 1, 1); PG8_SCHED; PG8_LDA(At, 1, 0); PG8_STAGE(PG8_SA(0, 1), a2 + hstepA, voffA);
            PG8_WAIT_V(8); PG8_WAIT_L(0); PG8_BAR; PG8_MMA(0, 0, At, B0); PG8_MMA(0, 1, At, B1); PG8_BAR; PG8_SCHED;
            PG8_LDA(At, 1, 1); PG8_STAGE(PG8_SB(1, 0), b3, voffB); PG8_STAGE(PG8_SB(1, 1), b3 + hstepB, voffB); PG8_STAGE(PG8_SA(1, 0), a3, voffA);
            PG8_WAIT_V(8); PG8_WAIT_L(0); PG8_BAR; PG8_MMA(1, 0, At, B0); PG8_MMA(1, 1, At, B1); PG8_BAR; PG8_SCHED;
            } else {
            PG8_LDB(B0, 0, 0); PG8_SCHED; PG8_LDA(At, 0, 0); PG8_STAGE(PG8_SA(1, 1), a1 + hstepA, voffA);
            PG8_WAIT_L(8); PG8_BAR; PG8_WAIT_L(0); PG8_MMA(0, 0, At, B0); PG8_BAR; PG8_SCHED;
            PG8_LDB(B1, 0, 1); PG8_STAGE(PG8_SB(0, 0), b2, voffB);
            PG8_BAR; PG8_WAIT_L(0); PG8_MMA(0, 1, At, B1); PG8_BAR;
            PG8_LDA(At, 0, 1); PG8_STAGE(PG8_SA(0, 0), a2, voffA);
            PG8_BAR; PG8_WAIT_L(0); PG8_MMA(1, 0, At, B0); PG8_BAR; PG8_SCHED;
            PG8_STAGE(PG8_SB(0, 1), b2 + hstepB, voffB);
            PG8_WAIT_V(6); PG8_BAR; PG8_MMA(1, 1, At, B1); PG8_BAR;
            PG8_LDB(B0, 1, 0); PG8_SCHED; PG8_LDA(At, 1, 0); PG8_STAGE(PG8_SA(0, 1), a2 + hstepA, voffA);
            PG8_WAIT_L(8); PG8_BAR; PG8_WAIT_L(0); PG8_MMA(0, 0, At, B0); PG8_BAR; PG8_SCHED;
            PG8_LDB(B1, 1, 1); PG8_STAGE(PG8_SB(1, 0), b3, voffB);
            PG8_BAR; PG8_WAIT_L(0); PG8_MMA(0, 1, At, B1); PG8_BAR;
            PG8_LDA(At, 1, 1); PG8_STAGE(PG8_SA(1, 0), a3, voffA);
            PG8_BAR; PG8_WAIT_L(0); PG8_MMA(1, 0, At, B0); PG8_BAR; PG8_SCHED;
            PG8_STAGE(PG8_SB(1, 1), b3 + hstepB, voffB);
            PG8_WAIT_V(6); PG8_BAR; PG8_MMA(1, 1, At, B1); PG8_BAR;
            }
        }
        if constexpr (ALIGN_EPI) { if (wr == 0) PG8_BAR; }
        if constexpr (!Epi::AFTER_DRAIN) { E(acc, cur, wr, wc, fr, fq); S.done(cur); }
        if (!has_next) break;
#pragma unroll
        for (int a = 0; a < 2; ++a)
#pragma unroll
            for (int b = 0; b < 2; ++b)
#pragma unroll
                for (int m = 0; m < 4; ++m)
#pragma unroll
                    for (int n = 0; n < 2; ++n) acc[a][b][m][n] = (f32x4){0.f, 0.f, 0.f, 0.f};
        cur = nxt; cA = nA; cB = nB; ++ui;
        if constexpr (ALIGN_EPI) { if (wr == 1) PG8_BAR; }
    }
    PG8_WAIT_V(0);
    if constexpr (!ALIGN_EPI) { if (wr == 0) PG8_BAR; }
    PG8_BAR;
    if constexpr (Epi::AFTER_DRAIN) { E.fused(acc, cur, wr, wc, fr, fq, lds, wid, lane); S.done(cur); }
#undef PG8_SA
#undef PG8_SB
#undef PG8_STAGE
#undef PG8_LDA
#undef PG8_LDB
#undef PG8_MMA
#undef PG8_WAIT_V
#undef PG8_WAIT_L
#undef PG8_BAR
#undef PG8_SCHED
}
}

constexpr int DM = 4096, NBP = 4, SEQ = 2048, NBS = 16, DSEQ = 32, PAST = 1024;
constexpr int MP = NBP * SEQ, MS = NBS * DSEQ, M = MP + MS, NBT = NBP + NBS;
constexpr int WPOOL = 2048, WSSD = 6144, HD = 64, NH = 96, NS = 128, CONVD = 8192, IN_DIM = 18528, NPAD = 18688, DIN = 8192;
constexpr int C_U = 0, C_G = 2048, C_Z = 4096, C_X = 10240, C_B = C_X + 6144, C_C = C_B + 1024, C_DT = 18432;
constexpr float LN_EPS = 1e-5f, RMS_EPS = 1e-5f, ALPHA = 1.41421356237f;
constexpr size_t O_Y = 0, O_PP = 35651584, O_CP = 35897344, O_SP = 36093952, O_PS = 42385408, O_CS = 43368448, O_SS = 44154880, O_END = 69320704;
constexpr size_t MiB = 1u << 20;
constexpr size_t WS_CTL = 0, CTL_ZERO_BYTES = 1 * MiB, WS_MODF = 1 * MiB, WS_WIN = 4 * MiB, WIN_L = 146 * MiB, WS_WOUT = 296 * MiB, WOUT_L = 64 * MiB, WS_WP = 424 * MiB,
                 WS_H = 428 * MiB, WS_PROJ = 496 * MiB, WS_XBC = 1117 * MiB, WS_POOLED = 1253 * MiB, WS_DTV = 1287 * MiB, WS_YG = 1291 * MiB, WS_MIXED = 1495 * MiB,
                 WS_R = 1631 * MiB, WS_X1 = 1767 * MiB, WS_END = 1903 * MiB;
static_assert((size_t)NPAD * DM * 2 == WIN_L && (size_t)DM * DIN * 2 == WOUT_L && WS_PROJ + (size_t)M * NPAD * 4 <= WS_XBC, "ws map");
constexpr int CW_BAR = 4096;
constexpr int RING_BYTES = 131072, LDSCTL_OFF = RING_BYTES, MISC_OFF = LDSCTL_OFF + 320, LDS_BYTES = 147456;
constexpr int NWAVES = 8;
constexpr int NPHASE = 14;

#define GAS __attribute__((address_space(1)))
#define LAS __attribute__((address_space(3)))
typedef unsigned short bf16;
typedef unsigned v4u __attribute__((ext_vector_type(4)));
typedef unsigned v2u __attribute__((ext_vector_type(2)));
typedef float f32x4 __attribute__((ext_vector_type(4)));
typedef float f32x2 __attribute__((ext_vector_type(2)));
#define LDS_WAIT() asm volatile("s_waitcnt lgkmcnt(0)" ::: "memory")
#define VM_WAIT() asm volatile("s_waitcnt vmcnt(0)" ::: "memory")
__device__ __forceinline__ unsigned f2bf(float f) { unsigned u = __builtin_bit_cast(unsigned, f); return (u + 0x7fffu + ((u >> 16) & 1u)) >> 16; }
__device__ __forceinline__ unsigned pk2(float lo, float hi) { return f2bf(lo) | (f2bf(hi) << 16); }
__device__ __forceinline__ float bf2f(unsigned short b) { return __builtin_bit_cast(float, ((unsigned)b) << 16); }
__device__ __forceinline__ float silu(float x) { return x / (1.0f + __expf(-x)); }
__device__ __forceinline__ float wave_sum(float v) {
#pragma unroll
    for (int o = 1; o < 64; o <<= 1) v += __shfl_xor(v, o);
    return v;
}

#define XB_TMO      128
#define XB_XCNT(j)  (256  + 64 * (j))
#define XB_XSUB(j)  (1280 + 64 * (j))
#define XB_XGEN(j)  (2304 + 64 * (j))
#define XB_TOP      3328
#define XB_TOPGEN   3392
#define XCD_BAR_WORDS 3456
#define XB_SPIN_CAP (1u << 18)
__device__ __forceinline__ unsigned xb_ld(unsigned* p)              { return __hip_atomic_load(p, __ATOMIC_RELAXED, __HIP_MEMORY_SCOPE_AGENT); }
__device__ __forceinline__ unsigned xb_add(unsigned* p, unsigned v) { return __hip_atomic_fetch_add(p, v, __ATOMIC_RELAXED, __HIP_MEMORY_SCOPE_AGENT); }
__device__ __forceinline__ unsigned xb_xcc_id() { return (unsigned)__builtin_amdgcn_s_getreg((3 << 11) | 20) & 0xFu; }
#define XB_SPIN(cond, bar) do { unsigned _sp = 0; while (cond) { __builtin_amdgcn_s_sleep(1); \
    if ((++_sp & 255u) == 0u) { if (xb_ld(&(bar)[XB_TMO])) break; if (_sp > XB_SPIN_CAP) { atomicAdd(&(bar)[XB_TMO], 1u); break; } } } } while (0)
struct XcdBarrier { unsigned* bar; unsigned x; volatile LAS unsigned* st; };
__device__ __forceinline__ XcdBarrier xcd_barrier_post(unsigned* bar, volatile LAS unsigned* st) {
    XcdBarrier b; b.bar = bar; b.x = xb_xcc_id(); b.st = st;
    if (threadIdx.x == 0) (void)xb_add(&bar[XB_XCNT(b.x)], 1u);
    return b;
}
__device__ __forceinline__ void xcd_barrier_complete(unsigned* bar, unsigned x, unsigned& nloc, unsigned& nx) {
    const unsigned G = gridDim.x * gridDim.y * gridDim.z;
    unsigned sum, cnt, mine, sp = 0u;
    for (;;) {
        sum = 0u; cnt = 0u; mine = 0u;
#pragma unroll
        for (unsigned j = 0; j < 16; ++j) { const unsigned c = xb_ld(&bar[XB_XCNT(j)]); sum += c; cnt += (c > 0u) ? 1u : 0u; mine = (j == x) ? c : mine; }
        if (sum == G) break;
        __builtin_amdgcn_s_sleep(1);
        if ((++sp & 255u) == 0u) { if (xb_ld(&bar[XB_TMO])) break; if (sp > XB_SPIN_CAP) { atomicAdd(&bar[XB_TMO], 1u); break; } }
    }
    nloc = mine > 0u ? mine : 1u; nx = cnt > 0u ? cnt : 1u;
}
__device__ __forceinline__ void xcd_barrier(const XcdBarrier& b) {
    asm volatile("s_waitcnt vmcnt(0)" ::: "memory");
    __syncthreads();
    if (threadIdx.x == 0) {
        unsigned* bar = b.bar;
        __builtin_amdgcn_s_waitcnt(0);
        unsigned nloc = b.st[0], nx = b.st[1];
        if (nloc == 0u) { xcd_barrier_complete(bar, b.x, nloc, nx); b.st[0] = nloc; b.st[1] = nx; }
        const unsigned old = xb_add(&bar[XB_XSUB(b.x)], 1u);
        const unsigned gen = old / nloc;
        if (old + 1u == (gen + 1u) * nloc) {
            __builtin_amdgcn_fence(__ATOMIC_RELEASE, "agent");
            asm volatile("s_waitcnt vmcnt(0)" ::: "memory");
            const unsigned og = xb_add(&bar[XB_TOP], 1u);
            const unsigned tg = og / nx;
            if (og + 1u == (tg + 1u) * nx) xb_add(&bar[XB_TOPGEN], 1u);
            else XB_SPIN(xb_ld(&bar[XB_TOPGEN]) == tg, bar);
            __builtin_amdgcn_fence(__ATOMIC_ACQUIRE, "agent");
            xb_add(&bar[XB_XGEN(b.x)], 1u);
            asm volatile("s_waitcnt vmcnt(0)" ::: "memory");
        } else {
            XB_SPIN(xb_ld(&bar[XB_XGEN(b.x)]) == gen, bar);
            __builtin_amdgcn_fence(__ATOMIC_ACQUIRE, "agent");
            asm volatile("s_waitcnt vmcnt(0)" ::: "memory");
        }
    }
    __syncthreads();
}

struct Args { const float* in[21]; float* out; unsigned char* ws; int ph_lo, ph_hi; };

__device__ __forceinline__ void p0_transpose_item(const float* W, int N, bf16* WT, int ldt, LAS float* scr, int kb, int nb, int lane) {
    const int k0 = 64 * kb, n0 = 32 * nb;
#pragma unroll 8
    for (int i = 0; i < 32; ++i) { const int kk = 2 * i + (lane >> 5); scr[kk * 33 + (lane & 31)] = W[(size_t)(k0 + kk) * N + n0 + (lane & 31)]; }
    LDS_WAIT(); asm volatile("" ::: "memory");
    const int c = lane & 7;
#pragma unroll
    for (int j = 0; j < 4; ++j) { const int n = (lane >> 3) + 8 * j; const LAS float* s = scr + (8 * c) * 33 + n;
        v4u o; o.x = pk2(s[0 * 33], s[1 * 33]); o.y = pk2(s[2 * 33], s[3 * 33]); o.z = pk2(s[4 * 33], s[5 * 33]); o.w = pk2(s[6 * 33], s[7 * 33]);
        *(GAS v4u*)(WT + (size_t)(n0 + n) * ldt + k0 + 8 * c) = o; }
    LDS_WAIT(); asm volatile("" ::: "memory");
}
__device__ __forceinline__ void p0_mod_item(const Args& a, LAS unsigned char* lds, int item, int tid, int lane, int wave) {
    const int l = item >> 7, cb = item & 127, e0 = cb * 96;
    const float* W = a.in[7] + (size_t)l * DM * 3 * DM;
    const float* cp = a.in[5]; const float* cs = a.in[6];
    LAS float* sl = (LAS float*)(lds + wave * 8192);
    f32x2 acc[20];
#pragma unroll
    for (int b = 0; b < 20; ++b) acc[b] = (f32x2){0.f, 0.f};
    const bool act = lane < 48;
    for (int ch = 0; ch < 8; ++ch) {
        const int d0 = wave * 512 + ch * 64;
#pragma unroll
        for (int b = 0; b < 20; ++b) { const float c = b < 4 ? cp[b * DM + d0 + lane] : cs[(b - 4) * DM + d0 + lane]; sl[lane * 20 + b] = c / (1.0f + expf(-c)); }
        LDS_WAIT(); asm volatile("" ::: "memory");
        for (int r = 0; r < 64; r += 8) {
            f32x2 wv[8];
#pragma unroll
            for (int j = 0; j < 8; ++j) wv[j] = act ? *(const f32x2*)(W + (size_t)(d0 + r + j) * (3 * DM) + e0 + 2 * lane) : (f32x2){0.f, 0.f};
#pragma unroll
            for (int j = 0; j < 8; ++j) { const LAS f32x4* sp = (const LAS f32x4*)(sl + (r + j) * 20);
#pragma unroll
                for (int q = 0; q < 5; ++q) { const f32x4 s4 = sp[q];
#pragma unroll
                    for (int c = 0; c < 4; ++c) acc[q * 4 + c] += wv[j] * s4[c]; } }
        }
        LDS_WAIT(); asm volatile("" ::: "memory");
    }
    LAS float* red = (LAS float*)(lds + 65536 + wave * 7680);
    if (act) {
#pragma unroll
        for (int b = 0; b < 20; ++b) *(LAS f32x2*)(red + b * 96 + 2 * lane) = acc[b]; }
    __syncthreads();
    float* modf = (float*)(a.ws + WS_MODF);
    for (int idx = tid; idx < 20 * 96; idx += NWAVES * 64) { float s = 0.f;
#pragma unroll
        for (int w = 0; w < 8; ++w) s += ((LAS float*)(lds + 65536 + w * 7680))[idx];
        const int b = idx / 96, e = idx % 96; modf[(size_t)(l * 20 + b) * (3 * DM) + e0 + e] = s + a.in[8][(size_t)l * 3 * DM + e0 + e]; }
    __syncthreads();
}
__device__ __forceinline__ void p0_prologue(const Args& a, LAS unsigned char* lds, int G, int bid, int tid, int lane, int wave) {
    for (int it = bid; it < 256; it += G) p0_mod_item(a, lds, it, tid, lane, wave);
    LAS float* scr = (LAS float*)(lds + wave * 16384);
    const int gw = bid * NWAVES + wave, NGW = G * NWAVES;
    constexpr int I_IN = 64 * 579, I_OUT = 128 * 128, I_P = 8 * 16;
    constexpr int NITEMS = 2 * I_IN + 2 * I_OUT + 8 * I_P;
    for (int it = gw; it < NITEMS; it += NGW) {
        int r = it;
        if (r < 2 * I_IN) { const int l = r / I_IN; r -= l * I_IN; p0_transpose_item(a.in[9] + (size_t)l * DM * IN_DIM, IN_DIM, (bf16*)(a.ws + WS_WIN + l * WIN_L), DM, scr, r / 579, r % 579, lane); continue; } r -= 2 * I_IN;
        if (r < 2 * I_OUT) { const int l = r / I_OUT; r -= l * I_OUT; p0_transpose_item(a.in[18] + (size_t)l * DIN * DM, DM, (bf16*)(a.ws + WS_WOUT + l * WOUT_L), DIN, scr, r / 128, r % 128, lane); continue; } r -= 2 * I_OUT;
        { const int lg = r / I_P; r -= lg * I_P; p0_transpose_item(a.in[10] + (size_t)lg * 512 * 512, 512, (bf16*)(a.ws + WS_WP) + (size_t)lg * 512 * 512, 512, scr, r / 16, r % 16, lane); }
    }
    for (int i = bid * NWAVES * 64 + tid; i < 2 * (NPAD - IN_DIM) * (DM / 8); i += G * NWAVES * 64) { const int l = i / ((NPAD - IN_DIM) * (DM / 8)), r = i % ((NPAD - IN_DIM) * (DM / 8));
        *(GAS v4u*)((bf16*)(a.ws + WS_WIN + l * WIN_L) + (size_t)IN_DIM * DM + (size_t)r * 8) = (v4u){0u, 0u, 0u, 0u}; }
}

__device__ __forceinline__ void row_stats(const f32x4 (&v)[16], float& mean, float& rstd) {
    float s = 0.f;
#pragma unroll
    for (int j = 0; j < 16; ++j) s += (v[j].x + v[j].y) + (v[j].z + v[j].w);
    mean = wave_sum(s) * (1.f / DM); float q = 0.f;
#pragma unroll
    for (int j = 0; j < 16; ++j) { const f32x4 d = v[j] - mean; q += (d.x * d.x + d.y * d.y) + (d.z * d.z + d.w * d.w); }
    rstd = 1.f / sqrtf(wave_sum(q) * (1.f / DM) + LN_EPS);
}
__device__ __forceinline__ int batch_of(int m) { return m < MP ? (m >> 11) : NBP + ((m - MP) >> 5); }
__device__ __forceinline__ void mod_row_to_bf16(const f32x4 (&v)[16], const float* md, bf16* hrow, int lane) {
    float mean, rstd; row_stats(v, mean, rstd);
#pragma unroll
    for (int j = 0; j < 16; ++j) { const f32x4 sh = ((const f32x4*)md)[lane + 64 * j], sc = ((const f32x4*)(md + DM))[lane + 64 * j];
        const f32x4 o = (v[j] - mean) * rstd * (sc + 1.0f) + sh;
        ((GAS v2u*)hrow)[lane + 64 * j] = (v2u){pk2(o.x, o.y), pk2(o.z, o.w)}; }
}
__device__ __forceinline__ void phase_a(const Args& a, int G, int bid, int lane, int wave) {
    const int gw = bid * NWAVES + wave, NGW = G * NWAVES;
    const float* modf = (const float*)(a.ws + WS_MODF); bf16* H = (bf16*)(a.ws + WS_H);
    for (int m = gw; m < M; m += NGW) {
        const float* xr = m < MP ? a.in[0] + (size_t)m * DM : a.in[1] + (size_t)(m - MP) * DM;
        f32x4 v[16];
#pragma unroll
        for (int j = 0; j < 16; ++j) v[j] = ((const f32x4*)xr)[lane + 64 * j];
        mod_row_to_bf16(v, modf + (size_t)batch_of(m) * 3 * DM, H + (size_t)m * DM, lane);
    }
}
__device__ __forceinline__ void phase_g(const Args& a, int l, int G, int bid, int lane, int wave) {
    const int gw = bid * NWAVES + wave, NGW = G * NWAVES;
    const float* modf = (const float*)(a.ws + WS_MODF); bf16* H = (bf16*)(a.ws + WS_H);
    const float* R = (const float*)(a.ws + WS_R); float* xo = l == 0 ? (float*)(a.ws + WS_X1) : a.out + O_Y;
    const float* lg = a.in[19] + (size_t)l * DM; const float* lb = a.in[20] + (size_t)l * DM;
    for (int m = gw; m < M; m += NGW) {
        f32x4 v[16];
#pragma unroll
        for (int j = 0; j < 16; ++j) v[j] = ((const f32x4*)(R + (size_t)m * DM))[lane + 64 * j];
        float mean, rstd; row_stats(v, mean, rstd);
#pragma unroll
        for (int j = 0; j < 16; ++j) { v[j] = (v[j] - mean) * rstd * ((const f32x4*)lg)[lane + 64 * j] + ((const f32x4*)lb)[lane + 64 * j];
            ((GAS f32x4*)(xo + (size_t)m * DM))[lane + 64 * j] = v[j]; }
        if (l == 0) mod_row_to_bf16(v, modf + (size_t)(NBT + batch_of(m)) * 3 * DM, H + (size_t)m * DM, lane);
    }
}
__device__ __forceinline__ f32x4 pool_hist(const float* pc, const float* st, bool samp, int t) {
    if (t >= 0) return *(const f32x4*)(pc + (size_t)t * NPAD);
    if (samp) return *(const f32x4*)(st + (size_t)(15 + t) * WPOOL);
    return (f32x4){0.f, 0.f, 0.f, 0.f};
}
__device__ __forceinline__ void phase_c(const Args& a, int l, int G, int bid, int tid) {
    const float* proj = (const float*)(a.ws + WS_PROJ);
    for (int it = bid; it < 272 * 5; it += G) {
        const int seg = it / 5, cblk = it % 5, m0 = seg * 32;
        const bool samp = m0 >= MP; const int b = samp ? (m0 - MP) >> 5 : m0 >> 11, t0 = samp ? 0 : (m0 & 2047), L = samp ? DSEQ : SEQ;
        if (cblk == 0) {
            const int j0 = 4 * tid, w = 2 << (j0 >> 9);
            const float* pc = proj + (size_t)(m0 - t0) * NPAD + C_U + j0;
            const float* st = a.in[2] + (size_t)(l * NBS + b) * 15 * WPOOL + j0;
            bf16* po = (bf16*)(a.ws + WS_POOLED) + (size_t)m0 * WPOOL + j0;
            float* no = a.out + (samp ? O_PS : O_PP) + (size_t)(l * (samp ? NBS : NBP) + b) * 15 * WPOOL + j0;
            f32x4 S = (f32x4){0.f, 0.f, 0.f, 0.f};
            for (int i = 1; i < w; ++i) S += pool_hist(pc, st, samp, t0 - i);
            for (int r = 0; r < 32; ++r) { const int t = t0 + r; const f32x4 u = pool_hist(pc, st, samp, t); S += u;
                const int pos = (samp ? PAST : 0) + t; const float cnt = (float)(pos + 1 < w ? pos + 1 : w);
                const f32x4 p = S / cnt - u;
                *(GAS v2u*)(po + (size_t)r * WPOOL) = (v2u){pk2(p.x, p.y), pk2(p.z, p.w)};
                S -= pool_hist(pc, st, samp, t - w + 1);
                if (t >= L - 15) *(GAS f32x4*)(no + (size_t)(t - (L - 15)) * WPOOL) = u; }
        } else {
            const int j0 = (cblk - 1) * 2048 + 4 * tid;
            const float* cw = a.in[12] + (size_t)l * 4 * CONVD + j0;
            const f32x4 w0 = *(const f32x4*)cw, w1 = *(const f32x4*)(cw + CONVD), w2 = *(const f32x4*)(cw + 2 * CONVD), w3 = *(const f32x4*)(cw + 3 * CONVD), bs = *(const f32x4*)(a.in[13] + (size_t)l * CONVD + j0);
            const float* pc = proj + (size_t)m0 * NPAD + C_X + j0;
            f32x4 p3 = (f32x4){0.f, 0.f, 0.f, 0.f}, p2 = p3, p1 = p3;
            if (samp) { const float* st = a.in[3] + (size_t)(l * NBS + b) * 3 * CONVD + j0; p3 = *(const f32x4*)st; p2 = *(const f32x4*)(st + CONVD); p1 = *(const f32x4*)(st + 2 * CONVD); }
            else if (t0 != 0) { p3 = *(const f32x4*)(pc - 3 * (size_t)NPAD); p2 = *(const f32x4*)(pc - 2 * (size_t)NPAD); p1 = *(const f32x4*)(pc - (size_t)NPAD); }
            bf16* xo = (bf16*)(a.ws + WS_XBC) + (size_t)m0 * CONVD + j0;
            float* no = a.out + (samp ? O_CS : O_CP) + (size_t)(l * (samp ? NBS : NBP) + b) * 3 * CONVD + j0;
            for (int r = 0; r < 32; ++r) { const f32x4 cur = *(const f32x4*)(pc + (size_t)r * NPAD);
                f32x4 o = w0 * p3 + w1 * p2 + w2 * p1 + w3 * cur + bs;
                o.x = silu(o.x); o.y = silu(o.y); o.z = silu(o.z); o.w = silu(o.w);
                *(GAS v2u*)(xo + (size_t)r * CONVD) = (v2u){pk2(o.x, o.y), pk2(o.z, o.w)};
                const int t = t0 + r; if (t >= L - 3) *(GAS f32x4*)(no + (size_t)(t - (L - 3)) * CONVD) = cur;
                p3 = p2; p2 = p1; p1 = cur; }
        }
    }
    float* dtv = (float*)(a.ws + WS_DTV);
    for (int i = bid * NWAVES * 64 + tid; i < M * NH; i += G * NWAVES * 64) { const int m = i / NH, h = i % NH;
        const float x = proj[(size_t)m * NPAD + C_DT + h] + a.in[14][l * NH + h];
        dtv[i] = fmaxf(x, 0.f) + log1pf(expf(-fabsf(x))); }
}
__device__ __forceinline__ void ssd_naive_unit(const Args& a, LAS unsigned char* lds, int l, int unit, int tid) {
    const bool samp = unit >= NBP * NH; const int u2 = samp ? unit - NBP * NH : unit; const int b = u2 / NH, h = u2 % NH, g = h / 12;
    const int T = samp ? DSEQ : SEQ, mbase = samp ? MP + b * DSEQ : b * SEQ;
    const int p = tid >> 3, nq = tid & 7;
    float hs[16];
    if (samp) { const float* s0 = a.in[4] + ((size_t)((l * NBS + b) * NH + h) * HD + p) * NS + nq * 16;
#pragma unroll
        for (int i = 0; i < 4; ++i) { const f32x4 t4 = ((const f32x4*)s0)[i]; hs[4 * i] = t4.x; hs[4 * i + 1] = t4.y; hs[4 * i + 2] = t4.z; hs[4 * i + 3] = t4.w; } }
    else {
#pragma unroll
        for (int i = 0; i < 16; ++i) hs[i] = 0.f; }
    const float A = -expf(a.in[15][l * NH + h]), Dk = a.in[16][l * NH + h];
    LAS float* xs = (LAS float*)lds; LAS float* Bs = (LAS float*)(lds + 16384); LAS float* Cs = (LAS float*)(lds + 49152); LAS float* zs = (LAS float*)(lds + 81920);
    LAS float* ys = (LAS float*)(lds + 98304); LAS float* dts = (LAS float*)(lds + 114688);
    const bf16* xbc = (const bf16*)(a.ws + WS_XBC); const float* proj = (const float*)(a.ws + WS_PROJ); const float* dtv = (const float*)(a.ws + WS_DTV); float* yg = (float*)(a.ws + WS_YG);
    for (int c0 = 0; c0 < T; c0 += 64) {
        const int CL = (T - c0) < 64 ? (T - c0) : 64;
        __syncthreads();
        { const int t = tid >> 3, c8 = (tid & 7) * 8;
          if (t < CL) { const v4u q = *(const v4u*)(xbc + (size_t)(mbase + c0 + t) * CONVD + h * HD + c8); LAS float* d = xs + t * 64 + c8;
              d[0] = bf2f(q.x & 0xffff); d[1] = bf2f(q.x >> 16); d[2] = bf2f(q.y & 0xffff); d[3] = bf2f(q.y >> 16); d[4] = bf2f(q.z & 0xffff); d[5] = bf2f(q.z >> 16); d[6] = bf2f(q.w & 0xffff); d[7] = bf2f(q.w >> 16); } }
#pragma unroll
        for (int ps = 0; ps < 2; ++ps) { const int t = (tid >> 4) + 32 * ps, c8 = (tid & 15) * 8;
          if (t < CL) { const bf16* rp = xbc + (size_t)(mbase + c0 + t) * CONVD + WSSD + g * NS + c8; const v4u qb = *(const v4u*)rp, qc = *(const v4u*)(rp + 1024);
              LAS float* d = Bs + t * 128 + c8; LAS float* e = Cs + t * 128 + c8;
              d[0] = bf2f(qb.x & 0xffff); d[1] = bf2f(qb.x >> 16); d[2] = bf2f(qb.y & 0xffff); d[3] = bf2f(qb.y >> 16); d[4] = bf2f(qb.z & 0xffff); d[5] = bf2f(qb.z >> 16); d[6] = bf2f(qb.w & 0xffff); d[7] = bf2f(qb.w >> 16);
              e[0] = bf2f(qc.x & 0xffff); e[1] = bf2f(qc.x >> 16); e[2] = bf2f(qc.y & 0xffff); e[3] = bf2f(qc.y >> 16); e[4] = bf2f(qc.z & 0xffff); e[5] = bf2f(qc.z >> 16); e[6] = bf2f(qc.w & 0xffff); e[7] = bf2f(qc.w >> 16); } }
#pragma unroll
        for (int ps = 0; ps < 2; ++ps) { const int t = (tid >> 4) + 32 * ps, c4 = (tid & 15) * 4;
          if (t < CL) *(LAS f32x4*)(zs + t * 64 + c4) = *(const f32x4*)(proj + (size_t)(mbase + c0 + t) * NPAD + C_Z + h * HD + c4); }
        if (tid < CL) dts[tid] = dtv[(size_t)(mbase + c0 + tid) * NH + h];
        __syncthreads();
        for (int t = 0; t < CL; ++t) {
            const float dt = dts[t], dA = __expf(dt * A), xv = xs[t * 64 + p], xdt = dt * xv;
            float yp = 0.f;
#pragma unroll
            for (int i4 = 0; i4 < 4; ++i4) { const f32x4 bv = *(const LAS f32x4*)(Bs + t * 128 + nq * 16 + 4 * i4), cv = *(const LAS f32x4*)(Cs + t * 128 + nq * 16 + 4 * i4);
#pragma unroll
                for (int k = 0; k < 4; ++k) { hs[4 * i4 + k] = dA * hs[4 * i4 + k] + xdt * bv[k]; yp += cv[k] * hs[4 * i4 + k]; } }
            yp += __shfl_xor(yp, 1); yp += __shfl_xor(yp, 2); yp += __shfl_xor(yp, 4);
            if (nq == 0) ys[t * 64 + p] = (yp + Dk * xv) * silu(zs[t * 64 + p]);
        }
        __syncthreads();
#pragma unroll
        for (int ps = 0; ps < 2; ++ps) { const int t = (tid >> 4) + 32 * ps, c4 = (tid & 15) * 4;
          if (t < CL) *(GAS f32x4*)(yg + (size_t)(mbase + c0 + t) * WSSD + h * HD + c4) = *(const LAS f32x4*)(ys + t * 64 + c4); }
    }
    float* so = a.out + (samp ? O_SS : O_SP) + ((size_t)((l * (samp ? NBS : NBP) + b) * NH + h) * HD + p) * NS + nq * 16;
#pragma unroll
    for (int i = 0; i < 4; ++i) ((GAS f32x4*)so)[i] = (f32x4){hs[4 * i], hs[4 * i + 1], hs[4 * i + 2], hs[4 * i + 3]};
    __syncthreads();
}
__device__ __forceinline__ void phase_e(const Args& a, int l, int G, int bid, int lane, int wave) {
    const int gw = bid * NWAVES + wave, NGW = G * NWAVES;
    const float* yg = (const float*)(a.ws + WS_YG); bf16* mx = (bf16*)(a.ws + WS_MIXED);
    for (int it = gw; it < M * 8; it += NGW) { const int m = it >> 3, g = it & 7;
        const f32x4* yr = (const f32x4*)(yg + (size_t)m * WSSD + g * 768); f32x4 v[3]; float ss = 0.f;
#pragma unroll
        for (int j = 0; j < 3; ++j) { v[j] = yr[lane + 64 * j]; ss += (v[j].x * v[j].x + v[j].y * v[j].y) + (v[j].z * v[j].z + v[j].w * v[j].w); }
        const float rstd = 1.f / sqrtf(wave_sum(ss) * (1.f / 768.f) + RMS_EPS);
        const f32x4* nw = (const f32x4*)(a.in[17] + (size_t)l * WSSD + g * 768);
#pragma unroll
        for (int j = 0; j < 3; ++j) { const f32x4 o = v[j] * rstd * nw[lane + 64 * j];
            ((GAS v2u*)(mx + (size_t)m * DIN + WPOOL + g * 768))[lane + 64 * j] = (v2u){pk2(o.x, o.y), pk2(o.z, o.w)}; }
    }
}

__global__ void __launch_bounds__(NWAVES * 64, 2) trunk_fwd(Args args) {
    extern __shared__ __attribute__((aligned(16))) unsigned char lds_raw[];
    LAS unsigned char* lds = (LAS unsigned char*)lds_raw;
    volatile LAS unsigned* MISC = (volatile LAS unsigned*)(lds + MISC_OFF);
    const int tid = threadIdx.x, lane = tid & 63, wave = __builtin_amdgcn_readfirstlane(tid >> 6);
    const int G = gridDim.x, bid = blockIdx.x;
    unsigned* ctl = (unsigned*)(args.ws + WS_CTL);
    for (int u = tid; u < (LDS_BYTES - LDSCTL_OFF) / 4; u += NWAVES * 64) ((LAS unsigned*)(lds + LDSCTL_OFF))[u] = 0u;
    __syncthreads();
    const int lo = args.ph_lo, hi = args.ph_hi;
    XcdBarrier bar; bar.bar = ctl + CW_BAR; bar.x = 0; bar.st = MISC + 8;
    if (hi - lo > 1) bar = xcd_barrier_post(ctl + CW_BAR, MISC + 8);
#define IN(k) (lo <= (k) && (k) < hi)
#define BOTH(k) (IN(k) && IN((k) + 1))
#define SEAM(k) do { if (BOTH(k)) xcd_barrier(bar); } while (0)

    if (IN(0)) { p0_prologue(args, lds, G, bid, tid, lane, wave); SEAM(0); }
    if (IN(1)) { phase_a(args, G, bid, lane, wave); SEAM(1); }
    for (int l = 0; l < 2; ++l) {
        const int pb = 2 + 6 * l;
        int tl = threadIdx.x; asm volatile("" : "+v"(tl));
        const int lanel = tl & 63, wavel = __builtin_amdgcn_readfirstlane(tl >> 6);
        if (IN(pb)) {
            pg8::Gemm g{(const pg8::bf16_t*)(args.ws + WS_H), (const pg8::bf16_t*)(args.ws + WS_WIN + (size_t)l * WIN_L), M, NPAD, DM, DM, DM, 0, 0};
            pg8::StaticOrder S; S.init(M, NPAD, G, bid);
            pg8::EpiF32 E{(float*)(args.ws + WS_PROJ), NPAD};
            pg8::gemm_phase<pg8::EpiF32, pg8::StaticOrder, true, true>(lds, g, S, E, tl);
            SEAM(pb);
        }
        if (IN(pb + 1)) { phase_c(args, l, G, bid, tl); SEAM(pb + 1); }
        if (IN(pb + 2)) {
            { pg8::Gemm g{(const pg8::bf16_t*)(args.ws + WS_POOLED), (const pg8::bf16_t*)(args.ws + WS_WP) + (size_t)l * 4 * 512 * 512, M, 512, 512, WPOOL, 512, 512, (size_t)512 * 512};
              pg8::GroupOrder S; S.init(M, 512, 4, G, bid);
              pg8::EpiPool E{(pg8::bf16_t*)(args.ws + WS_MIXED), DIN, (const float*)(args.ws + WS_PROJ) + C_G, NPAD, args.in[11] + (size_t)l * WPOOL};
              pg8::gemm_phase<pg8::EpiPool, pg8::GroupOrder, true, true>(lds, g, S, E, tl); }
            __syncthreads();
            for (int u = bid; u < (NBP + NBS) * NH; u += G) ssd_naive_unit(args, lds, l, u, tl);
            SEAM(pb + 2);
        }
        if (IN(pb + 3)) { phase_e(args, l, G, bid, lanel, wavel); SEAM(pb + 3); }
        if (IN(pb + 4)) {
            pg8::Gemm g{(const pg8::bf16_t*)(args.ws + WS_MIXED), (const pg8::bf16_t*)(args.ws + WS_WOUT + (size_t)l * WOUT_L), M, DM, DIN, DIN, DIN, 0, 0};
            pg8::StaticOrder S; S.init(M, DM, G, bid);
            const float* xp = l == 0 ? args.in[0] : (const float*)(args.ws + WS_X1); const float* xs = l == 0 ? args.in[1] : (const float*)(args.ws + WS_X1) + (size_t)MP * DM;
            pg8::EpiResid E{(float*)(args.ws + WS_R), DM, xp, xs, (const float*)(args.ws + WS_MODF) + (size_t)l * NBT * 3 * DM + 2 * DM, 3 * DM, ALPHA};
            pg8::gemm_phase<pg8::EpiResid, pg8::StaticOrder, true, true>(lds, g, S, E, tl);
            SEAM(pb + 4);
        }
        if (IN(pb + 5)) { phase_g(args, l, G, bid, lanel, wavel); if (pb + 5 < NPHASE - 1) SEAM(pb + 5); }
    }
#undef IN
#undef BOTH
#undef SEAM
}

#ifndef MK_SPLIT
#define MK_SPLIT 0
#endif
extern "C" void kernel_launch(void* const* d_in, const int* in_sizes, int n_in, void* d_out, int out_size, void* d_ws, size_t ws_size, hipStream_t stream) {
    static int grid = 0;
    if (grid == 0) {
        if (n_in != 21 || (size_t)out_size != O_END || ws_size < WS_END) { fprintf(stderr, "kernel_launch: unexpected shapes: n_in %d out %d ws %zu; nothing launched\n", n_in, out_size, ws_size); grid = -1; return; }
        int dev = 0, cus = 0, per_cu = 0;
        if (hipGetDevice(&dev) != hipSuccess || hipDeviceGetAttribute(&cus, hipDeviceAttributeMultiprocessorCount, dev) != hipSuccess) { grid = -1; return; }
        if (hipFuncSetAttribute((const void*)trunk_fwd, hipFuncAttributeMaxDynamicSharedMemorySize, LDS_BYTES) != hipSuccess) { fprintf(stderr, "kernel_launch: hipFuncSetAttribute failed\n"); grid = -1; return; }
        if (hipOccupancyMaxActiveBlocksPerMultiprocessor(&per_cu, (const void*)trunk_fwd, NWAVES * 64, LDS_BYTES) != hipSuccess || per_cu < 1) { fprintf(stderr, "kernel_launch: occupancy query says %d blocks per CU\n", per_cu); (void)hipGetLastError(); grid = -1; return; }
        grid = cus;
    }
    if (grid < 0) return;
    if (hipMemsetAsync((char*)d_ws + WS_CTL, 0, CTL_ZERO_BYTES, stream) != hipSuccess) return;
    Args a{};
    for (int i = 0; i < 21; ++i) a.in[i] = (const float*)d_in[i];
    a.out = (float*)d_out; a.ws = (unsigned char*)d_ws;
#if MK_SPLIT
    for (int ph = 0; ph < NPHASE; ++ph) { a.ph_lo = ph; a.ph_hi = ph + 1; hipLaunchKernelGGL(trunk_fwd, dim3(grid), dim3(NWAVES * 64), LDS_BYTES, stream, a); }
#else
    a.ph_lo = 0; a.ph_hi = NPHASE; hipLaunchKernelGGL(trunk_fwd, dim3(grid), dim3(NWAVES * 64), LDS_BYTES, stream, a);
#endif
}
```

```cpp
#include <hip/hip_runtime.h>
#include <cstdio>
#include <cstdint>
namespace pg8 {
#define PG8_LAS __attribute__((address_space(3)))
typedef unsigned short bf16_t;
typedef short bf16x8 __attribute__((ext_vector_type(8)));
typedef float f32x4 __attribute__((ext_vector_type(4)));
typedef unsigned u32x4 __attribute__((ext_vector_type(4)));
constexpr int BM = 256, BK = 64, HALF = 128, HTB = HALF * BK * 2  , STAGE_BYTES = 8 * HTB, NXCD = 8, WGM = 8;

__host__ __device__ __forceinline__ int lds_byte(int r, int c) { const int st = (r >> 4) * 2 + (c >> 5), rr = r & 15, cc = c & 31, ob = rr * 64 + cc * 2; return st * 1024 + (ob ^ (((ob >> 9) & 1) << 5)); }
__host__ __device__ __forceinline__ void stage_rc(int b, int& R, int& C) { const int st = b / 1024, sb = b % 1024, swz = sb ^ (((sb >> 9) & 1) << 5); R = (st >> 1) * 16 + swz / 64; C = (st & 1) * 32 + (swz % 64) / 2; }
__host__ __device__ __forceinline__ int perm32(int rho) { const int n = rho >> 4, i = rho & 15; return 8 * (i >> 2) + 4 * n + (i & 3); }

struct Unit { int pm, pn, g; };
struct Gemm { const bf16_t* A; const bf16_t* Bt; int M, N, K, lda, ldb; size_t a_goff, b_goff; };

struct StaticOrder {
    int nM, nN, nwg, G, c;
    __host__ __device__ void init(int M, int N, int G_, int c_) { nM = M / BM; nN = N / BM; nwg = nM * nN; G = G_; c = c_; }
    __host__ __device__ bool next(int i, Unit& u) const {
        const long L = (long)i * G + c; if (L >= nwg) return false;
        int wgid = (int)L; { const int q = nwg / NXCD, r = nwg % NXCD, xcd = wgid % NXCD, off = wgid / NXCD; wgid = (xcd < r ? xcd * (q + 1) : r * (q + 1) + (xcd - r) * q) + off; }
        const int nig = WGM * nN, gid = wgid / nig, fm = gid * WGM, gsz = (nM - fm) < WGM ? (nM - fm) : WGM;
        u.pm = fm + ((wgid % nig) % gsz); u.pn = (wgid % nig) / gsz; u.g = 0; return true;
    }
    __device__ __forceinline__ void a_ready(const Unit&) const {}
    __device__ __forceinline__ void done(const Unit&) const {}
};
struct GroupOrder {
    int nM, nN, ng, G, c;
    __host__ __device__ void init(int M, int N, int ng_, int G_, int c_) { nM = M / BM; nN = N / BM; ng = ng_; G = G_; c = c_; }
    __host__ __device__ bool next(int i, Unit& u) const {
        const long L = (long)i * G + c; if (L >= (long)nM * nN * ng) return false;
        const int per = nM * nN, l = (int)L; u.g = l / per; const int r = l % per; u.pm = r % nM; u.pn = r / nM; return true;
    }
    __device__ __forceinline__ void a_ready(const Unit&) const {}
    __device__ __forceinline__ void done(const Unit&) const {}
};

__device__ __forceinline__ unsigned cvt_pk_bf16(float lo, float hi) { unsigned r; asm volatile("v_cvt_pk_bf16_f32 %0, %1, %2" : "=v"(r) : "v"(lo), "v"(hi)); return r; }
__device__ __forceinline__ float silu_f(float x) { return x * __builtin_amdgcn_rcpf(1.0f + __expf(-x)); }

struct EpiF32 {
    static constexpr bool PERM = false, AFTER_DRAIN = false;
    float* C; int ldc;
    __device__ __forceinline__ void operator()(const f32x4 (&acc)[2][2][4][2], const Unit& u, int wr, int wc, int fr, int fq) const {
        const int row0 = u.pm * BM + wr * 64 + fr, col0 = u.pn * BM + wc * 32 + 4 * fq;
#pragma unroll
        for (int ai = 0; ai < 2; ++ai)
#pragma unroll
            for (int m = 0; m < 4; ++m) { float* rowp = C + (size_t)(row0 + ai * HALF + m * 16) * ldc + col0;
#pragma unroll
                for (int bj = 0; bj < 2; ++bj)
#pragma unroll
                    for (int n = 0; n < 2; ++n) *(f32x4*)(rowp + bj * HALF + n * 16) = acc[ai][bj][m][n]; }
    }
};
struct EpiPool {
    static constexpr bool PERM = true, AFTER_DRAIN = false;
    bf16_t* O; int ldo; const float* gp; int ldp; const float* pscale;
    __device__ __forceinline__ void operator()(const f32x4 (&acc)[2][2][4][2], const Unit& u, int wr, int wc, int fr, int fq) const {
        const int row0 = u.pm * BM + wr * 64 + fr, col0 = u.g * 512 + u.pn * BM + wc * 32 + 8 * fq;
        f32x4 ps[2][2];
#pragma unroll
        for (int bj = 0; bj < 2; ++bj)
#pragma unroll
            for (int n = 0; n < 2; ++n) ps[bj][n] = *(const f32x4*)(pscale + col0 + bj * HALF + 4 * n);
#pragma unroll
        for (int ai = 0; ai < 2; ++ai)
#pragma unroll
            for (int m = 0; m < 4; ++m) { const size_t row = (size_t)(row0 + ai * HALF + m * 16);
#pragma unroll
                for (int bj = 0; bj < 2; ++bj) { const int c = col0 + bj * HALF;
                    const f32x4 g0 = *(const f32x4*)(gp + row * ldp + c), g1 = *(const f32x4*)(gp + row * ldp + c + 4);
                    f32x4 v0 = acc[ai][bj][m][0] * ps[bj][0], v1 = acc[ai][bj][m][1] * ps[bj][1];
#pragma unroll
                    for (int j = 0; j < 4; ++j) { v0[j] *= silu_f(g0[j]); v1[j] *= silu_f(g1[j]); }
                    u32x4 w; w.x = cvt_pk_bf16(v0[0], v0[1]); w.y = cvt_pk_bf16(v0[2], v0[3]); w.z = cvt_pk_bf16(v1[0], v1[1]); w.w = cvt_pk_bf16(v1[2], v1[3]);
                    *(u32x4*)(O + row * ldo + c) = w; } }
    }
};
struct EpiResid {
    static constexpr bool PERM = false, AFTER_DRAIN = false;
    float* R; int ldr; const float* xp; const float* xs; const float* gate; int ldg; float alpha;
    __device__ __forceinline__ void operator()(const f32x4 (&acc)[2][2][4][2], const Unit& u, int wr, int wc, int fr, int fq) const {
        const int row0 = u.pm * BM + wr * 64 + fr, col0 = u.pn * BM + wc * 32 + 4 * fq;
#pragma unroll
        for (int ai = 0; ai < 2; ++ai)
#pragma unroll
            for (int m = 0; m < 4; ++m) { const int row = row0 + ai * HALF + m * 16;
                const int b = row < 8192 ? (row >> 11) : 4 + ((row - 8192) >> 5);
                const float* xr = row < 8192 ? xp + (size_t)row * 4096 : xs + (size_t)(row - 8192) * 4096;
                const float* gr = gate + (size_t)b * ldg; float* rr = R + (size_t)row * ldr;
#pragma unroll
                for (int bj = 0; bj < 2; ++bj)
#pragma unroll
                    for (int n = 0; n < 2; ++n) { const int c = col0 + bj * HALF + n * 16;
                        const f32x4 xv = *(const f32x4*)(xr + c), gv = *(const f32x4*)(gr + c);
                        *(f32x4*)(rr + c) = xv * alpha + gv * acc[ai][bj][m][n]; } }
    }
};

template <class Epi, class Sched, bool ALIGN_EPI = false, bool SP2 = false>
__device__ __forceinline__ void gemm_phase(PG8_LAS unsigned char* lds, const Gemm g, const Sched& S, const Epi& E, const int tid) {
    const int wid = __builtin_amdgcn_readfirstlane(tid >> 6), lane = tid & 63, wr = wid >> 2, wc = wid & 3, fr = lane & 15, fq = lane >> 4;
    const int K = g.K, nt = K / BK;
    unsigned voffA[2], voffB[2];
#pragma unroll
    for (int i = 0; i < 2; ++i) { int R, C; stage_rc(tid * 16 + i * 8192, R, C); const int Rb = Epi::PERM ? ((R & ~31) + perm32(R & 31)) : R;
        voffA[i] = (unsigned)(R * g.lda + C) * 2u; voffB[i] = (unsigned)(Rb * g.ldb + C) * 2u; }
    const size_t kstep = (size_t)(BK * 2);
    const size_t hstepA = (size_t)HALF * g.lda * 2, hstepB = (size_t)HALF * g.ldb * 2;
    const size_t tstepA = 2 * hstepA, tstepB = 2 * hstepB;
    const unsigned ldsw = (unsigned)wid * 1024u;
    const int aoff = lds_byte(wr * 64 + fr, fq * 8), boff = lds_byte(wc * 32 + fr, fq * 8);
#define PG8_SA(b, h) (((b) * 2 + (h)) * HTB)
#define PG8_SB(b, h) ((4 + (b) * 2 + (h)) * HTB)
#define PG8_STAGE(bufoff, gbase, voff) do { _Pragma("unroll") for (int _i = 0; _i < 2; ++_i) \
        __builtin_amdgcn_global_load_lds((const unsigned*)((const char*)(gbase) + (voff)[_i]), (PG8_LAS unsigned*)(lds + (bufoff) + ldsw + _i * 8192), 16, 0, 0); } while (0)
#define PG8_LDA(dst, b, h) do { _Pragma("unroll") for (int m = 0; m < 4; ++m) _Pragma("unroll") for (int k = 0; k < 2; ++k) dst[m][k] = *(const PG8_LAS bf16x8*)(lds + PG8_SA(b, h) + aoff + m * 2048 + k * 1024); } while (0)
#define PG8_LDB(dst, b, h) do { _Pragma("unroll") for (int n = 0; n < 2; ++n) _Pragma("unroll") for (int k = 0; k < 2; ++k) dst[n][k] = *(const PG8_LAS bf16x8*)(lds + PG8_SB(b, h) + boff + n * 2048 + k * 1024); } while (0)
#define PG8_MMA(ai, bj, At, Bt) do { __builtin_amdgcn_s_setprio(1); _Pragma("unroll") for (int m = 0; m < 4; ++m) _Pragma("unroll") for (int n = 0; n < 2; ++n) _Pragma("unroll") for (int k = 0; k < 2; ++k) \
        acc[ai][bj][m][n] = __builtin_amdgcn_mfma_f32_16x16x32_bf16(Bt[n][k], At[m][k], acc[ai][bj][m][n], 0, 0, 0); __builtin_amdgcn_s_setprio(0); } while (0)
#define PG8_WAIT_V(n) asm volatile("s_waitcnt vmcnt(" #n ")" ::: "memory")
#define PG8_WAIT_L(n) asm volatile("s_waitcnt lgkmcnt(" #n ")" ::: "memory")
#define PG8_BAR __builtin_amdgcn_s_barrier()
#define PG8_SCHED __builtin_amdgcn_sched_barrier(0)
    Unit cur, nxt; int ui = 0;
    if (!S.next(0, cur)) return;
    f32x4 acc[2][2][4][2];
#pragma unroll
    for (int a = 0; a < 2; ++a)
#pragma unroll
        for (int b = 0; b < 2; ++b)
#pragma unroll
            for (int m = 0; m < 4; ++m)
#pragma unroll
                for (int n = 0; n < 2; ++n) acc[a][b][m][n] = (f32x4){0.f, 0.f, 0.f, 0.f};
    bf16x8 At[4][2], B0[2][2], B1[2][2];
    const char* cA = (const char*)g.A + (size_t)cur.g * g.a_goff * 2 + (size_t)cur.pm * tstepA; const char* cB = (const char*)g.Bt + (size_t)cur.g * g.b_goff * 2 + (size_t)cur.pn * tstepB;
    S.a_ready(cur);
    if constexpr (SP2) {
        PG8_STAGE(PG8_SB(0, 0), cB, voffB); PG8_STAGE(PG8_SB(0, 1), cB + hstepB, voffB); PG8_STAGE(PG8_SA(0, 0), cA, voffA); PG8_STAGE(PG8_SA(0, 1), cA + hstepA, voffA);
        if (wr == 1) PG8_BAR;
        PG8_WAIT_V(2); PG8_BAR;
        PG8_STAGE(PG8_SB(1, 0), cB + kstep, voffB); PG8_STAGE(PG8_SA(1, 0), cA + kstep, voffA); PG8_STAGE(PG8_SB(1, 1), cB + hstepB + kstep, voffB);
        PG8_WAIT_V(6); PG8_BAR;
    } else {
        PG8_STAGE(PG8_SB(0, 0), cB, voffB); PG8_STAGE(PG8_SA(0, 0), cA, voffA); PG8_STAGE(PG8_SB(0, 1), cB + hstepB, voffB); PG8_STAGE(PG8_SA(0, 1), cA + hstepA, voffA);
        if (wr == 1) PG8_BAR;
        PG8_WAIT_V(4); PG8_BAR;
        PG8_STAGE(PG8_SB(1, 0), cB + kstep, voffB); PG8_STAGE(PG8_SA(1, 0), cA + kstep, voffA); PG8_STAGE(PG8_SB(1, 1), cB + hstepB + kstep, voffB);
        PG8_WAIT_V(6); PG8_BAR;
    }
    for (;;) {
        const bool has_next = S.next(ui + 1, nxt);
        const char* nA = has_next ? (const char*)g.A + (size_t)nxt.g * g.a_goff * 2 + (size_t)nxt.pm * tstepA : cA; const char* nB = has_next ? (const char*)g.Bt + (size_t)nxt.g * g.b_goff * 2 + (size_t)nxt.pn * tstepB : cB;
        for (int t = 0; t < nt; t += 2) {
            const bool last = (t == nt - 2);
            const char* a1 = cA + (size_t)(t + 1) * kstep;
            const char* a2 = last ? nA : cA + (size_t)(t + 2) * kstep; const char* b2 = last ? nB : cB + (size_t)(t + 2) * kstep;
            const char* a3 = a2 + kstep; const char* b3 = b2 + kstep;
            if (last && has_next) S.a_ready(nxt);
            if constexpr (SP2) {
            PG8_LDB(B0, 0, 0); PG8_LDB(B1, 0, 1); PG8_SCHED; PG8_LDA(At, 0, 0); PG8_STAGE(PG8_SA(1, 1), a1 + hstepA, voffA);
            PG8_WAIT_V(8); PG8_WAIT_L(0); PG8_BAR; PG8_MMA(0, 0, At, B0); PG8_MMA(0, 1, At, B1); PG8_BAR; PG8_SCHED;
            PG8_LDA(At, 0, 1); PG8_STAGE(PG8_SB(0, 0), b2, voffB); PG8_STAGE(PG8_SB(0, 1), b2 + hstepB, voffB); PG8_STAGE(PG8_SA(0, 0), a2, voffA);
            PG8_WAIT_V(8); PG8_WAIT_L(0); PG8_BAR; PG8_MMA(1, 0, At, B0); PG8_MMA(1, 1, At, B1); PG8_BAR; PG8_SCHED;
            PG8_LDB(B0, 1, 0); PG8_LDB(B1, 1, 1); PG8_SCHED; PG8_LDA(At, 1, 0); PG8_STAGE(PG8_SA(0, 1), a2 + hstepA, voffA);
            PG8_WAIT_V(8); PG8_WAIT_L(0); PG8_BAR; PG8_MMA(0, 0, At, B0); PG8_MMA(0, 1, At, B1); PG8_BAR; PG8_SCHED;
            PG8_LDA(At, 1, 1); PG8_STAGE(PG8_SB(1, 0), b3, voffB); PG8_STAGE(PG8_SB(1, 1), b3 + hstepB, voffB); PG8_STAGE(PG8_SA(1, 0), a3, voffA);
            PG8_WAIT_V(8); PG8_WAIT_L(0); PG8_BAR; PG8_MMA(1, 0, At, B0); PG8_MMA(1, 1, At, B1); PG8_BAR; PG8_SCHED;
            } else {
            PG8_LDB(B0, 0, 0); PG8_SCHED; PG8_LDA(At, 0, 0); PG8_STAGE(PG8_SA(1, 1), a1 + hstepA, voffA);
            PG8_WAIT_L(8); PG8_BAR; PG8_WAIT_L(0); PG8_MMA(0, 0, At, B0); PG8_BAR; PG8_SCHED;
            PG8_LDB(B1, 0, 1); PG8_STAGE(PG8_SB(0, 0), b2, voffB);
            PG8_BAR; PG8_WAIT_L(0); PG8_MMA(0, 1, At, B1); PG8_BAR;
            PG8_LDA(At, 0, 1); PG8_STAGE(PG8_SA(0, 0), a2, voffA);
            PG8_BAR; PG8_WAIT_L(0); PG8_MMA(1, 0, At, B0); PG8_BAR; PG8_SCHED;
            PG8_STAGE(PG8_SB(0, 1), b2 + hstepB, voffB);
            PG8_WAIT_V(6); PG8_BAR; PG8_MMA(1, 1, At, B1); PG8_BAR;
            PG8_LDB(B0, 1, 0); PG8_SCHED; PG8_LDA(At, 1, 0); PG8_STAGE(PG8_SA(0, 1), a2 + hstepA, voffA);
            PG8_WAIT_L(8); PG8_BAR; PG8_WAIT_L(0); PG8_MMA(0, 0, At, B0); PG8_BAR; PG8_SCHED;
            PG8_LDB(B1, 1, 1); PG8_STAGE(PG8_SB(1, 0), b3, voffB);
            PG8_BAR; PG8_WAIT_L(0); PG8_MMA(0, 1, At, B1); PG8_BAR;
            PG8_LDA(At, 1, 1); PG8_STAGE(PG8_SA(1, 0), a3, voffA);
            PG8_BAR; PG8_WAIT_L(0); PG8_MMA(1, 0, At, B0); PG8_BAR; PG8_SCHED;
            PG8_STAGE(PG8_SB(1, 1), b3 + hstepB, voffB);
            PG8_WAIT_V(6); PG8_BAR; PG8_MMA(1, 1, At, B1); PG8_BAR;
            }
        }
        if constexpr (ALIGN_EPI) { if (wr == 0) PG8_BAR; }
        if constexpr (!Epi::AFTER_DRAIN) { E(acc, cur, wr, wc, fr, fq); S.done(cur); }
        if (!has_next) break;
#pragma unroll
        for (int a = 0; a < 2; ++a)
#pragma unroll
            for (int b = 0; b < 2; ++b)
#pragma unroll
                for (int m = 0; m < 4; ++m)
#pragma unroll
                    for (int n = 0; n < 2; ++n) acc[a][b][m][n] = (f32x4){0.f, 0.f, 0.f, 0.f};
        cur = nxt; cA = nA; cB = nB; ++ui;
        if constexpr (ALIGN_EPI) { if (wr == 1) PG8_BAR; }
    }
    PG8_WAIT_V(0);
    if constexpr (!ALIGN_EPI) { if (wr == 0) PG8_BAR; }
    PG8_BAR;
    if constexpr (Epi::AFTER_DRAIN) { E.fused(acc, cur, wr, wc, fr, fq, lds, wid, lane); S.done(cur); }
#undef PG8_SA
#undef PG8_SB
#undef PG8_STAGE
#undef PG8_LDA
#undef PG8_LDB
#undef PG8_MMA
#undef PG8_WAIT_V
#undef PG8_WAIT_L
#undef PG8_BAR
#undef PG8_SCHED
}
}

constexpr int DM = 4096, NBP = 4, SEQ = 2048, NBS = 16, DSEQ = 32, PAST = 1024;
constexpr int MP = NBP * SEQ, MS = NBS * DSEQ, M = MP + MS, NBT = NBP + NBS;
constexpr int WPOOL = 2048, WSSD = 6144, HD = 64, NH = 96, NS = 128, CONVD = 8192, IN_DIM = 18528, NPAD = 18688, DIN = 8192;
constexpr int C_U = 0, C_G = 2048, C_Z = 4096, C_X = 10240, C_B = C_X + 6144, C_C = C_B + 1024, C_DT = 18432;
constexpr float LN_EPS = 1e-5f, RMS_EPS = 1e-5f, ALPHA = 1.41421356237f;
constexpr size_t O_Y = 0, O_PP = 35651584, O_CP = 35897344, O_SP = 36093952, O_PS = 42385408, O_CS = 43368448, O_SS = 44154880, O_END = 69320704;
constexpr size_t MiB = 1u << 20;
constexpr size_t WS_CTL = 0, CTL_ZERO_BYTES = 1 * MiB, WS_MODF = 1 * MiB, WS_WIN = 4 * MiB, WIN_L = 146 * MiB, WS_WOUT = 296 * MiB, WOUT_L = 64 * MiB, WS_WP = 424 * MiB,
                 WS_H = 428 * MiB, WS_PROJ = 496 * MiB, WS_XBC = 1117 * MiB, WS_POOLED = 1253 * MiB, WS_DTV = 1287 * MiB, WS_YG = 1291 * MiB, WS_MIXED = 1495 * MiB,
                 WS_R = 1631 * MiB, WS_X1 = 1767 * MiB, WS_END = 1903 * MiB;
static_assert((size_t)NPAD * DM * 2 == WIN_L && (size_t)DM * DIN * 2 == WOUT_L && WS_PROJ + (size_t)M * NPAD * 4 <= WS_XBC, "ws map");
constexpr int CW_BAR = 4096;
constexpr int RING_BYTES = 131072, LDSCTL_OFF = RING_BYTES, MISC_OFF = LDSCTL_OFF + 320, LDS_BYTES = 155648;
constexpr int NWAVES = 8;
constexpr int NPHASE = 14;

#define GAS __attribute__((address_space(1)))
#define LAS __attribute__((address_space(3)))
typedef unsigned short bf16;
typedef unsigned v4u __attribute__((ext_vector_type(4)));
typedef unsigned v2u __attribute__((ext_vector_type(2)));
typedef float f32x4 __attribute__((ext_vector_type(4)));
typedef float f32x2 __attribute__((ext_vector_type(2)));
#define LDS_WAIT() asm volatile("s_waitcnt lgkmcnt(0)" ::: "memory")
#define VM_WAIT() asm volatile("s_waitcnt vmcnt(0)" ::: "memory")
__device__ __forceinline__ unsigned f2bf(float f) { unsigned u = __builtin_bit_cast(unsigned, f); return (u + 0x7fffu + ((u >> 16) & 1u)) >> 16; }
__device__ __forceinline__ unsigned pk2(float lo, float hi) { return f2bf(lo) | (f2bf(hi) << 16); }
__device__ __forceinline__ float bf2f(unsigned short b) { return __builtin_bit_cast(float, ((unsigned)b) << 16); }
__device__ __forceinline__ float silu(float x) { return x / (1.0f + __expf(-x)); }
__device__ __forceinline__ float wave_sum(float v) {
#pragma unroll
    for (int o = 1; o < 64; o <<= 1) v += __shfl_xor(v, o);
    return v;
}

#define XB_TMO      128
#define XB_XCNT(j)  (256  + 64 * (j))
#define XB_XSUB(j)  (1280 + 64 * (j))
#define XB_XGEN(j)  (2304 + 64 * (j))
#define XB_TOP      3328
#define XB_TOPGEN   3392
#define XCD_BAR_WORDS 3456
#define XB_SPIN_CAP (1u << 18)
__device__ __forceinline__ unsigned xb_ld(unsigned* p)              { return __hip_atomic_load(p, __ATOMIC_RELAXED, __HIP_MEMORY_SCOPE_AGENT); }
__device__ __forceinline__ unsigned xb_add(unsigned* p, unsigned v) { return __hip_atomic_fetch_add(p, v, __ATOMIC_RELAXED, __HIP_MEMORY_SCOPE_AGENT); }
__device__ __forceinline__ unsigned xb_xcc_id() { return (unsigned)__builtin_amdgcn_s_getreg((3 << 11) | 20) & 0xFu; }
#define XB_SPIN(cond, bar) do { unsigned _sp = 0; while (cond) { __builtin_amdgcn_s_sleep(1); \
    if ((++_sp & 255u) == 0u) { if (xb_ld(&(bar)[XB_TMO])) break; if (_sp > XB_SPIN_CAP) { atomicAdd(&(bar)[XB_TMO], 1u); break; } } } } while (0)
struct XcdBarrier { unsigned* bar; unsigned x; volatile LAS unsigned* st; };
__device__ __forceinline__ XcdBarrier xcd_barrier_post(unsigned* bar, volatile LAS unsigned* st) {
    XcdBarrier b; b.bar = bar; b.x = xb_xcc_id(); b.st = st;
    if (threadIdx.x == 0) (void)xb_add(&bar[XB_XCNT(b.x)], 1u);
    return b;
}
__device__ __forceinline__ void xcd_barrier_complete(unsigned* bar, unsigned x, unsigned& nloc, unsigned& nx) {
    const unsigned G = gridDim.x * gridDim.y * gridDim.z;
    unsigned sum, cnt, mine, sp = 0u;
    for (;;) {
        sum = 0u; cnt = 0u; mine = 0u;
#pragma unroll
        for (unsigned j = 0; j < 16; ++j) { const unsigned c = xb_ld(&bar[XB_XCNT(j)]); sum += c; cnt += (c > 0u) ? 1u : 0u; mine = (j == x) ? c : mine; }
        if (sum == G) break;
        __builtin_amdgcn_s_sleep(1);
        if ((++sp & 255u) == 0u) { if (xb_ld(&bar[XB_TMO])) break; if (sp > XB_SPIN_CAP) { atomicAdd(&bar[XB_TMO], 1u); break; } }
    }
    nloc = mine > 0u ? mine : 1u; nx = cnt > 0u ? cnt : 1u;
}
__device__ __forceinline__ void xcd_barrier(const XcdBarrier& b) {
    asm volatile("s_waitcnt vmcnt(0)" ::: "memory");
    __syncthreads();
    if (threadIdx.x == 0) {
        unsigned* bar = b.bar;
        __builtin_amdgcn_s_waitcnt(0);
        unsigned nloc = b.st[0], nx = b.st[1];
        if (nloc == 0u) { xcd_barrier_complete(bar, b.x, nloc, nx); b.st[0] = nloc; b.st[1] = nx; }
        const unsigned old = xb_add(&bar[XB_XSUB(b.x)], 1u);
        const unsigned gen = old / nloc;
        if (old + 1u == (gen + 1u) * nloc) {
            __builtin_amdgcn_fence(__ATOMIC_RELEASE, "agent");
            asm volatile("s_waitcnt vmcnt(0)" ::: "memory");
            const unsigned og = xb_add(&bar[XB_TOP], 1u);
            const unsigned tg = og / nx;
            if (og + 1u == (tg + 1u) * nx) xb_add(&bar[XB_TOPGEN], 1u);
            else XB_SPIN(xb_ld(&bar[XB_TOPGEN]) == tg, bar);
            __builtin_amdgcn_fence(__ATOMIC_ACQUIRE, "agent");
            xb_add(&bar[XB_XGEN(b.x)], 1u);
            asm volatile("s_waitcnt vmcnt(0)" ::: "memory");
        } else {
            XB_SPIN(xb_ld(&bar[XB_XGEN(b.x)]) == gen, bar);
            __builtin_amdgcn_fence(__ATOMIC_ACQUIRE, "agent");
            asm volatile("s_waitcnt vmcnt(0)" ::: "memory");
        }
    }
    __syncthreads();
}

struct Args { const float* in[21]; float* out; unsigned char* ws; int ph_lo, ph_hi; };

__device__ __forceinline__ void p0_transpose_item(const float* W, int N, bf16* WT, int ldt, LAS float* scr, int kb, int nb, int lane) {
    const int k0 = 64 * kb, n0 = 32 * nb;
#pragma unroll 8
    for (int i = 0; i < 32; ++i) { const int kk = 2 * i + (lane >> 5); scr[kk * 33 + (lane & 31)] = W[(size_t)(k0 + kk) * N + n0 + (lane & 31)]; }
    LDS_WAIT(); asm volatile("" ::: "memory");
    const int c = lane & 7;
#pragma unroll
    for (int j = 0; j < 4; ++j) { const int n = (lane >> 3) + 8 * j; const LAS float* s = scr + (8 * c) * 33 + n;
        v4u o; o.x = pk2(s[0 * 33], s[1 * 33]); o.y = pk2(s[2 * 33], s[3 * 33]); o.z = pk2(s[4 * 33], s[5 * 33]); o.w = pk2(s[6 * 33], s[7 * 33]);
        *(GAS v4u*)(WT + (size_t)(n0 + n) * ldt + k0 + 8 * c) = o; }
    LDS_WAIT(); asm volatile("" ::: "memory");
}
__device__ __forceinline__ void p0_mod_item(const Args& a, LAS unsigned char* lds, int item, int tid, int lane, int wave) {
    const int l = item >> 7, cb = item & 127, e0 = cb * 96;
    const float* W = a.in[7] + (size_t)l * DM * 3 * DM;
    const float* cp = a.in[5]; const float* cs = a.in[6];
    LAS float* sl = (LAS float*)(lds + wave * 8192);
    f32x2 acc[20];
#pragma unroll
    for (int b = 0; b < 20; ++b) acc[b] = (f32x2){0.f, 0.f};
    const bool act = lane < 48;
    for (int ch = 0; ch < 8; ++ch) {
        const int d0 = wave * 512 + ch * 64;
#pragma unroll
        for (int b = 0; b < 20; ++b) { const float c = b < 4 ? cp[b * DM + d0 + lane] : cs[(b - 4) * DM + d0 + lane]; sl[lane * 20 + b] = c / (1.0f + expf(-c)); }
        LDS_WAIT(); asm volatile("" ::: "memory");
        for (int r = 0; r < 64; r += 8) {
            f32x2 wv[8];
#pragma unroll
            for (int j = 0; j < 8; ++j) wv[j] = act ? *(const f32x2*)(W + (size_t)(d0 + r + j) * (3 * DM) + e0 + 2 * lane) : (f32x2){0.f, 0.f};
#pragma unroll
            for (int j = 0; j < 8; ++j) { const LAS f32x4* sp = (const LAS f32x4*)(sl + (r + j) * 20);
#pragma unroll
                for (int q = 0; q < 5; ++q) { const f32x4 s4 = sp[q];
#pragma unroll
                    for (int c = 0; c < 4; ++c) acc[q * 4 + c] += wv[j] * s4[c]; } }
        }
        LDS_WAIT(); asm volatile("" ::: "memory");
    }
    LAS float* red = (LAS float*)(lds + 65536 + wave * 7680);
    if (act) {
#pragma unroll
        for (int b = 0; b < 20; ++b) *(LAS f32x2*)(red + b * 96 + 2 * lane) = acc[b]; }
    __syncthreads();
    float* modf = (float*)(a.ws + WS_MODF);
    for (int idx = tid; idx < 20 * 96; idx += NWAVES * 64) { float s = 0.f;
#pragma unroll
        for (int w = 0; w < 8; ++w) s += ((LAS float*)(lds + 65536 + w * 7680))[idx];
        const int b = idx / 96, e = idx % 96; modf[(size_t)(l * 20 + b) * (3 * DM) + e0 + e] = s + a.in[8][(size_t)l * 3 * DM + e0 + e]; }
    __syncthreads();
}
__device__ __forceinline__ void p0_prologue(const Args& a, LAS unsigned char* lds, int G, int bid, int tid, int lane, int wave) {
    for (int it = bid; it < 256; it += G) p0_mod_item(a, lds, it, tid, lane, wave);
    LAS float* scr = (LAS float*)(lds + wave * 16384);
    const int gw = bid * NWAVES + wave, NGW = G * NWAVES;
    constexpr int I_IN = 64 * 579, I_OUT = 128 * 128, I_P = 8 * 16;
    constexpr int NITEMS = 2 * I_IN + 2 * I_OUT + 8 * I_P;
    for (int it = gw; it < NITEMS; it += NGW) {
        int r = it;
        if (r < 2 * I_IN) { const int l = r / I_IN; r -= l * I_IN; p0_transpose_item(a.in[9] + (size_t)l * DM * IN_DIM, IN_DIM, (bf16*)(a.ws + WS_WIN + l * WIN_L), DM, scr, r / 579, r % 579, lane); continue; } r -= 2 * I_IN;
        if (r < 2 * I_OUT) { const int l = r / I_OUT; r -= l * I_OUT; p0_transpose_item(a.in[18] + (size_t)l * DIN * DM, DM, (bf16*)(a.ws + WS_WOUT + l * WOUT_L), DIN, scr, r / 128, r % 128, lane); continue; } r -= 2 * I_OUT;
        { const int lg = r / I_P; r -= lg * I_P; p0_transpose_item(a.in[10] + (size_t)lg * 512 * 512, 512, (bf16*)(a.ws + WS_WP) + (size_t)lg * 512 * 512, 512, scr, r / 16, r % 16, lane); }
    }
    for (int i = bid * NWAVES * 64 + tid; i < 2 * (NPAD - IN_DIM) * (DM / 8); i += G * NWAVES * 64) { const int l = i / ((NPAD - IN_DIM) * (DM / 8)), r = i % ((NPAD - IN_DIM) * (DM / 8));
        *(GAS v4u*)((bf16*)(a.ws + WS_WIN + l * WIN_L) + (size_t)IN_DIM * DM + (size_t)r * 8) = (v4u){0u, 0u, 0u, 0u}; }
}

__device__ __forceinline__ void row_stats(const f32x4 (&v)[16], float& mean, float& rstd) {
    float s = 0.f;
#pragma unroll
    for (int j = 0; j < 16; ++j) s += (v[j].x + v[j].y) + (v[j].z + v[j].w);
    mean = wave_sum(s) * (1.f / DM); float q = 0.f;
#pragma unroll
    for (int j = 0; j < 16; ++j) { const f32x4 d = v[j] - mean; q += (d.x * d.x + d.y * d.y) + (d.z * d.z + d.w * d.w); }
    rstd = 1.f / sqrtf(wave_sum(q) * (1.f / DM) + LN_EPS);
}
__device__ __forceinline__ int batch_of(int m) { return m < MP ? (m >> 11) : NBP + ((m - MP) >> 5); }
__device__ __forceinline__ void mod_row_to_bf16(const f32x4 (&v)[16], const float* md, bf16* hrow, int lane) {
    float mean, rstd; row_stats(v, mean, rstd);
#pragma unroll
    for (int j = 0; j < 16; ++j) { const f32x4 sh = ((const f32x4*)md)[lane + 64 * j], sc = ((const f32x4*)(md + DM))[lane + 64 * j];
        const f32x4 o = (v[j] - mean) * rstd * (sc + 1.0f) + sh;
        ((GAS v2u*)hrow)[lane + 64 * j] = (v2u){pk2(o.x, o.y), pk2(o.z, o.w)}; }
}
__device__ __forceinline__ void phase_a(const Args& a, int G, int bid, int lane, int wave) {
    const int gw = bid * NWAVES + wave, NGW = G * NWAVES;
    const float* modf = (const float*)(a.ws + WS_MODF); bf16* H = (bf16*)(a.ws + WS_H);
    for (int m = gw; m < M; m += NGW) {
        const float* xr = m < MP ? a.in[0] + (size_t)m * DM : a.in[1] + (size_t)(m - MP) * DM;
        f32x4 v[16];
#pragma unroll
        for (int j = 0; j < 16; ++j) v[j] = ((const f32x4*)xr)[lane + 64 * j];
        mod_row_to_bf16(v, modf + (size_t)batch_of(m) * 3 * DM, H + (size_t)m * DM, lane);
    }
}
__device__ __forceinline__ void phase_g(const Args& a, int l, int G, int bid, int lane, int wave) {
    const int gw = bid * NWAVES + wave, NGW = G * NWAVES;
    const float* modf = (const float*)(a.ws + WS_MODF); bf16* H = (bf16*)(a.ws + WS_H);
    const float* R = (const float*)(a.ws + WS_R); float* xo = l == 0 ? (float*)(a.ws + WS_X1) : a.out + O_Y;
    const float* lg = a.in[19] + (size_t)l * DM; const float* lb = a.in[20] + (size_t)l * DM;
    for (int m = gw; m < M; m += NGW) {
        f32x4 v[16];
#pragma unroll
        for (int j = 0; j < 16; ++j) v[j] = ((const f32x4*)(R + (size_t)m * DM))[lane + 64 * j];
        float mean, rstd; row_stats(v, mean, rstd);
#pragma unroll
        for (int j = 0; j < 16; ++j) { v[j] = (v[j] - mean) * rstd * ((const f32x4*)lg)[lane + 64 * j] + ((const f32x4*)lb)[lane + 64 * j];
            ((GAS f32x4*)(xo + (size_t)m * DM))[lane + 64 * j] = v[j]; }
        if (l == 0) mod_row_to_bf16(v, modf + (size_t)(NBT + batch_of(m)) * 3 * DM, H + (size_t)m * DM, lane);
    }
}
__device__ __forceinline__ f32x4 pool_hist(const float* pc, const float* st, bool samp, int t) {
    if (t >= 0) return *(const f32x4*)(pc + (size_t)t * NPAD);
    if (samp) return *(const f32x4*)(st + (size_t)(15 + t) * WPOOL);
    return (f32x4){0.f, 0.f, 0.f, 0.f};
}
__device__ __forceinline__ void phase_c(const Args& a, int l, int G, int bid, int tid) {
    const float* proj = (const float*)(a.ws + WS_PROJ);
    for (int it = bid; it < 272 * 5; it += G) {
        const int seg = it / 5, cblk = it % 5, m0 = seg * 32;
        const bool samp = m0 >= MP; const int b = samp ? (m0 - MP) >> 5 : m0 >> 11, t0 = samp ? 0 : (m0 & 2047), L = samp ? DSEQ : SEQ;
        if (cblk == 0) {
            const int j0 = 4 * tid, w = 2 << (j0 >> 9);
            const float* pc = proj + (size_t)(m0 - t0) * NPAD + C_U + j0;
            const float* st = a.in[2] + (size_t)(l * NBS + b) * 15 * WPOOL + j0;
            bf16* po = (bf16*)(a.ws + WS_POOLED) + (size_t)m0 * WPOOL + j0;
            float* no = a.out + (samp ? O_PS : O_PP) + (size_t)(l * (samp ? NBS : NBP) + b) * 15 * WPOOL + j0;
            f32x4 S = (f32x4){0.f, 0.f, 0.f, 0.f};
            for (int i = 1; i < w; ++i) S += pool_hist(pc, st, samp, t0 - i);
            for (int r = 0; r < 32; ++r) { const int t = t0 + r; const f32x4 u = pool_hist(pc, st, samp, t); S += u;
                const int pos = (samp ? PAST : 0) + t; const float cnt = (float)(pos + 1 < w ? pos + 1 : w);
                const f32x4 p = S / cnt - u;
                *(GAS v2u*)(po + (size_t)r * WPOOL) = (v2u){pk2(p.x, p.y), pk2(p.z, p.w)};
                S -= pool_hist(pc, st, samp, t - w + 1);
                if (t >= L - 15) *(GAS f32x4*)(no + (size_t)(t - (L - 15)) * WPOOL) = u; }
        } else {
            const int j0 = (cblk - 1) * 2048 + 4 * tid;
            const float* cw = a.in[12] + (size_t)l * 4 * CONVD + j0;
            const f32x4 w0 = *(const f32x4*)cw, w1 = *(const f32x4*)(cw + CONVD), w2 = *(const f32x4*)(cw + 2 * CONVD), w3 = *(const f32x4*)(cw + 3 * CONVD), bs = *(const f32x4*)(a.in[13] + (size_t)l * CONVD + j0);
            const float* pc = proj + (size_t)m0 * NPAD + C_X + j0;
            f32x4 p3 = (f32x4){0.f, 0.f, 0.f, 0.f}, p2 = p3, p1 = p3;
            if (samp) { const float* st = a.in[3] + (size_t)(l * NBS + b) * 3 * CONVD + j0; p3 = *(const f32x4*)st; p2 = *(const f32x4*)(st + CONVD); p1 = *(const f32x4*)(st + 2 * CONVD); }
            else if (t0 != 0) { p3 = *(const f32x4*)(pc - 3 * (size_t)NPAD); p2 = *(const f32x4*)(pc - 2 * (size_t)NPAD); p1 = *(const f32x4*)(pc - (size_t)NPAD); }
            bf16* xo = (bf16*)(a.ws + WS_XBC) + (size_t)m0 * CONVD + j0;
            float* no = a.out + (samp ? O_CS : O_CP) + (size_t)(l * (samp ? NBS : NBP) + b) * 3 * CONVD + j0;
            for (int r = 0; r < 32; ++r) { const f32x4 cur = *(const f32x4*)(pc + (size_t)r * NPAD);
                f32x4 o = w0 * p3 + w1 * p2 + w2 * p1 + w3 * cur + bs;
                o.x = silu(o.x); o.y = silu(o.y); o.z = silu(o.z); o.w = silu(o.w);
                *(GAS v2u*)(xo + (size_t)r * CONVD) = (v2u){pk2(o.x, o.y), pk2(o.z, o.w)};
                const int t = t0 + r; if (t >= L - 3) *(GAS f32x4*)(no + (size_t)(t - (L - 3)) * CONVD) = cur;
                p3 = p2; p2 = p1; p1 = cur; }
        }
    }
    float* dtv = (float*)(a.ws + WS_DTV);
    for (int i = bid * NWAVES * 64 + tid; i < M * NH; i += G * NWAVES * 64) { const int m = i / NH, h = i % NH;
        const float x = proj[(size_t)m * NPAD + C_DT + h] + a.in[14][l * NH + h];
        dtv[(size_t)h * M + m] = fmaxf(x, 0.f) + log1pf(expf(-fabsf(x))); }
}
typedef short s16x4 __attribute__((ext_vector_type(4)));
typedef short s16x8 __attribute__((ext_vector_type(8)));
constexpr int SSD_STAGE = 49152, SSD_XX = 0, SSD_BS = 16384, SSD_CS = 32768, SSD_HB = 98304, SSD_TAB = 135168;
__device__ __forceinline__ unsigned off_b(unsigned row, unsigned ch) { return 256u * row + 16u * (ch ^ (((row & 3u) << 2) | ((row >> 2) & 3u))); }
__device__ __forceinline__ s16x8 tr_frag(LAS unsigned char* img, int lane, int c, int ks) {
    const unsigned g = (unsigned)lane >> 4, qq = ((unsigned)lane & 15u) >> 2, pp = (unsigned)lane & 3u;
    const unsigned a0 = off_b(32u * ks + 8u * g + qq, 2u * c + (pp >> 1)) + 8u * (pp & 1u), a1 = off_b(32u * ks + 8u * g + 4u + qq, 2u * c + (pp >> 1)) + 8u * (pp & 1u);
    const s16x4 lo = __builtin_amdgcn_ds_read_tr16_b64_v4i16((LAS s16x4*)(img + a0)), hi = __builtin_amdgcn_ds_read_tr16_b64_v4i16((LAS s16x4*)(img + a1));
    return __builtin_shufflevector(lo, hi, 0, 1, 2, 3, 4, 5, 6, 7);
}
__device__ __forceinline__ s16x8 row_frag(LAS unsigned char* img, int row, int ch) { return *(const LAS s16x8*)(img + off_b((unsigned)row, (unsigned)ch)); }
__device__ __forceinline__ float ex2(float x) { return __builtin_amdgcn_exp2f(x); }
__device__ __forceinline__ unsigned scale_pk(unsigned v, float w) { return pk2(bf2f((unsigned short)(v & 0xffffu)) * w, bf2f((unsigned short)(v >> 16)) * w); }

__device__ __forceinline__ void ssd_unit(const Args& a, LAS unsigned char* lds, int l, int unit, int tid) {
    const int lane = tid & 63, wave = __builtin_amdgcn_readfirstlane(tid >> 6), r16 = lane & 15, q = lane >> 4;
    const int lt = wave & 3, ph = wave >> 2;
    const bool samp = unit >= NBP * NH; const int u2 = samp ? unit - NBP * NH : unit; const int b = u2 / NH, h = u2 % NH, g = h / 12;
    const int nchunk = samp ? 1 : SEQ / 64, vr = samp ? DSEQ : 64, mbase = samp ? MP + b * DSEQ : b * SEQ;
    const float A2 = -expf(a.in[15][l * NH + h]) * 1.44269504089f, Dk = a.in[16][l * NH + h];
    const bf16* xbc = (const bf16*)(a.ws + WS_XBC); const float* proj = (const float*)(a.ws + WS_PROJ); const float* dtt = (const float*)(a.ws + WS_DTV) + (size_t)h * M + mbase; float* yg = (float*)(a.ws + WS_YG);
    const int xrow = tid >> 3, xch = tid & 7, brow = tid >> 4, bch = tid & 15;
    const int lrow = 16 * lt + r16;
    v4u xr, br[2], cr[2]; f32x4 zr[2]; float dtl;
    const v4u zero4 = (v4u){0u, 0u, 0u, 0u};
#define SSD_LOAD(c) do { const size_t m0_ = (size_t)mbase + 64 * (size_t)(c); \
        xr = xrow < vr ? *(const v4u*)(xbc + (m0_ + xrow) * CONVD + h * HD + 8 * xch) : zero4; \
        _Pragma("unroll") for (int i_ = 0; i_ < 2; ++i_) { const int row_ = brow + 32 * i_; const bf16* rp_ = xbc + (m0_ + row_) * CONVD + WSSD + g * NS + 8 * bch; \
            br[i_] = row_ < vr ? *(const v4u*)rp_ : zero4; cr[i_] = row_ < vr ? *(const v4u*)(rp_ + 1024) : zero4; } \
        _Pragma("unroll") for (int j_ = 0; j_ < 2; ++j_) zr[j_] = lrow < vr ? *(const f32x4*)(proj + (m0_ + lrow) * NPAD + C_Z + h * HD + 16 * (2 * ph + j_) + 4 * q) : (f32x4){0.f, 0.f, 0.f, 0.f}; \
        dtl = lane < vr ? dtt[64 * (c) + lane] : 0.f; } while (0)
#define SSD_STAGE_WRITE(i_) do { LAS float* tb_ = (LAS float*)(lds + SSD_TAB + (2 * wave + (i_)) * 1024); float cs_ = dtl * A2; \
        _Pragma("unroll") for (int o_ = 1; o_ < 64; o_ <<= 1) { const float t_ = __shfl_up(cs_, o_); cs_ += lane >= o_ ? t_ : 0.f; } \
        const float tot_ = __shfl(cs_, 63); tb_[lane] = cs_; tb_[64 + lane] = dtl; tb_[128 + lane] = dtl * ex2(tot_ - cs_); \
        LDS_WAIT(); asm volatile("" ::: "memory"); \
        LAS unsigned char* st_ = lds + (i_) * SSD_STAGE; const float w_ = tb_[128 + xrow]; \
        *(LAS v4u*)(st_ + SSD_XX + off_b(xrow, xch)) = xr; \
        *(LAS v4u*)(st_ + SSD_XX + off_b(xrow, 8 + xch)) = (v4u){scale_pk(xr.x, w_), scale_pk(xr.y, w_), scale_pk(xr.z, w_), scale_pk(xr.w, w_)}; \
        _Pragma("unroll") for (int i2_ = 0; i2_ < 2; ++i2_) { *(LAS v4u*)(st_ + SSD_BS + off_b(brow + 32 * i2_, bch)) = br[i2_]; *(LAS v4u*)(st_ + SSD_CS + off_b(brow + 32 * i2_, bch)) = cr[i2_]; } } while (0)
#define SSD_BAR() do { asm volatile("s_waitcnt lgkmcnt(0)" ::: "memory"); __builtin_amdgcn_s_barrier(); asm volatile("" ::: "memory"); } while (0)

    f32x4 Hacc[2][2];
#pragma unroll
    for (int i = 0; i < 2; ++i)
#pragma unroll
        for (int j = 0; j < 2; ++j) Hacc[i][j] = samp ? *(const f32x4*)(a.in[4] + ((size_t)((l * NBS + b) * NH + h) * HD + 16 * (2 * ph + j) + r16) * NS + 16 * (2 * lt + i) + 4 * q) : (f32x4){0.f, 0.f, 0.f, 0.f};
    SSD_LOAD(0);
    f32x4 zc[2] = {zr[0], zr[1]};
    SSD_STAGE_WRITE(0);
#define SSD_HWRITE(i_) do { LAS unsigned char* hb_ = lds + SSD_HB + (i_) * 16384; \
        _Pragma("unroll") for (int i2_ = 0; i2_ < 2; ++i2_) _Pragma("unroll") for (int j2_ = 0; j2_ < 2; ++j2_) { const f32x4 v_ = Hacc[i2_][j2_]; \
            *(LAS v2u*)(hb_ + off_b(16 * (2 * ph + j2_) + r16, 2 * (2 * lt + i2_) + (q >> 1)) + 8 * (q & 1)) = (v2u){pk2(v_.x, v_.y), pk2(v_.z, v_.w)}; } } while (0)
    SSD_HWRITE(0);
    SSD_BAR();
    for (int c = 0; c < nchunk; ++c) {
        const bool more = c + 1 < nchunk;
        if (more) SSD_LOAD(c + 1);
        LAS unsigned char* st = lds + (c & 1) * SSD_STAGE; LAS unsigned char* hb = lds + SSD_HB + (c & 1) * 16384; LAS float* tb = (LAS float*)(lds + SSD_TAB + (2 * wave + (c & 1)) * 1024);
        s16x8 cf[4];
#pragma unroll
        for (int kk = 0; kk < 4; ++kk) cf[kk] = row_frag(st + SSD_CS, lrow, 4 * kk + q);
        f32x4 acc[2] = {(f32x4){0.f, 0.f, 0.f, 0.f}, (f32x4){0.f, 0.f, 0.f, 0.f}};
#pragma unroll
        for (int j = 0; j < 2; ++j)
#pragma unroll
            for (int kk = 0; kk < 4; ++kk) acc[j] = __builtin_amdgcn_mfma_f32_16x16x32_bf16(row_frag(hb, 16 * (2 * ph + j) + r16, 4 * kk + q), cf[kk], acc[j], 0, 0, 0);
        const float acl = tb[lrow], el = ex2(acl);
        acc[0] = acc[0] * el; acc[1] = acc[1] * el;
#pragma unroll
        for (int k2 = 0; k2 < 2; ++k2) if (k2 <= (lt >> 1)) {
            f32x4 gx = (f32x4){0.f, 0.f, 0.f, 0.f}, gy = gx;
            const int sx = 32 * k2 + 8 * (r16 >> 2) + (r16 & 3);
#pragma unroll
            for (int kk = 0; kk < 4; ++kk) { gx = __builtin_amdgcn_mfma_f32_16x16x32_bf16(row_frag(st + SSD_BS, sx, 4 * kk + q), cf[kk], gx, 0, 0, 0);
                                             gy = __builtin_amdgcn_mfma_f32_16x16x32_bf16(row_frag(st + SSD_BS, sx + 4, 4 * kk + q), cf[kk], gy, 0, 0, 0); }
            const int s0 = 32 * k2 + 8 * q;
            const f32x4 as0 = *(const LAS f32x4*)(tb + s0), as1 = *(const LAS f32x4*)(tb + s0 + 4), d0 = *(const LAS f32x4*)(tb + 64 + s0), d1 = *(const LAS f32x4*)(tb + 64 + s0 + 4);
#pragma unroll
            for (int e = 0; e < 4; ++e) { gx[e] = (s0 + e <= lrow) ? gx[e] * ex2(acl - as0[e]) * d0[e] : 0.f; gy[e] = (s0 + 4 + e <= lrow) ? gy[e] * ex2(acl - as1[e]) * d1[e] : 0.f; }
            const s16x8 gms = __builtin_bit_cast(s16x8, (v4u){pk2(gx[0], gx[1]), pk2(gx[2], gx[3]), pk2(gy[0], gy[1]), pk2(gy[2], gy[3])});
#pragma unroll
            for (int j = 0; j < 2; ++j) acc[j] = __builtin_amdgcn_mfma_f32_16x16x32_bf16(tr_frag(st + SSD_XX, lane, 2 * ph + j, k2), gms, acc[j], 0, 0, 0);
        }
#pragma unroll
        for (int j = 0; j < 2; ++j) { const int p0 = 16 * (2 * ph + j) + 4 * q;
            const v2u xw = *(const LAS v2u*)(st + SSD_XX + off_b(lrow, p0 >> 3) + 2 * (p0 & 7));
            f32x4 y = acc[j] + Dk * (f32x4){bf2f((unsigned short)(xw.x & 0xffffu)), bf2f((unsigned short)(xw.x >> 16)), bf2f((unsigned short)(xw.y & 0xffffu)), bf2f((unsigned short)(xw.y >> 16))};
            y.x *= silu(zc[j].x); y.y *= silu(zc[j].y); y.z *= silu(zc[j].z); y.w *= silu(zc[j].w);
            if (lrow < vr) *(GAS f32x4*)(yg + ((size_t)mbase + 64 * c + lrow) * WSSD + h * HD + p0) = y; }
        const float cd = ex2(tb[63]);
#pragma unroll
        for (int i = 0; i < 2; ++i)
#pragma unroll
            for (int j = 0; j < 2; ++j) Hacc[i][j] = Hacc[i][j] * cd;
#pragma unroll
        for (int k2 = 0; k2 < 2; ++k2) { s16x8 bt[2], xs[2];
#pragma unroll
            for (int i = 0; i < 2; ++i) { bt[i] = tr_frag(st + SSD_BS, lane, 2 * lt + i, k2); xs[i] = tr_frag(st + SSD_XX, lane, 4 + 2 * ph + i, k2); }
#pragma unroll
            for (int i = 0; i < 2; ++i)
#pragma unroll
                for (int j = 0; j < 2; ++j) Hacc[i][j] = __builtin_amdgcn_mfma_f32_16x16x32_bf16(bt[i], xs[j], Hacc[i][j], 0, 0, 0); }
        if (more) { SSD_HWRITE((c + 1) & 1); SSD_STAGE_WRITE((c + 1) & 1); zc[0] = zr[0]; zc[1] = zr[1]; }
        SSD_BAR();
    }
    float* so = a.out + (samp ? O_SS : O_SP) + (size_t)((l * (samp ? NBS : NBP) + b) * NH + h) * HD * NS;
#pragma unroll
    for (int i = 0; i < 2; ++i)
#pragma unroll
        for (int j = 0; j < 2; ++j) *(GAS f32x4*)(so + (size_t)(16 * (2 * ph + j) + r16) * NS + 16 * (2 * lt + i) + 4 * q) = Hacc[i][j];
#undef SSD_LOAD
#undef SSD_STAGE_WRITE
#undef SSD_HWRITE
#undef SSD_BAR
}
__device__ __forceinline__ void phase_e(const Args& a, int l, int G, int bid, int lane, int wave) {
    const int gw = bid * NWAVES + wave, NGW = G * NWAVES;
    const float* yg = (const float*)(a.ws + WS_YG); bf16* mx = (bf16*)(a.ws + WS_MIXED);
    for (int it = gw; it < M * 8; it += NGW) { const int m = it >> 3, g = it & 7;
        const f32x4* yr = (const f32x4*)(yg + (size_t)m * WSSD + g * 768); f32x4 v[3]; float ss = 0.f;
#pragma unroll
        for (int j = 0; j < 3; ++j) { v[j] = yr[lane + 64 * j]; ss += (v[j].x * v[j].x + v[j].y * v[j].y) + (v[j].z * v[j].z + v[j].w * v[j].w); }
        const float rstd = 1.f / sqrtf(wave_sum(ss) * (1.f / 768.f) + RMS_EPS);
        const f32x4* nw = (const f32x4*)(a.in[17] + (size_t)l * WSSD + g * 768);
#pragma unroll
        for (int j = 0; j < 3; ++j) { const f32x4 o = v[j] * rstd * nw[lane + 64 * j];
            ((GAS v2u*)(mx + (size_t)m * DIN + WPOOL + g * 768))[lane + 64 * j] = (v2u){pk2(o.x, o.y), pk2(o.z, o.w)}; }
    }
}

__global__ void __launch_bounds__(NWAVES * 64, 2) trunk_fwd(Args args) {
    extern __shared__ __attribute__((aligned(16))) unsigned char lds_raw[];
    LAS unsigned char* lds = (LAS unsigned char*)lds_raw;
    volatile LAS unsigned* MISC = (volatile LAS unsigned*)(lds + MISC_OFF);
    const int tid = threadIdx.x, lane = tid & 63, wave = __builtin_amdgcn_readfirstlane(tid >> 6);
    const int G = gridDim.x, bid = blockIdx.x;
    unsigned* ctl = (unsigned*)(args.ws + WS_CTL);
    for (int u = tid; u < (LDS_BYTES - LDSCTL_OFF) / 4; u += NWAVES * 64) ((LAS unsigned*)(lds + LDSCTL_OFF))[u] = 0u;
    __syncthreads();
    const int lo = args.ph_lo, hi = args.ph_hi;
    XcdBarrier bar; bar.bar = ctl + CW_BAR; bar.x = 0; bar.st = MISC + 8;
    if (hi - lo > 1) bar = xcd_barrier_post(ctl + CW_BAR, MISC + 8);
#ifndef PROBE_MASK
#define PROBE_MASK 0
#endif
#define REP(kind) for (int _r = 0; _r < (((PROBE_MASK) >> (kind)) & 1 ? 2 : 1); ++_r)
#define IN(k) (lo <= (k) && (k) < hi)
#define BOTH(k) (IN(k) && IN((k) + 1))
#define SEAM(k) do { if (BOTH(k)) xcd_barrier(bar); } while (0)

    if (IN(0)) { REP(0) p0_prologue(args, lds, G, bid, tid, lane, wave); SEAM(0); }
    if (IN(1)) { REP(1) phase_a(args, G, bid, lane, wave); SEAM(1); }
    for (int l = 0; l < 2; ++l) {
        const int pb = 2 + 6 * l;
        int tl = threadIdx.x; asm volatile("" : "+v"(tl));
        const int lanel = tl & 63, wavel = __builtin_amdgcn_readfirstlane(tl >> 6);
        if (IN(pb)) {
            pg8::Gemm g{(const pg8::bf16_t*)(args.ws + WS_H), (const pg8::bf16_t*)(args.ws + WS_WIN + (size_t)l * WIN_L), M, NPAD, DM, DM, DM, 0, 0};
            pg8::StaticOrder S; S.init(M, NPAD, G, bid);
            pg8::EpiF32 E{(float*)(args.ws + WS_PROJ), NPAD};
            pg8::gemm_phase<pg8::EpiF32, pg8::StaticOrder, true, true>(lds, g, S, E, tl);
#if (PROBE_MASK >> 2) & 1
            __syncthreads(); pg8::gemm_phase<pg8::EpiF32, pg8::StaticOrder, true, true>(lds, g, S, E, tl);
#endif

            SEAM(pb);
        }
        if (IN(pb + 1)) { REP(3) phase_c(args, l, G, bid, tl); SEAM(pb + 1); }
        if (IN(pb + 2)) {
            { pg8::Gemm g{(const pg8::bf16_t*)(args.ws + WS_POOLED), (const pg8::bf16_t*)(args.ws + WS_WP) + (size_t)l * 4 * 512 * 512, M, 512, 512, WPOOL, 512, 512, (size_t)512 * 512};
              pg8::GroupOrder S; S.init(M, 512, 4, G, bid);
              pg8::EpiPool E{(pg8::bf16_t*)(args.ws + WS_MIXED), DIN, (const float*)(args.ws + WS_PROJ) + C_G, NPAD, args.in[11] + (size_t)l * WPOOL};
              pg8::gemm_phase<pg8::EpiPool, pg8::GroupOrder, true, true>(lds, g, S, E, tl);
#if (PROBE_MASK >> 4) & 1
            __syncthreads(); pg8::gemm_phase<pg8::EpiPool, pg8::GroupOrder, true, true>(lds, g, S, E, tl);
#endif
 }
            __syncthreads();
            REP(5) for (int k = 0; ; ++k) {
                int u;
                if (G == 256) { if (k >= (bid < 128 ? 2 : 13)) break; u = k == 0 ? bid : (bid < 128 ? 256 + bid : NBP * NH + (bid - 128) * 12 + (k - 1)); }
                else { u = bid + k * G; if (u >= (NBP + NBS) * NH) break; }
                ssd_unit(args, lds, l, u, tl); }
            SEAM(pb + 2);
        }
        if (IN(pb + 3)) { REP(6) phase_e(args, l, G, bid, lanel, wavel); SEAM(pb + 3); }
        if (IN(pb + 4)) {
            pg8::Gemm g{(const pg8::bf16_t*)(args.ws + WS_MIXED), (const pg8::bf16_t*)(args.ws + WS_WOUT + (size_t)l * WOUT_L), M, DM, DIN, DIN, DIN, 0, 0};
            pg8::StaticOrder S; S.init(M, DM, G, bid);
            const float* xp = l == 0 ? args.in[0] : (const float*)(args.ws + WS_X1); const float* xs = l == 0 ? args.in[1] : (const float*)(args.ws + WS_X1) + (size_t)MP * DM;
            pg8::EpiResid E{(float*)(args.ws + WS_R), DM, xp, xs, (const float*)(args.ws + WS_MODF) + (size_t)l * NBT * 3 * DM + 2 * DM, 3 * DM, ALPHA};
            pg8::gemm_phase<pg8::EpiResid, pg8::StaticOrder, true, true>(lds, g, S, E, tl);
#if (PROBE_MASK >> 7) & 1
            __syncthreads(); pg8::gemm_phase<pg8::EpiResid, pg8::StaticOrder, true, true>(lds, g, S, E, tl);
#endif

            SEAM(pb + 4);
        }
        if (IN(pb + 5)) { REP(8) phase_g(args, l, G, bid, lanel, wavel); if (pb + 5 < NPHASE - 1) SEAM(pb + 5); }
    }
#undef IN
#undef BOTH
#undef SEAM
}

#ifndef MK_SPLIT
#define MK_SPLIT 0
#endif
extern "C" void kernel_launch(void* const* d_in, const int* in_sizes, int n_in, void* d_out, int out_size, void* d_ws, size_t ws_size, hipStream_t stream) {
    static int grid = 0;
    if (grid == 0) {
        if (n_in != 21 || (size_t)out_size != O_END || ws_size < WS_END) { fprintf(stderr, "kernel_launch: unexpected shapes: n_in %d out %d ws %zu; nothing launched\n", n_in, out_size, ws_size); grid = -1; return; }
        int dev = 0, cus = 0, per_cu = 0;
        if (hipGetDevice(&dev) != hipSuccess || hipDeviceGetAttribute(&cus, hipDeviceAttributeMultiprocessorCount, dev) != hipSuccess) { grid = -1; return; }
        if (hipFuncSetAttribute((const void*)trunk_fwd, hipFuncAttributeMaxDynamicSharedMemorySize, LDS_BYTES) != hipSuccess) { fprintf(stderr, "kernel_launch: hipFuncSetAttribute failed\n"); grid = -1; return; }
        if (hipOccupancyMaxActiveBlocksPerMultiprocessor(&per_cu, (const void*)trunk_fwd, NWAVES * 64, LDS_BYTES) != hipSuccess || per_cu < 1) { fprintf(stderr, "kernel_launch: occupancy query says %d blocks per CU\n", per_cu); (void)hipGetLastError(); grid = -1; return; }
        grid = cus;
    }
    if (grid < 0) return;
    if (hipMemsetAsync((char*)d_ws + WS_CTL, 0, CTL_ZERO_BYTES, stream) != hipSuccess) return;
    Args a{};
    for (int i = 0; i < 21; ++i) a.in[i] = (const float*)d_in[i];
    a.out = (float*)d_out; a.ws = (unsigned char*)d_ws;
#if MK_SPLIT
    for (int ph = 0; ph < NPHASE; ++ph) { a.ph_lo = ph; a.ph_hi = ph + 1; hipLaunchKernelGGL(trunk_fwd, dim3(grid), dim3(NWAVES * 64), LDS_BYTES, stream, a); }
#else
    a.ph_lo = 0; a.ph_hi = NPHASE; hipLaunchKernelGGL(trunk_fwd, dim3(grid), dim3(NWAVES * 64), LDS_BYTES, stream, a);
#endif
}
```

```cpp
#ifndef PROBE_MASK
#define PROBE_MASK 0
#endif
#include <hip/hip_runtime.h>
#include <cstdio>
#include <cstdint>
namespace pg8 {
#define PG8_LAS __attribute__((address_space(3)))
typedef unsigned short bf16_t;
typedef short bf16x8 __attribute__((ext_vector_type(8)));
typedef float f32x4 __attribute__((ext_vector_type(4)));
typedef unsigned u32x4 __attribute__((ext_vector_type(4)));
constexpr int BM = 256, BK = 64, HALF = 128, HTB = HALF * BK * 2  , STAGE_BYTES = 8 * HTB, NXCD = 8, WGM = 8;

__host__ __device__ __forceinline__ int lds_byte(int r, int c) { const int st = (r >> 4) * 2 + (c >> 5), rr = r & 15, cc = c & 31, ob = rr * 64 + cc * 2; return st * 1024 + (ob ^ (((ob >> 9) & 1) << 5)); }
__host__ __device__ __forceinline__ void stage_rc(int b, int& R, int& C) { const int st = b / 1024, sb = b % 1024, swz = sb ^ (((sb >> 9) & 1) << 5); R = (st >> 1) * 16 + swz / 64; C = (st & 1) * 32 + (swz % 64) / 2; }
__host__ __device__ __forceinline__ int perm32(int rho) { const int n = rho >> 4, i = rho & 15; return 8 * (i >> 2) + 4 * n + (i & 3); }

struct Unit { int pm, pn, g; };
struct Gemm { const bf16_t* A; const bf16_t* Bt; int M, N, K, lda, ldb; size_t a_goff, b_goff; };

struct StaticOrder {
    int nM, nN, nwg, G, c;
    __host__ __device__ void init(int M, int N, int G_, int c_) { nM = M / BM; nN = N / BM; nwg = nM * nN; G = G_; c = c_; }
    __host__ __device__ bool next(int i, Unit& u) const {
        const long L = (long)i * G + c; if (L >= nwg) return false;
        int wgid = (int)L; { const int q = nwg / NXCD, r = nwg % NXCD, xcd = wgid % NXCD, off = wgid / NXCD; wgid = (xcd < r ? xcd * (q + 1) : r * (q + 1) + (xcd - r) * q) + off; }
        const int nig = WGM * nN, gid = wgid / nig, fm = gid * WGM, gsz = (nM - fm) < WGM ? (nM - fm) : WGM;
        u.pm = fm + ((wgid % nig) % gsz); u.pn = (wgid % nig) / gsz; u.g = 0; return true;
    }
    __device__ __forceinline__ void a_ready(const Unit&) const {}
    __device__ __forceinline__ void done(const Unit&) const {}
};
struct GroupOrder {
    int nM, nN, ng, G, c;
    __host__ __device__ void init(int M, int N, int ng_, int G_, int c_) { nM = M / BM; nN = N / BM; ng = ng_; G = G_; c = c_; }
    __host__ __device__ bool next(int i, Unit& u) const {
        const long L = (long)i * G + c; if (L >= (long)nM * nN * ng) return false;
        const int per = nM * nN, l = (int)L; u.g = l / per; const int r = l % per; u.pm = r % nM; u.pn = r / nM; return true;
    }
    __device__ __forceinline__ void a_ready(const Unit&) const {}
    __device__ __forceinline__ void done(const Unit&) const {}
};

__device__ __forceinline__ unsigned cvt_pk_bf16(float lo, float hi) { unsigned r; asm volatile("v_cvt_pk_bf16_f32 %0, %1, %2" : "=v"(r) : "v"(lo), "v"(hi)); return r; }
__device__ __forceinline__ float silu_f(float x) { return x * __builtin_amdgcn_rcpf(1.0f + __expf(-x)); }

__device__ __forceinline__ f32x4 bf4_to_f32(unsigned lo, unsigned hi) { return (f32x4){__builtin_bit_cast(float, lo << 16), __builtin_bit_cast(float, lo & 0xffff0000u), __builtin_bit_cast(float, hi << 16), __builtin_bit_cast(float, hi & 0xffff0000u)}; }
struct EpiSlab {
    static constexpr bool PERM = false, AFTER_DRAIN = false;
    float* C; int ldc; size_t gstride;
    __device__ __forceinline__ void operator()(const f32x4 (&acc)[2][2][4][2], const Unit& u, int wr, int wc, int fr, int fq) const {
        asm volatile("" : "+v"(fr), "+v"(fq));
        const int row0 = u.pm * BM + wr * 64 + fr, col0 = u.pn * BM + wc * 32 + 4 * fq; float* Cg = C + (size_t)u.g * gstride;
#pragma unroll
        for (int ai = 0; ai < 2; ++ai)
#pragma unroll
            for (int m = 0; m < 4; ++m) { float* rowp = Cg + (size_t)(row0 + ai * HALF + m * 16) * ldc + col0;
#pragma unroll
                for (int bj = 0; bj < 2; ++bj)
#pragma unroll
                    for (int n = 0; n < 2; ++n) *(f32x4*)(rowp + bj * HALF + n * 16) = acc[ai][bj][m][n]; }
    }
};
struct EpiPool {
    static constexpr bool PERM = true, AFTER_DRAIN = false;
    bf16_t* O; int ldo; const bf16_t* sg; int ldp; const float* pscale;
    __device__ __forceinline__ void operator()(const f32x4 (&acc)[2][2][4][2], const Unit& u, int wr, int wc, int fr, int fq) const {
        asm volatile("" : "+v"(fr), "+v"(fq));
        const int row0 = u.pm * BM + wr * 64 + fr, col0 = u.g * 512 + u.pn * BM + wc * 32 + 8 * fq;
        f32x4 ps[2][2];
#pragma unroll
        for (int bj = 0; bj < 2; ++bj)
#pragma unroll
            for (int n = 0; n < 2; ++n) ps[bj][n] = *(const f32x4*)(pscale + col0 + bj * HALF + 4 * n);
#pragma unroll
        for (int ai = 0; ai < 2; ++ai)
#pragma unroll
            for (int m = 0; m < 4; ++m) { const size_t row = (size_t)(row0 + ai * HALF + m * 16);
#pragma unroll
                for (int bj = 0; bj < 2; ++bj) { const int c = col0 + bj * HALF;
                    const u32x4 gq = *(const u32x4*)(sg + row * ldp + c);
                    const f32x4 v0 = acc[ai][bj][m][0] * ps[bj][0] * bf4_to_f32(gq.x, gq.y), v1 = acc[ai][bj][m][1] * ps[bj][1] * bf4_to_f32(gq.z, gq.w);
                    u32x4 w; w.x = cvt_pk_bf16(v0[0], v0[1]); w.y = cvt_pk_bf16(v0[2], v0[3]); w.z = cvt_pk_bf16(v1[0], v1[1]); w.w = cvt_pk_bf16(v1[2], v1[3]);
                    *(u32x4*)(O + row * ldo + c) = w; } }
    }
};
struct EpiResid {
    static constexpr bool PERM = false, AFTER_DRAIN = false;
    float* R; int ldr; const float* xp; const float* xs; const float* gate; int ldg; float alpha;
    __device__ __forceinline__ void operator()(const f32x4 (&acc)[2][2][4][2], const Unit& u, int wr, int wc, int fr, int fq) const {
        asm volatile("" : "+v"(fr), "+v"(fq));
        const int row0 = u.pm * BM + wr * 64 + fr, col0 = u.pn * BM + wc * 32 + 4 * fq;
#pragma unroll
        for (int ai = 0; ai < 2; ++ai)
#pragma unroll
            for (int m = 0; m < 4; ++m) { const int row = row0 + ai * HALF + m * 16;
                const int b = row < 8192 ? (row >> 11) : 4 + ((row - 8192) >> 5);
                const float* xr = row < 8192 ? xp + (size_t)row * 4096 : xs + (size_t)(row - 8192) * 4096;
                const float* gr = gate + (size_t)b * ldg; float* rr = R + (size_t)row * ldr;
#pragma unroll
                for (int bj = 0; bj < 2; ++bj)
#pragma unroll
                    for (int n = 0; n < 2; ++n) { const int c = col0 + bj * HALF + n * 16;
                        const f32x4 xv = *(const f32x4*)(xr + c), gv = *(const f32x4*)(gr + c);
                        *(f32x4*)(rr + c) = xv * alpha + gv * acc[ai][bj][m][n]; } }
    }
};

template <class Epi, class Sched, bool ALIGN_EPI = false, bool SP2 = false>
__device__ __forceinline__ void gemm_phase(PG8_LAS unsigned char* lds, const Gemm g, const Sched& S, const Epi& E, const int tid) {
    const int wid = __builtin_amdgcn_readfirstlane(tid >> 6), lane = tid & 63, wr = wid >> 2, wc = wid & 3, fr = lane & 15, fq = lane >> 4;
    const int K = g.K, nt = K / BK;
    unsigned voffA[2], voffB[2];
#pragma unroll
    for (int i = 0; i < 2; ++i) { int R, C; stage_rc(tid * 16 + i * 8192, R, C); const int Rb = Epi::PERM ? ((R & ~31) + perm32(R & 31)) : R;
        voffA[i] = (unsigned)(R * g.lda + C) * 2u; voffB[i] = (unsigned)(Rb * g.ldb + C) * 2u; }
    const size_t kstep = (size_t)(BK * 2);
    const size_t hstepA = (size_t)HALF * g.lda * 2, hstepB = (size_t)HALF * g.ldb * 2;
    const size_t tstepA = 2 * hstepA, tstepB = 2 * hstepB;
    const unsigned ldsw = (unsigned)wid * 1024u;
    const int aoff = lds_byte(wr * 64 + fr, fq * 8), boff = lds_byte(wc * 32 + fr, fq * 8);
#define PG8_SA(b, h) (((b) * 2 + (h)) * HTB)
#define PG8_SB(b, h) ((4 + (b) * 2 + (h)) * HTB)
#define PG8_STAGE(bufoff, gbase, voff) do { _Pragma("unroll") for (int _i = 0; _i < 2; ++_i) \
        __builtin_amdgcn_global_load_lds((const unsigned*)((const char*)(gbase) + (voff)[_i]), (PG8_LAS unsigned*)(lds + (bufoff) + ldsw + _i * 8192), 16, 0, 0); } while (0)
#define PG8_LDA(dst, b, h) do { _Pragma("unroll") for (int m = 0; m < 4; ++m) _Pragma("unroll") for (int k = 0; k < 2; ++k) dst[m][k] = *(const PG8_LAS bf16x8*)(lds + PG8_SA(b, h) + aoff + m * 2048 + k * 1024); } while (0)
#define PG8_LDB(dst, b, h) do { _Pragma("unroll") for (int n = 0; n < 2; ++n) _Pragma("unroll") for (int k = 0; k < 2; ++k) dst[n][k] = *(const PG8_LAS bf16x8*)(lds + PG8_SB(b, h) + boff + n * 2048 + k * 1024); } while (0)
#define PG8_MMA(ai, bj, At, Bt) do { __builtin_amdgcn_s_setprio(1); _Pragma("unroll") for (int m = 0; m < 4; ++m) _Pragma("unroll") for (int n = 0; n < 2; ++n) _Pragma("unroll") for (int k = 0; k < 2; ++k) \
        acc[ai][bj][m][n] = __builtin_amdgcn_mfma_f32_16x16x32_bf16(Bt[n][k], At[m][k], acc[ai][bj][m][n], 0, 0, 0); __builtin_amdgcn_s_setprio(0); } while (0)
#define PG8_WAIT_V(n) asm volatile("s_waitcnt vmcnt(" #n ")" ::: "memory")
#define PG8_WAIT_L(n) asm volatile("s_waitcnt lgkmcnt(" #n ")" ::: "memory")
#define PG8_BAR __builtin_amdgcn_s_barrier()
#define PG8_SCHED __builtin_amdgcn_sched_barrier(0)
    Unit cur, nxt; int ui = 0;
    if (!S.next(0, cur)) return;
    f32x4 acc[2][2][4][2];
#pragma unroll
    for (int a = 0; a < 2; ++a)
#pragma unroll
        for (int b = 0; b < 2; ++b)
#pragma unroll
            for (int m = 0; m < 4; ++m)
#pragma unroll
                for (int n = 0; n < 2; ++n) acc[a][b][m][n] = (f32x4){0.f, 0.f, 0.f, 0.f};
    bf16x8 At[4][2], B0[2][2], B1[2][2];
    const char* cA = (const char*)g.A + (size_t)cur.g * g.a_goff * 2 + (size_t)cur.pm * tstepA; const char* cB = (const char*)g.Bt + (size_t)cur.g * g.b_goff * 2 + (size_t)cur.pn * tstepB;
    S.a_ready(cur);
    if constexpr (SP2) {
        PG8_STAGE(PG8_SB(0, 0), cB, voffB); PG8_STAGE(PG8_SB(0, 1), cB + hstepB, voffB); PG8_STAGE(PG8_SA(0, 0), cA, voffA); PG8_STAGE(PG8_SA(0, 1), cA + hstepA, voffA);
        if (wr == 1) PG8_BAR;
        PG8_WAIT_V(2); PG8_BAR;
        PG8_STAGE(PG8_SB(1, 0), cB + kstep, voffB); PG8_STAGE(PG8_SA(1, 0), cA + kstep, voffA); PG8_STAGE(PG8_SB(1, 1), cB + hstepB + kstep, voffB);
        PG8_WAIT_V(6); PG8_BAR;
    } else {
        PG8_STAGE(PG8_SB(0, 0), cB, voffB); PG8_STAGE(PG8_SA(0, 0), cA, voffA); PG8_STAGE(PG8_SB(0, 1), cB + hstepB, voffB); PG8_STAGE(PG8_SA(0, 1), cA + hstepA, voffA);
        if (wr == 1) PG8_BAR;
        PG8_WAIT_V(4); PG8_BAR;
        PG8_STAGE(PG8_SB(1, 0), cB + kstep, voffB); PG8_STAGE(PG8_SA(1, 0), cA + kstep, voffA); PG8_STAGE(PG8_SB(1, 1), cB + hstepB + kstep, voffB);
        PG8_WAIT_V(6); PG8_BAR;
    }
    for (;;) {
        const bool has_next = S.next(ui + 1, nxt);
        const char* nA = has_next ? (const char*)g.A + (size_t)nxt.g * g.a_goff * 2 + (size_t)nxt.pm * tstepA : cA; const char* nB = has_next ? (const char*)g.Bt + (size_t)nxt.g * g.b_goff * 2 + (size_t)nxt.pn * tstepB : cB;
        for (int t = 0; t < nt; t += 2) {
            const bool last = (t == nt - 2);
            const char* a1 = cA + (size_t)(t + 1) * kstep;
            const char* a2 = last ? nA : cA + (size_t)(t + 2) * kstep; const char* b2 = last ? nB : cB + (size_t)(t + 2) * kstep;
            const char* a3 = a2 + kstep; const char* b3 = b2 + kstep;
            if (last && has_next) S.a_ready(nxt);
            if constexpr (SP2) {
            PG8_LDB(B0, 0, 0); PG8_LDB(B1, 0, 1); PG8_SCHED; PG8_LDA(At, 0, 0); PG8_STAGE(PG8_SA(1, 1), a1 + hstepA, voffA);
            PG8_WAIT_V(8); PG8_WAIT_L(0); PG8_BAR; PG8_MMA(0, 0, At, B0); PG8_MMA(0, 1, At, B1); PG8_BAR; PG8_SCHED;
            PG8_LDA(At, 0, 1); PG8_STAGE(PG8_SB(0, 0), b2, voffB); PG8_STAGE(PG8_SB(0, 1), b2 + hstepB, voffB); PG8_STAGE(PG8_SA(0, 0), a2, voffA);
            PG8_WAIT_V(8); PG8_WAIT_L(0); PG8_BAR; PG8_MMA(1, 0, At, B0); PG8_MMA(1, 1, At, B1); PG8_BAR; PG8_SCHED;
            PG8_LDB(B0, 1, 0); PG8_LDB(B1, 1, 1); PG8_SCHED; PG8_LDA(At, 1, 0); PG8_STAGE(PG8_SA(0, 1), a2 + hstepA, voffA);
            PG8_WAIT_V(8); PG8_WAIT_L(0); PG8_BAR; PG8_MMA(0, 0, At, B0); PG8_MMA(0, 1, At, B1); PG8_BAR; PG8_SCHED;
            PG8_LDA(At, 1, 1); PG8_STAGE(PG8_SB(1, 0), b3, voffB); PG8_STAGE(PG8_SB(1, 1), b3 + hstepB, voffB); PG8_STAGE(PG8_SA(1, 0), a3, voffA);
            PG8_WAIT_V(8); PG8_WAIT_L(0); PG8_BAR; PG8_MMA(1, 0, At, B0); PG8_MMA(1, 1, At, B1); PG8_BAR; PG8_SCHED;
            } else {
            PG8_LDB(B0, 0, 0); PG8_SCHED; PG8_LDA(At, 0, 0); PG8_STAGE(PG8_SA(1, 1), a1 + hstepA, voffA);
            PG8_WAIT_L(8); PG8_BAR; PG8_WAIT_L(0); PG8_MMA(0, 0, At, B0); PG8_BAR; PG8_SCHED;
            PG8_LDB(B1, 0, 1); PG8_STAGE(PG8_SB(0, 0), b2, voffB);
            PG8_BAR; PG8_WAIT_L(0); PG8_MMA(0, 1, At, B1); PG8_BAR;
            PG8_LDA(At, 0, 1); PG8_STAGE(PG8_SA(0, 0), a2, voffA);
            PG8_BAR; PG8_WAIT_L(0); PG8_MMA(1, 0, At, B0); PG8_BAR; PG8_SCHED;
            PG8_STAGE(PG8_SB(0, 1), b2 + hstepB, voffB);
            PG8_WAIT_V(6); PG8_BAR; PG8_MMA(1, 1, At, B1); PG8_BAR;
            PG8_LDB(B0, 1, 0); PG8_SCHED; PG8_LDA(At, 1, 0); PG8_STAGE(PG8_SA(0, 1), a2 + hstepA, voffA);
            PG8_WAIT_L(8); PG8_BAR; PG8_WAIT_L(0); PG8_MMA(0, 0, At, B0); PG8_BAR; PG8_SCHED;
            PG8_LDB(B1, 1, 1); PG8_STAGE(PG8_SB(1, 0), b3, voffB);
            PG8_BAR; PG8_WAIT_L(0); PG8_MMA(0, 1, At, B1); PG8_BAR;
            PG8_LDA(At, 1, 1); PG8_STAGE(PG8_SA(1, 0), a3, voffA);
            PG8_BAR; PG8_WAIT_L(0); PG8_MMA(1, 0, At, B0); PG8_BAR; PG8_SCHED;
            PG8_STAGE(PG8_SB(1, 1), b3 + hstepB, voffB);
            PG8_WAIT_V(6); PG8_BAR; PG8_MMA(1, 1, At, B1); PG8_BAR;
            }
        }
        if constexpr (ALIGN_EPI) { if (wr == 0) PG8_BAR; }
        if constexpr (!Epi::AFTER_DRAIN) { E(acc, cur, wr, wc, fr, fq); S.done(cur); }
        if (!has_next) break;
#pragma unroll
        for (int a = 0; a < 2; ++a)
#pragma unroll
            for (int b = 0; b < 2; ++b)
#pragma unroll
                for (int m = 0; m < 4; ++m)
#pragma unroll
                    for (int n = 0; n < 2; ++n) acc[a][b][m][n] = (f32x4){0.f, 0.f, 0.f, 0.f};
        cur = nxt; cA = nA; cB = nB; ++ui;
        if constexpr (ALIGN_EPI) { if (wr == 1) PG8_BAR; }
    }
    PG8_WAIT_V(0);
    if constexpr (!ALIGN_EPI) { if (wr == 0) PG8_BAR; }
    PG8_BAR;
    if constexpr (Epi::AFTER_DRAIN) { E.fused(acc, cur, wr, wc, fr, fq, lds, wid, lane); S.done(cur); }
#undef PG8_SA
#undef PG8_SB
#undef PG8_STAGE
#undef PG8_LDA
#undef PG8_LDB
#undef PG8_MMA
#undef PG8_WAIT_V
#undef PG8_WAIT_L
#undef PG8_BAR
#undef PG8_SCHED
}
}

constexpr int DM = 4096, NBP = 4, SEQ = 2048, NBS = 16, DSEQ = 32, PAST = 1024;
constexpr int MP = NBP * SEQ, MS = NBS * DSEQ, M = MP + MS, NBT = NBP + NBS;
constexpr int WPOOL = 2048, WSSD = 6144, HD = 64, NH = 96, NS = 128, CONVD = 8192, IN_DIM = 18528, NPAD = 18688, DIN = 8192;
constexpr int C_U = 0, C_G = 2048, C_Z = 4096, C_X = 10240, C_B = C_X + 6144, C_C = C_B + 1024, C_DT = 18432;
constexpr float LN_EPS = 1e-5f, RMS_EPS = 1e-5f, ALPHA = 1.41421356237f;
constexpr size_t O_Y = 0, O_PP = 35651584, O_CP = 35897344, O_SP = 36093952, O_PS = 42385408, O_CS = 43368448, O_SS = 44154880, O_END = 69320704;
constexpr size_t MiB = 1u << 20;
constexpr size_t WS_CTL = 0, CTL_ZERO_BYTES = 1 * MiB, WS_MODF = 1 * MiB, WS_WIN = 4 * MiB, WIN_L = 146 * MiB, WS_WOUT = 296 * MiB, WOUT_L = 64 * MiB, WS_WP = 424 * MiB,
                 WS_H = 428 * MiB, WS_UP = 496 * MiB, WS_SG = 530 * MiB, WS_SZ = 564 * MiB, WS_XP = 666 * MiB, WS_XBC = 802 * MiB, WS_POOLED = 938 * MiB, WS_DTV = 972 * MiB,
                 WS_YG = 976 * MiB, WS_MIXED = 1078 * MiB, WS_R = 1214 * MiB, WS_X1 = 1350 * MiB, WS_SLAB = 1486 * MiB, WS_END = 1550 * MiB;
static_assert((size_t)NPAD * DM * 2 == WIN_L && (size_t)DM * DIN * 2 == WOUT_L && WS_SZ + (size_t)M * WSSD * 2 <= WS_XP && WS_XP + (size_t)M * CONVD * 2 <= WS_XBC && WS_SLAB + (size_t)8 * MS * DM * 4 <= WS_END, "ws map");
constexpr int CW_BAR = 4096;
constexpr int RING_BYTES = 131072, LDSCTL_OFF = RING_BYTES, MISC_OFF = LDSCTL_OFF + 320, LDS_BYTES = 155648;
constexpr int NWAVES = 8;
constexpr int NPHASE = 14;

struct EpiProj {
    typedef pg8::bf16_t bf16_t; typedef pg8::f32x4 f32x4; typedef pg8::u32x4 u32x4; typedef pg8::Unit Unit; static constexpr int BM = pg8::BM, HALF = pg8::HALF;
    static constexpr bool PERM = true, AFTER_DRAIN = false;
    unsigned char* ws; float* out; const float* dtb; int l;
    __device__ __forceinline__ void operator()(const f32x4 (&acc)[2][2][4][2], const Unit& u, int wr, int wc, int fr, int fq) const {
        asm volatile("" : "+v"(fr), "+v"(fq));
        const int pn = u.pn, row0 = u.pm * BM + wr * 64 + fr, cl = wc * 32 + 8 * fq;
        if (pn < 8 || (pn >= 40 && pn < 72)) {
            const bool pool = pn < 8; bf16_t* O = (bf16_t*)(ws + (pool ? WS_UP : WS_XP)); const int ldo = pool ? 2048 : 8192, c0 = (pool ? pn : pn - 40) * BM + cl, hist = pool ? 15 : 3;
#pragma unroll
            for (int ai = 0; ai < 2; ++ai)
#pragma unroll
                for (int m = 0; m < 4; ++m) { const int row = row0 + ai * HALF + m * 16;
#pragma unroll
                    for (int bj = 0; bj < 2; ++bj) { const f32x4 v0 = acc[ai][bj][m][0], v1 = acc[ai][bj][m][1];
                        u32x4 w; w.x = pg8::cvt_pk_bf16(v0[0], v0[1]); w.y = pg8::cvt_pk_bf16(v0[2], v0[3]); w.z = pg8::cvt_pk_bf16(v1[0], v1[1]); w.w = pg8::cvt_pk_bf16(v1[2], v1[3]);
                        *(u32x4*)(O + (size_t)row * ldo + c0 + bj * HALF) = w; }
                    asm volatile("" ::: "memory"); }
            if (u.pm >= 32 || (u.pm & 7) == 7) {
#pragma unroll
                for (int ai = 0; ai < 2; ++ai)
#pragma unroll
                    for (int m = 0; m < 4; ++m) { const int row = row0 + ai * HALF + m * 16;
                        const bool samp = row >= 8192; const int t = samp ? ((row - 8192) & 31) : (row & 2047), L = samp ? 32 : 2048, b = samp ? ((row - 8192) >> 5) : (row >> 11);
                        if (t >= L - hist) { float* nb = out + (samp ? (pool ? O_PS : O_CS) : (pool ? O_PP : O_CP)) + ((size_t)(l * (samp ? NBS : NBP) + b) * hist + (t - (L - hist))) * ldo + c0;
#pragma unroll
                            for (int bj = 0; bj < 2; ++bj) { *(f32x4*)(nb + bj * HALF) = acc[ai][bj][m][0]; *(f32x4*)(nb + bj * HALF + 4) = acc[ai][bj][m][1]; } }
                        asm volatile("" ::: "memory"); }
            }
        } else if (pn < 40) {
            const bool gp = pn < 16; bf16_t* O = (bf16_t*)(ws + (gp ? WS_SG : WS_SZ)); const int ldo = gp ? 2048 : 6144, c0 = (gp ? pn - 8 : pn - 16) * BM + cl;
#pragma unroll
            for (int ai = 0; ai < 2; ++ai)
#pragma unroll
                for (int m = 0; m < 4; ++m) { const int row = row0 + ai * HALF + m * 16;
#pragma unroll
                    for (int bj = 0; bj < 2; ++bj) { f32x4 v0 = acc[ai][bj][m][0], v1 = acc[ai][bj][m][1];
#pragma unroll
                        for (int j = 0; j < 4; ++j) { v0[j] = pg8::silu_f(v0[j]); v1[j] = pg8::silu_f(v1[j]); }
                        u32x4 w; w.x = pg8::cvt_pk_bf16(v0[0], v0[1]); w.y = pg8::cvt_pk_bf16(v0[2], v0[3]); w.z = pg8::cvt_pk_bf16(v1[0], v1[1]); w.w = pg8::cvt_pk_bf16(v1[2], v1[3]);
                        *(u32x4*)(O + (size_t)row * ldo + c0 + bj * HALF) = w; }
                    asm volatile("" ::: "memory"); }
        } else {
            if (cl < 96) {
#pragma unroll
                for (int n = 0; n < 2; ++n)
#pragma unroll
                    for (int j = 0; j < 4; ++j) { const int c = cl + 4 * n + j; const float bias = dtb[c];
#pragma unroll
                        for (int ai = 0; ai < 2; ++ai)
#pragma unroll
                            for (int m = 0; m < 4; ++m) { const float x = acc[ai][0][m][n][j] + bias;
                                ((float*)(ws + WS_DTV))[(size_t)c * 8704 + row0 + ai * HALF + m * 16] = fmaxf(x, 0.f) + log1pf(expf(-fabsf(x))); } }
            }
        }
    }
};

#define GAS __attribute__((address_space(1)))
#define LAS __attribute__((address_space(3)))
typedef unsigned short bf16;
typedef unsigned v4u __attribute__((ext_vector_type(4)));
typedef unsigned v2u __attribute__((ext_vector_type(2)));
typedef float f32x4 __attribute__((ext_vector_type(4)));
typedef float f32x2 __attribute__((ext_vector_type(2)));
#define LDS_WAIT() asm volatile("s_waitcnt lgkmcnt(0)" ::: "memory")
#define VM_WAIT() asm volatile("s_waitcnt vmcnt(0)" ::: "memory")
__device__ __forceinline__ unsigned f2bf(float f) { unsigned u = __builtin_bit_cast(unsigned, f); return (u + 0x7fffu + ((u >> 16) & 1u)) >> 16; }
__device__ __forceinline__ unsigned pk2(float lo, float hi) { return f2bf(lo) | (f2bf(hi) << 16); }
__device__ __forceinline__ float bf2f(unsigned short b) { return __builtin_bit_cast(float, ((unsigned)b) << 16); }
__device__ __forceinline__ float silu(float x) { return x / (1.0f + __expf(-x)); }
__device__ __forceinline__ float wave_sum(float v) {
#pragma unroll
    for (int o = 1; o < 64; o <<= 1) v += __shfl_xor(v, o);
    return v;
}

#define XB_TMO      128
#define XB_XCNT(j)  (256  + 64 * (j))
#define XB_XSUB(j)  (1280 + 64 * (j))
#define XB_XGEN(j)  (2304 + 64 * (j))
#define XB_TOP      3328
#define XB_TOPGEN   3392
#define XCD_BAR_WORDS 3456
#define XB_SPIN_CAP (1u << 18)
__device__ __forceinline__ unsigned xb_ld(unsigned* p)              { return __hip_atomic_load(p, __ATOMIC_RELAXED, __HIP_MEMORY_SCOPE_AGENT); }
__device__ __forceinline__ unsigned xb_add(unsigned* p, unsigned v) { return __hip_atomic_fetch_add(p, v, __ATOMIC_RELAXED, __HIP_MEMORY_SCOPE_AGENT); }
__device__ __forceinline__ unsigned xb_xcc_id() { return (unsigned)__builtin_amdgcn_s_getreg((3 << 11) | 20) & 0xFu; }
#define XB_SPIN(cond, bar) do { unsigned _sp = 0; while (cond) { __builtin_amdgcn_s_sleep(1); \
    if ((++_sp & 255u) == 0u) { if (xb_ld(&(bar)[XB_TMO])) break; if (_sp > XB_SPIN_CAP) { atomicAdd(&(bar)[XB_TMO], 1u); break; } } } } while (0)
struct XcdBarrier { unsigned* bar; unsigned x; volatile LAS unsigned* st; };
__device__ __forceinline__ XcdBarrier xcd_barrier_post(unsigned* bar, volatile LAS unsigned* st) {
    XcdBarrier b; b.bar = bar; b.x = xb_xcc_id(); b.st = st;
    if (threadIdx.x == 0) (void)xb_add(&bar[XB_XCNT(b.x)], 1u);
    return b;
}
__device__ __forceinline__ void xcd_barrier_complete(unsigned* bar, unsigned x, unsigned& nloc, unsigned& nx) {
    const unsigned G = gridDim.x * gridDim.y * gridDim.z;
    unsigned sum, cnt, mine, sp = 0u;
    for (;;) {
        sum = 0u; cnt = 0u; mine = 0u;
#pragma unroll
        for (unsigned j = 0; j < 16; ++j) { const unsigned c = xb_ld(&bar[XB_XCNT(j)]); sum += c; cnt += (c > 0u) ? 1u : 0u; mine = (j == x) ? c : mine; }
        if (sum == G) break;
        __builtin_amdgcn_s_sleep(1);
        if ((++sp & 255u) == 0u) { if (xb_ld(&bar[XB_TMO])) break; if (sp > XB_SPIN_CAP) { atomicAdd(&bar[XB_TMO], 1u); break; } }
    }
    nloc = mine > 0u ? mine : 1u; nx = cnt > 0u ? cnt : 1u;
}
__device__ __forceinline__ void xcd_barrier(const XcdBarrier& b) {
    asm volatile("s_waitcnt vmcnt(0)" ::: "memory");
    __syncthreads();
    if (threadIdx.x == 0) {
        unsigned* bar = b.bar;
        __builtin_amdgcn_s_waitcnt(0);
        unsigned nloc = b.st[0], nx = b.st[1];
        if (nloc == 0u) { xcd_barrier_complete(bar, b.x, nloc, nx); b.st[0] = nloc; b.st[1] = nx; }
        const unsigned old = xb_add(&bar[XB_XSUB(b.x)], 1u);
        const unsigned gen = old / nloc;
        if (old + 1u == (gen + 1u) * nloc) {
            __builtin_amdgcn_fence(__ATOMIC_RELEASE, "agent");
            asm volatile("s_waitcnt vmcnt(0)" ::: "memory");
            const unsigned og = xb_add(&bar[XB_TOP], 1u);
            const unsigned tg = og / nx;
            if (og + 1u == (tg + 1u) * nx) xb_add(&bar[XB_TOPGEN], 1u);
            else XB_SPIN(xb_ld(&bar[XB_TOPGEN]) == tg, bar);
            __builtin_amdgcn_fence(__ATOMIC_ACQUIRE, "agent");
            xb_add(&bar[XB_XGEN(b.x)], 1u);
            asm volatile("s_waitcnt vmcnt(0)" ::: "memory");
        } else {
            XB_SPIN(xb_ld(&bar[XB_XGEN(b.x)]) == gen, bar);
            __builtin_amdgcn_fence(__ATOMIC_ACQUIRE, "agent");
            asm volatile("s_waitcnt vmcnt(0)" ::: "memory");
        }
    }
    __syncthreads();
}

struct Args { const float* in[21]; float* out; unsigned char* ws; int ph_lo, ph_hi; };

__device__ __forceinline__ void p0_transpose_item(const float* W, int N, bf16* WT, int ldt, LAS float* scr, int kb, int nb, int lane) {
    const int k0 = 64 * kb, n0 = 32 * nb;
#pragma unroll 8
    for (int i = 0; i < 32; ++i) { const int kk = 2 * i + (lane >> 5); scr[kk * 33 + (lane & 31)] = W[(size_t)(k0 + kk) * N + n0 + (lane & 31)]; }
    LDS_WAIT(); asm volatile("" ::: "memory");
    const int c = lane & 7;
#pragma unroll
    for (int j = 0; j < 4; ++j) { const int n = (lane >> 3) + 8 * j; const LAS float* s = scr + (8 * c) * 33 + n;
        v4u o; o.x = pk2(s[0 * 33], s[1 * 33]); o.y = pk2(s[2 * 33], s[3 * 33]); o.z = pk2(s[4 * 33], s[5 * 33]); o.w = pk2(s[6 * 33], s[7 * 33]);
        *(GAS v4u*)(WT + (size_t)(n0 + n) * ldt + k0 + 8 * c) = o; }
    LDS_WAIT(); asm volatile("" ::: "memory");
}
__device__ __forceinline__ void p0_mod_item(const Args& a, LAS unsigned char* lds, int item, int tid, int lane, int wave) {
    const int l = item >> 7, cb = item & 127, e0 = cb * 96;
    const float* W = a.in[7] + (size_t)l * DM * 3 * DM;
    const float* cp = a.in[5]; const float* cs = a.in[6];
    LAS float* sl = (LAS float*)(lds + wave * 8192);
    f32x2 acc[20];
#pragma unroll
    for (int b = 0; b < 20; ++b) acc[b] = (f32x2){0.f, 0.f};
    const bool act = lane < 48;
    for (int ch = 0; ch < 8; ++ch) {
        const int d0 = wave * 512 + ch * 64;
#pragma unroll
        for (int b = 0; b < 20; ++b) { const float c = b < 4 ? cp[b * DM + d0 + lane] : cs[(b - 4) * DM + d0 + lane]; sl[lane * 20 + b] = c / (1.0f + expf(-c)); }
        LDS_WAIT(); asm volatile("" ::: "memory");
        for (int r = 0; r < 64; r += 8) {
            f32x2 wv[8];
#pragma unroll
            for (int j = 0; j < 8; ++j) wv[j] = act ? *(const f32x2*)(W + (size_t)(d0 + r + j) * (3 * DM) + e0 + 2 * lane) : (f32x2){0.f, 0.f};
#pragma unroll
            for (int j = 0; j < 8; ++j) { const LAS f32x4* sp = (const LAS f32x4*)(sl + (r + j) * 20);
#pragma unroll
                for (int q = 0; q < 5; ++q) { const f32x4 s4 = sp[q];
#pragma unroll
                    for (int c = 0; c < 4; ++c) acc[q * 4 + c] += wv[j] * s4[c]; } }
        }
        LDS_WAIT(); asm volatile("" ::: "memory");
    }
    LAS float* red = (LAS float*)(lds + 65536 + wave * 7680);
    if (act) {
#pragma unroll
        for (int b = 0; b < 20; ++b) *(LAS f32x2*)(red + b * 96 + 2 * lane) = acc[b]; }
    __syncthreads();
    float* modf = (float*)(a.ws + WS_MODF);
    for (int idx = tid; idx < 20 * 96; idx += NWAVES * 64) { float s = 0.f;
#pragma unroll
        for (int w = 0; w < 8; ++w) s += ((LAS float*)(lds + 65536 + w * 7680))[idx];
        const int b = idx / 96, e = idx % 96; modf[(size_t)(l * 20 + b) * (3 * DM) + e0 + e] = s + a.in[8][(size_t)l * 3 * DM + e0 + e]; }
    __syncthreads();
}
__device__ __forceinline__ void p0_prologue(const Args& a, LAS unsigned char* lds, int G, int bid, int tid, int lane, int wave) {
    for (int it = bid; it < 256; it += G) p0_mod_item(a, lds, it, tid, lane, wave);
    LAS float* scr = (LAS float*)(lds + wave * 16384);
    const int gw = bid * NWAVES + wave, NGW = G * NWAVES;
    constexpr int I_IN = 64 * 579, I_OUT = 128 * 128, I_P = 8 * 16;
    constexpr int NITEMS = 2 * I_IN + 2 * I_OUT + 8 * I_P;
    for (int it = gw; it < NITEMS; it += NGW) {
        int r = it;
        if (r < 2 * I_IN) { const int l = r / I_IN; r -= l * I_IN; p0_transpose_item(a.in[9] + (size_t)l * DM * IN_DIM, IN_DIM, (bf16*)(a.ws + WS_WIN + l * WIN_L), DM, scr, r / 579, r % 579, lane); continue; } r -= 2 * I_IN;
        if (r < 2 * I_OUT) { const int l = r / I_OUT; r -= l * I_OUT; p0_transpose_item(a.in[18] + (size_t)l * DIN * DM, DM, (bf16*)(a.ws + WS_WOUT + l * WOUT_L), DIN, scr, r / 128, r % 128, lane); continue; } r -= 2 * I_OUT;
        { const int lg = r / I_P; r -= lg * I_P; p0_transpose_item(a.in[10] + (size_t)lg * 512 * 512, 512, (bf16*)(a.ws + WS_WP) + (size_t)lg * 512 * 512, 512, scr, r / 16, r % 16, lane); }
    }
    for (int i = bid * NWAVES * 64 + tid; i < 2 * (NPAD - IN_DIM) * (DM / 8); i += G * NWAVES * 64) { const int l = i / ((NPAD - IN_DIM) * (DM / 8)), r = i % ((NPAD - IN_DIM) * (DM / 8));
        *(GAS v4u*)((bf16*)(a.ws + WS_WIN + l * WIN_L) + (size_t)IN_DIM * DM + (size_t)r * 8) = (v4u){0u, 0u, 0u, 0u}; }
}

__device__ __forceinline__ void row_stats(const f32x4 (&v)[16], float& mean, float& rstd) {
    float s = 0.f;
#pragma unroll
    for (int j = 0; j < 16; ++j) s += (v[j].x + v[j].y) + (v[j].z + v[j].w);
    mean = wave_sum(s) * (1.f / DM); float q = 0.f;
#pragma unroll
    for (int j = 0; j < 16; ++j) { const f32x4 d = v[j] - mean; q += (d.x * d.x + d.y * d.y) + (d.z * d.z + d.w * d.w); }
    rstd = 1.f / sqrtf(wave_sum(q) * (1.f / DM) + LN_EPS);
}
__device__ __forceinline__ int batch_of(int m) { return m < MP ? (m >> 11) : NBP + ((m - MP) >> 5); }
__device__ __forceinline__ void mod_row_to_bf16(const f32x4 (&v)[16], const float* md, bf16* hrow, int lane) {
    float mean, rstd; row_stats(v, mean, rstd);
#pragma unroll
    for (int j = 0; j < 16; ++j) { const f32x4 sh = ((const f32x4*)md)[lane + 64 * j], sc = ((const f32x4*)(md + DM))[lane + 64 * j];
        const f32x4 o = (v[j] - mean) * rstd * (sc + 1.0f) + sh;
        ((GAS v2u*)hrow)[lane + 64 * j] = (v2u){pk2(o.x, o.y), pk2(o.z, o.w)}; }
}
__device__ __forceinline__ void phase_a(const Args& a, int G, int bid, int lane, int wave) {
    const int gw = bid * NWAVES + wave, NGW = G * NWAVES;
    const float* modf = (const float*)(a.ws + WS_MODF); bf16* H = (bf16*)(a.ws + WS_H);
    for (int m = gw; m < M; m += NGW) {
        const float* xr = m < MP ? a.in[0] + (size_t)m * DM : a.in[1] + (size_t)(m - MP) * DM;
        f32x4 v[16];
#pragma unroll
        for (int j = 0; j < 16; ++j) v[j] = ((const f32x4*)xr)[lane + 64 * j];
        mod_row_to_bf16(v, modf + (size_t)batch_of(m) * 3 * DM, H + (size_t)m * DM, lane);
    }
}
__device__ __forceinline__ void phase_g(const Args& a, int l, int G, int bid, int lane, int wave) {
    const int gw = bid * NWAVES + wave, NGW = G * NWAVES;
    const float* modf = (const float*)(a.ws + WS_MODF); bf16* H = (bf16*)(a.ws + WS_H);
    const float* R = (const float*)(a.ws + WS_R); float* xo = l == 0 ? (float*)(a.ws + WS_X1) : a.out + O_Y;
    const float* lg = a.in[19] + (size_t)l * DM; const float* lb = a.in[20] + (size_t)l * DM;
    for (int m = gw; m < M; m += NGW) {
        f32x4 v[16];
        if (m < MP) {
#pragma unroll
            for (int j = 0; j < 16; ++j) v[j] = ((const f32x4*)(R + (size_t)m * DM))[lane + 64 * j];
        } else {
            const float* xr = (l == 0 ? a.in[1] : (const float*)(a.ws + WS_X1) + (size_t)MP * DM) + (size_t)(m - MP) * DM;
            const float* gr = modf + (size_t)(l * NBT + batch_of(m)) * 3 * DM + 2 * DM; const float* sl = (const float*)(a.ws + WS_SLAB) + (size_t)(m - MP) * DM;
#pragma unroll
            for (int j = 0; j < 16; ++j) { f32x4 o = ((const f32x4*)sl)[lane + 64 * j];
#pragma unroll
                for (int k = 1; k < 8; ++k) o += ((const f32x4*)(sl + (size_t)k * MS * DM))[lane + 64 * j];
                v[j] = ((const f32x4*)xr)[lane + 64 * j] * ALPHA + ((const f32x4*)gr)[lane + 64 * j] * o; }
        }
        float mean, rstd; row_stats(v, mean, rstd);
#pragma unroll
        for (int j = 0; j < 16; ++j) { v[j] = (v[j] - mean) * rstd * ((const f32x4*)lg)[lane + 64 * j] + ((const f32x4*)lb)[lane + 64 * j];
            ((GAS f32x4*)(xo + (size_t)m * DM))[lane + 64 * j] = v[j]; }
        if (l == 0) mod_row_to_bf16(v, modf + (size_t)(NBT + batch_of(m)) * 3 * DM, H + (size_t)m * DM, lane);
    }
}
__device__ __forceinline__ f32x4 ld_bf4(const bf16* p) { const v2u q = *(const v2u*)p; return (f32x4){bf2f((unsigned short)(q.x & 0xffffu)), bf2f((unsigned short)(q.x >> 16)), bf2f((unsigned short)(q.y & 0xffffu)), bf2f((unsigned short)(q.y >> 16))}; }
__device__ __forceinline__ f32x4 pool_hist(const bf16* pc, const float* st, bool samp, int t) {
    if (t >= 0) return ld_bf4(pc + (size_t)t * WPOOL);
    if (samp) return *(const f32x4*)(st + (size_t)(15 + t) * WPOOL);
    return (f32x4){0.f, 0.f, 0.f, 0.f};
}
__device__ __forceinline__ void phase_c(const Args& a, int l, int G, int bid, int tid) {
    for (int it = bid; it < 272 * 5; it += G) {
        const int seg = it / 5, cblk = it % 5, m0 = seg * 32;
        const bool samp = m0 >= MP; const int b = samp ? (m0 - MP) >> 5 : m0 >> 11, t0 = samp ? 0 : (m0 & 2047);
        if (cblk == 0) {
            const int j0 = 4 * tid, w = 2 << (j0 >> 9);
            const bf16* pc = (const bf16*)(a.ws + WS_UP) + (size_t)(m0 - t0) * WPOOL + j0;
            const float* st = a.in[2] + (size_t)(l * NBS + b) * 15 * WPOOL + j0;
            bf16* po = (bf16*)(a.ws + WS_POOLED) + (size_t)m0 * WPOOL + j0;
            f32x4 S = (f32x4){0.f, 0.f, 0.f, 0.f};
            for (int i = 1; i < w; ++i) S += pool_hist(pc, st, samp, t0 - i);
            for (int r = 0; r < 32; ++r) { const int t = t0 + r; const f32x4 u = pool_hist(pc, st, samp, t); S += u;
                const int pos = (samp ? PAST : 0) + t; const float cnt = (float)(pos + 1 < w ? pos + 1 : w);
                const f32x4 p = S / cnt - u;
                *(GAS v2u*)(po + (size_t)r * WPOOL) = (v2u){pk2(p.x, p.y), pk2(p.z, p.w)};
                S -= pool_hist(pc, st, samp, t - w + 1); }
        } else {
            const int j0 = (cblk - 1) * 2048 + 4 * tid;
            const float* cw = a.in[12] + (size_t)l * 4 * CONVD + j0;
            const f32x4 w0 = *(const f32x4*)cw, w1 = *(const f32x4*)(cw + CONVD), w2 = *(const f32x4*)(cw + 2 * CONVD), w3 = *(const f32x4*)(cw + 3 * CONVD), bs = *(const f32x4*)(a.in[13] + (size_t)l * CONVD + j0);
            const bf16* pc = (const bf16*)(a.ws + WS_XP) + (size_t)m0 * CONVD + j0;
            f32x4 p3 = (f32x4){0.f, 0.f, 0.f, 0.f}, p2 = p3, p1 = p3;
            if (samp) { const float* st = a.in[3] + (size_t)(l * NBS + b) * 3 * CONVD + j0; p3 = *(const f32x4*)st; p2 = *(const f32x4*)(st + CONVD); p1 = *(const f32x4*)(st + 2 * CONVD); }
            else if (t0 != 0) { p3 = ld_bf4(pc - 3 * (size_t)CONVD); p2 = ld_bf4(pc - 2 * (size_t)CONVD); p1 = ld_bf4(pc - (size_t)CONVD); }
            bf16* xo = (bf16*)(a.ws + WS_XBC) + (size_t)m0 * CONVD + j0;
            for (int r = 0; r < 32; ++r) { const f32x4 cur = ld_bf4(pc + (size_t)r * CONVD);
                f32x4 o = w0 * p3 + w1 * p2 + w2 * p1 + w3 * cur + bs;
                o.x = silu(o.x); o.y = silu(o.y); o.z = silu(o.z); o.w = silu(o.w);
                *(GAS v2u*)(xo + (size_t)r * CONVD) = (v2u){pk2(o.x, o.y), pk2(o.z, o.w)};
                p3 = p2; p2 = p1; p1 = cur; }
        }
    }
}
typedef short s16x4 __attribute__((ext_vector_type(4)));
typedef short s16x8 __attribute__((ext_vector_type(8)));
constexpr int SSD_STAGE = 49152, SSD_XX = 0, SSD_BS = 16384, SSD_CS = 32768, SSD_HB = 98304, SSD_TAB = 135168;
__device__ __forceinline__ unsigned off_b(unsigned row, unsigned ch) { return 256u * row + 16u * (ch ^ (((row & 3u) << 2) | ((row >> 2) & 3u))); }
__device__ __forceinline__ s16x8 tr_frag(LAS unsigned char* img, int lane, int c, int ks) {
    const unsigned g = (unsigned)lane >> 4, qq = ((unsigned)lane & 15u) >> 2, pp = (unsigned)lane & 3u;
    const unsigned a0 = off_b(32u * ks + 8u * g + qq, 2u * c + (pp >> 1)) + 8u * (pp & 1u), a1 = off_b(32u * ks + 8u * g + 4u + qq, 2u * c + (pp >> 1)) + 8u * (pp & 1u);
    const s16x4 lo = __builtin_amdgcn_ds_read_tr16_b64_v4i16((LAS s16x4*)(img + a0)), hi = __builtin_amdgcn_ds_read_tr16_b64_v4i16((LAS s16x4*)(img + a1));
    return __builtin_shufflevector(lo, hi, 0, 1, 2, 3, 4, 5, 6, 7);
}
__device__ __forceinline__ s16x8 row_frag(LAS unsigned char* img, int row, int ch) { return *(const LAS s16x8*)(img + off_b((unsigned)row, (unsigned)ch)); }
__device__ __forceinline__ float ex2(float x) { return __builtin_amdgcn_exp2f(x); }
__device__ __forceinline__ unsigned scale_pk(unsigned v, float w) { return pk2(bf2f((unsigned short)(v & 0xffffu)) * w, bf2f((unsigned short)(v >> 16)) * w); }

__device__ __forceinline__ void ssd_unit(const Args& a, LAS unsigned char* lds, int l, int unit, int tid) {
    const int lane = tid & 63, wave = __builtin_amdgcn_readfirstlane(tid >> 6), r16 = lane & 15, q = lane >> 4;
    const int lt = wave & 3, ph = wave >> 2;
    const bool samp = unit >= NBP * NH; const int u2 = samp ? unit - NBP * NH : unit; const int b = u2 / NH, h = u2 % NH, g = h / 12;
    const int nchunk = samp ? 1 : SEQ / 64, vr = samp ? DSEQ : 64, mbase = samp ? MP + b * DSEQ : b * SEQ;
    const float A2 = -expf(a.in[15][l * NH + h]) * 1.44269504089f, Dk = a.in[16][l * NH + h];
    const bf16* xbc = (const bf16*)(a.ws + WS_XBC); const bf16* sz = (const bf16*)(a.ws + WS_SZ); const float* dtt = (const float*)(a.ws + WS_DTV) + (size_t)h * M + mbase; bf16* yg = (bf16*)(a.ws + WS_YG);
    const int xrow = tid >> 3, xch = tid & 7, brow = tid >> 4, bch = tid & 15;
    const int lrow = 16 * lt + r16;
    v4u xr, br[2], cr[2]; v2u zr[2]; float dtl;
    const v4u zero4 = (v4u){0u, 0u, 0u, 0u};
#define SSD_LOAD(c) do { const size_t m0_ = (size_t)mbase + 64 * (size_t)(c); \
        xr = xrow < vr ? *(const v4u*)(xbc + (m0_ + xrow) * CONVD + h * HD + 8 * xch) : zero4; \
        _Pragma("unroll") for (int i_ = 0; i_ < 2; ++i_) { const int row_ = brow + 32 * i_; const bf16* rp_ = xbc + (m0_ + row_) * CONVD + WSSD + g * NS + 8 * bch; \
            br[i_] = row_ < vr ? *(const v4u*)rp_ : zero4; cr[i_] = row_ < vr ? *(const v4u*)(rp_ + 1024) : zero4; } \
        _Pragma("unroll") for (int j_ = 0; j_ < 2; ++j_) zr[j_] = lrow < vr ? *(const v2u*)(sz + (m0_ + lrow) * WSSD + h * HD + 16 * (2 * ph + j_) + 4 * q) : (v2u){0u, 0u}; \
        dtl = lane < vr ? dtt[64 * (c) + lane] : 0.f; } while (0)
#define SSD_STAGE_WRITE(i_) do { LAS float* tb_ = (LAS float*)(lds + SSD_TAB + (2 * wave + (i_)) * 1024); float cs_ = dtl * A2; \
        _Pragma("unroll") for (int o_ = 1; o_ < 64; o_ <<= 1) { const float t_ = __shfl_up(cs_, o_); cs_ += lane >= o_ ? t_ : 0.f; } \
        const float tot_ = __shfl(cs_, 63); tb_[lane] = cs_; tb_[64 + lane] = dtl; tb_[128 + lane] = dtl * ex2(tot_ - cs_); \
        LDS_WAIT(); asm volatile("" ::: "memory"); \
        LAS unsigned char* st_ = lds + (i_) * SSD_STAGE; const float w_ = tb_[128 + xrow]; \
        *(LAS v4u*)(st_ + SSD_XX + off_b(xrow, xch)) = xr; \
        *(LAS v4u*)(st_ + SSD_XX + off_b(xrow, 8 + xch)) = (v4u){scale_pk(xr.x, w_), scale_pk(xr.y, w_), scale_pk(xr.z, w_), scale_pk(xr.w, w_)}; \
        _Pragma("unroll") for (int i2_ = 0; i2_ < 2; ++i2_) { *(LAS v4u*)(st_ + SSD_BS + off_b(brow + 32 * i2_, bch)) = br[i2_]; *(LAS v4u*)(st_ + SSD_CS + off_b(brow + 32 * i2_, bch)) = cr[i2_]; } } while (0)
#define SSD_BAR() do { asm volatile("s_waitcnt lgkmcnt(0)" ::: "memory"); __builtin_amdgcn_s_barrier(); asm volatile("" ::: "memory"); } while (0)

    f32x4 Hacc[2][2];
#pragma unroll
    for (int i = 0; i < 2; ++i)
#pragma unroll
        for (int j = 0; j < 2; ++j) Hacc[i][j] = samp ? *(const f32x4*)(a.in[4] + ((size_t)((l * NBS + b) * NH + h) * HD + 16 * (2 * ph + j) + r16) * NS + 16 * (2 * lt + i) + 4 * q) : (f32x4){0.f, 0.f, 0.f, 0.f};
    SSD_LOAD(0);
    v2u zc[2] = {zr[0], zr[1]};
    SSD_STAGE_WRITE(0);
#define SSD_HWRITE(i_) do { LAS unsigned char* hb_ = lds + SSD_HB + (i_) * 16384; \
        _Pragma("unroll") for (int i2_ = 0; i2_ < 2; ++i2_) _Pragma("unroll") for (int j2_ = 0; j2_ < 2; ++j2_) { const f32x4 v_ = Hacc[i2_][j2_]; \
            *(LAS v2u*)(hb_ + off_b(16 * (2 * ph + j2_) + r16, 2 * (2 * lt + i2_) + (q >> 1)) + 8 * (q & 1)) = (v2u){pk2(v_.x, v_.y), pk2(v_.z, v_.w)}; } } while (0)
    SSD_HWRITE(0);
    SSD_BAR();
    for (int c = 0; c < nchunk; ++c) {
        const bool more = c + 1 < nchunk;
        if (more) SSD_LOAD(c + 1);
        LAS unsigned char* st = lds + (c & 1) * SSD_STAGE; LAS unsigned char* hb = lds + SSD_HB + (c & 1) * 16384; LAS float* tb = (LAS float*)(lds + SSD_TAB + (2 * wave + (c & 1)) * 1024);
        s16x8 cf[4];
#pragma unroll
        for (int kk = 0; kk < 4; ++kk) cf[kk] = row_frag(st + SSD_CS, lrow, 4 * kk + q);
        f32x4 acc[2] = {(f32x4){0.f, 0.f, 0.f, 0.f}, (f32x4){0.f, 0.f, 0.f, 0.f}};
#pragma unroll
        for (int j = 0; j < 2; ++j)
#pragma unroll
            for (int kk = 0; kk < 4; ++kk) acc[j] = __builtin_amdgcn_mfma_f32_16x16x32_bf16(row_frag(hb, 16 * (2 * ph + j) + r16, 4 * kk + q), cf[kk], acc[j], 0, 0, 0);
        const float acl = tb[lrow], el = ex2(acl);
        acc[0] = acc[0] * el; acc[1] = acc[1] * el;
#pragma unroll
        for (int k2 = 0; k2 < 2; ++k2) if (k2 <= (lt >> 1)) {
            f32x4 gx = (f32x4){0.f, 0.f, 0.f, 0.f}, gy = gx;
            const int sx = 32 * k2 + 8 * (r16 >> 2) + (r16 & 3);
#pragma unroll
            for (int kk = 0; kk < 4; ++kk) { gx = __builtin_amdgcn_mfma_f32_16x16x32_bf16(row_frag(st + SSD_BS, sx, 4 * kk + q), cf[kk], gx, 0, 0, 0);
                                             gy = __builtin_amdgcn_mfma_f32_16x16x32_bf16(row_frag(st + SSD_BS, sx + 4, 4 * kk + q), cf[kk], gy, 0, 0, 0); }
            const int s0 = 32 * k2 + 8 * q;
            const f32x4 as0 = *(const LAS f32x4*)(tb + s0), as1 = *(const LAS f32x4*)(tb + s0 + 4), d0 = *(const LAS f32x4*)(tb + 64 + s0), d1 = *(const LAS f32x4*)(tb + 64 + s0 + 4);
#pragma unroll
            for (int e = 0; e < 4; ++e) { gx[e] = (s0 + e <= lrow) ? gx[e] * ex2(acl - as0[e]) * d0[e] : 0.f; gy[e] = (s0 + 4 + e <= lrow) ? gy[e] * ex2(acl - as1[e]) * d1[e] : 0.f; }
            const s16x8 gms = __builtin_bit_cast(s16x8, (v4u){pk2(gx[0], gx[1]), pk2(gx[2], gx[3]), pk2(gy[0], gy[1]), pk2(gy[2], gy[3])});
#pragma unroll
            for (int j = 0; j < 2; ++j) acc[j] = __builtin_amdgcn_mfma_f32_16x16x32_bf16(tr_frag(st + SSD_XX, lane, 2 * ph + j, k2), gms, acc[j], 0, 0, 0);
        }
#pragma unroll
        for (int j = 0; j < 2; ++j) { const int p0 = 16 * (2 * ph + j) + 4 * q;
            const v2u xw = *(const LAS v2u*)(st + SSD_XX + off_b(lrow, p0 >> 3) + 2 * (p0 & 7));
            f32x4 y = acc[j] + Dk * (f32x4){bf2f((unsigned short)(xw.x & 0xffffu)), bf2f((unsigned short)(xw.x >> 16)), bf2f((unsigned short)(xw.y & 0xffffu)), bf2f((unsigned short)(xw.y >> 16))};
            y = y * (f32x4){bf2f((unsigned short)(zc[j].x & 0xffffu)), bf2f((unsigned short)(zc[j].x >> 16)), bf2f((unsigned short)(zc[j].y & 0xffffu)), bf2f((unsigned short)(zc[j].y >> 16))};
            if (lrow < vr) *(GAS v2u*)(yg + ((size_t)mbase + 64 * c + lrow) * WSSD + h * HD + p0) = (v2u){pk2(y.x, y.y), pk2(y.z, y.w)}; }
        const float cd = ex2(tb[63]);
#pragma unroll
        for (int i = 0; i < 2; ++i)
#pragma unroll
            for (int j = 0; j < 2; ++j) Hacc[i][j] = Hacc[i][j] * cd;
#pragma unroll
        for (int k2 = 0; k2 < 2; ++k2) { s16x8 bt[2], xs[2];
#pragma unroll
            for (int i = 0; i < 2; ++i) { bt[i] = tr_frag(st + SSD_BS, lane, 2 * lt + i, k2); xs[i] = tr_frag(st + SSD_XX, lane, 4 + 2 * ph + i, k2); }
#pragma unroll
            for (int i = 0; i < 2; ++i)
#pragma unroll
                for (int j = 0; j < 2; ++j) Hacc[i][j] = __builtin_amdgcn_mfma_f32_16x16x32_bf16(bt[i], xs[j], Hacc[i][j], 0, 0, 0); }
        if (more) { SSD_HWRITE((c + 1) & 1); SSD_STAGE_WRITE((c + 1) & 1); zc[0] = zr[0]; zc[1] = zr[1]; }
        SSD_BAR();
    }
    float* so = a.out + (samp ? O_SS : O_SP) + (size_t)((l * (samp ? NBS : NBP) + b) * NH + h) * HD * NS;
#pragma unroll
    for (int i = 0; i < 2; ++i)
#pragma unroll
        for (int j = 0; j < 2; ++j) *(GAS f32x4*)(so + (size_t)(16 * (2 * ph + j) + r16) * NS + 16 * (2 * lt + i) + 4 * q) = Hacc[i][j];
#undef SSD_LOAD
#undef SSD_STAGE_WRITE
#undef SSD_HWRITE
#undef SSD_BAR
}
__device__ __forceinline__ void phase_e(const Args& a, int l, int G, int bid, int lane, int wave) {
    const int gw = bid * NWAVES + wave, NGW = G * NWAVES;
    const bf16* yg = (const bf16*)(a.ws + WS_YG); bf16* mx = (bf16*)(a.ws + WS_MIXED);
    for (int it = gw; it < M * 8; it += NGW) { const int m = it >> 3, g = it & 7;
        const bf16* yr = yg + (size_t)m * WSSD + g * 768; f32x4 v[3]; float ss = 0.f;
#pragma unroll
        for (int j = 0; j < 3; ++j) { v[j] = ld_bf4(yr + 4 * (lane + 64 * j)); ss += (v[j].x * v[j].x + v[j].y * v[j].y) + (v[j].z * v[j].z + v[j].w * v[j].w); }
        const float rstd = 1.f / sqrtf(wave_sum(ss) * (1.f / 768.f) + RMS_EPS);
        const f32x4* nw = (const f32x4*)(a.in[17] + (size_t)l * WSSD + g * 768);
#pragma unroll
        for (int j = 0; j < 3; ++j) { const f32x4 o = v[j] * rstd * nw[lane + 64 * j];
            ((GAS v2u*)(mx + (size_t)m * DIN + WPOOL + g * 768))[lane + 64 * j] = (v2u){pk2(o.x, o.y), pk2(o.z, o.w)}; }
    }
}

__global__ void __launch_bounds__(NWAVES * 64, 2) trunk_fwd(Args args) {
    extern __shared__ __attribute__((aligned(16))) unsigned char lds_raw[];
    LAS unsigned char* lds = (LAS unsigned char*)lds_raw;
    volatile LAS unsigned* MISC = (volatile LAS unsigned*)(lds + MISC_OFF);
    const int tid = threadIdx.x, lane = tid & 63, wave = __builtin_amdgcn_readfirstlane(tid >> 6);
    const int G = gridDim.x, bid = blockIdx.x;
    unsigned* ctl = (unsigned*)(args.ws + WS_CTL);
    for (int u = tid; u < (LDS_BYTES - LDSCTL_OFF) / 4; u += NWAVES * 64) ((LAS unsigned*)(lds + LDSCTL_OFF))[u] = 0u;
    __syncthreads();
    const int lo = args.ph_lo, hi = args.ph_hi;
    XcdBarrier bar; bar.bar = ctl + CW_BAR; bar.x = 0; bar.st = MISC + 8;
    if (hi - lo > 1) bar = xcd_barrier_post(ctl + CW_BAR, MISC + 8);
#ifndef PROBE_MASK
#define PROBE_MASK 0
#endif
#define REP(kind) for (int _r = 0; _r < (((PROBE_MASK) >> (kind)) & 1 ? 2 : 1); ++_r)
#define IN(k) (lo <= (k) && (k) < hi)
#define BOTH(k) (IN(k) && IN((k) + 1))
#define SEAM(k) do { if (BOTH(k)) xcd_barrier(bar); } while (0)

    if (IN(0)) { REP(0) p0_prologue(args, lds, G, bid, tid, lane, wave); SEAM(0); }
    if (IN(1)) { REP(1) phase_a(args, G, bid, lane, wave); SEAM(1); }
    for (int l = 0; l < 2; ++l) {
        const int pb = 2 + 6 * l;
        int tl = threadIdx.x; asm volatile("" : "+v"(tl));
        const int lanel = tl & 63, wavel = __builtin_amdgcn_readfirstlane(tl >> 6);
        if (IN(pb)) {
            pg8::Gemm g{(const pg8::bf16_t*)(args.ws + WS_H), (const pg8::bf16_t*)(args.ws + WS_WIN + (size_t)l * WIN_L), M, NPAD, DM, DM, DM, 0, 0};
            pg8::StaticOrder S; S.init(M, NPAD, G, bid);
            EpiProj E{args.ws, args.out, args.in[14] + (size_t)l * NH, l};
            pg8::gemm_phase<EpiProj, pg8::StaticOrder, true, true>(lds, g, S, E, tl);
#if (PROBE_MASK >> 2) & 1
            __syncthreads(); pg8::gemm_phase<EpiProj, pg8::StaticOrder, true, true>(lds, g, S, E, tl);
#endif
            SEAM(pb);
        }
        if (IN(pb + 1)) { REP(3) phase_c(args, l, G, bid, tl); SEAM(pb + 1); }
        if (IN(pb + 2)) {
            { pg8::Gemm g{(const pg8::bf16_t*)(args.ws + WS_POOLED), (const pg8::bf16_t*)(args.ws + WS_WP) + (size_t)l * 4 * 512 * 512, M, 512, 512, WPOOL, 512, 512, (size_t)512 * 512};
              pg8::GroupOrder S; S.init(M, 512, 4, G, bid);
              pg8::EpiPool E{(pg8::bf16_t*)(args.ws + WS_MIXED), DIN, (const pg8::bf16_t*)(args.ws + WS_SG), WPOOL, args.in[11] + (size_t)l * WPOOL};
              pg8::gemm_phase<pg8::EpiPool, pg8::GroupOrder, true, true>(lds, g, S, E, tl);
#if (PROBE_MASK >> 4) & 1
            __syncthreads(); pg8::gemm_phase<pg8::EpiPool, pg8::GroupOrder, true, true>(lds, g, S, E, tl);
#endif
 }
            __syncthreads();
            REP(5) for (int k = 0; ; ++k) {
                int u;
                if (G == 256) { if (k >= (bid < 128 ? 2 : 13)) break; u = k == 0 ? bid : (bid < 128 ? 256 + bid : NBP * NH + (bid - 128) * 12 + (k - 1)); }
                else { u = bid + k * G; if (u >= (NBP + NBS) * NH) break; }
                ssd_unit(args, lds, l, u, tl); }
            SEAM(pb + 2);
        }
        if (IN(pb + 3)) { REP(6) phase_e(args, l, G, bid, lanel, wavel); SEAM(pb + 3); }
        if (IN(pb + 4)) {
            { pg8::Gemm g{(const pg8::bf16_t*)(args.ws + WS_MIXED), (const pg8::bf16_t*)(args.ws + WS_WOUT + (size_t)l * WOUT_L), MP, DM, DIN, DIN, DIN, 0, 0};
              pg8::StaticOrder S; S.init(MP, DM, G, bid);
              const float* xp = l == 0 ? args.in[0] : (const float*)(args.ws + WS_X1); const float* xs = l == 0 ? args.in[1] : (const float*)(args.ws + WS_X1) + (size_t)MP * DM;
              pg8::EpiResid E{(float*)(args.ws + WS_R), DM, xp, xs, (const float*)(args.ws + WS_MODF) + (size_t)l * NBT * 3 * DM + 2 * DM, 3 * DM, ALPHA};
              pg8::gemm_phase<pg8::EpiResid, pg8::StaticOrder, true, true>(lds, g, S, E, tl);
#if (PROBE_MASK >> 7) & 1
              __syncthreads(); pg8::gemm_phase<pg8::EpiResid, pg8::StaticOrder, true, true>(lds, g, S, E, tl);
#endif
            }
            __syncthreads();
            { pg8::Gemm g{(const pg8::bf16_t*)(args.ws + WS_MIXED) + (size_t)MP * DIN, (const pg8::bf16_t*)(args.ws + WS_WOUT + (size_t)l * WOUT_L), MS, DM, DIN / 8, DIN, DIN, (size_t)(DIN / 8), (size_t)(DIN / 8)};
              pg8::GroupOrder S; S.init(MS, DM, 8, G, bid);
              pg8::EpiSlab E{(float*)(args.ws + WS_SLAB), DM, (size_t)MS * DM};
              pg8::gemm_phase<pg8::EpiSlab, pg8::GroupOrder, true, true>(lds, g, S, E, tl); }
            SEAM(pb + 4);
        }
        if (IN(pb + 5)) { REP(8) phase_g(args, l, G, bid, lanel, wavel); if (pb + 5 < NPHASE - 1) SEAM(pb + 5); }
    }
#undef IN
#undef BOTH
#undef SEAM
}

#ifndef MK_SPLIT
#define MK_SPLIT 0
#endif
extern "C" void kernel_launch(void* const* d_in, const int* in_sizes, int n_in, void* d_out, int out_size, void* d_ws, size_t ws_size, hipStream_t stream) {
    static int grid = 0;
    if (grid == 0) {
        if (n_in != 21 || (size_t)out_size != O_END || ws_size < WS_END) { fprintf(stderr, "kernel_launch: unexpected shapes: n_in %d out %d ws %zu; nothing launched\n", n_in, out_size, ws_size); grid = -1; return; }
        int dev = 0, cus = 0, per_cu = 0;
        if (hipGetDevice(&dev) != hipSuccess || hipDeviceGetAttribute(&cus, hipDeviceAttributeMultiprocessorCount, dev) != hipSuccess) { grid = -1; return; }
        if (hipFuncSetAttribute((const void*)trunk_fwd, hipFuncAttributeMaxDynamicSharedMemorySize, LDS_BYTES) != hipSuccess) { fprintf(stderr, "kernel_launch: hipFuncSetAttribute failed\n"); grid = -1; return; }
        if (hipOccupancyMaxActiveBlocksPerMultiprocessor(&per_cu, (const void*)trunk_fwd, NWAVES * 64, LDS_BYTES) != hipSuccess || per_cu < 1) { fprintf(stderr, "kernel_launch: occupancy query says %d blocks per CU\n", per_cu); (void)hipGetLastError(); grid = -1; return; }
        grid = cus;
    }
    if (grid < 0) return;
    if (hipMemsetAsync((char*)d_ws + WS_CTL, 0, CTL_ZERO_BYTES, stream) != hipSuccess) return;
    Args a{};
    for (int i = 0; i < 21; ++i) a.in[i] = (const float*)d_in[i];
    a.out = (float*)d_out; a.ws = (unsigned char*)d_ws;
#if MK_SPLIT
    for (int ph = 0; ph < NPHASE; ++ph) { a.ph_lo = ph; a.ph_hi = ph + 1; hipLaunchKernelGGL(trunk_fwd, dim3(grid), dim3(NWAVES * 64), LDS_BYTES, stream, a); }
#else
    a.ph_lo = 0; a.ph_hi = NPHASE; hipLaunchKernelGGL(trunk_fwd, dim3(grid), dim3(NWAVES * 64), LDS_BYTES, stream, a);
#endif
}
```

```cpp
#ifndef PROBE_MASK
#define PROBE_MASK 0
#endif
#include <hip/hip_runtime.h>
#include <cstdio>
#include <cstdint>
namespace pg8 {
#define PG8_LAS __attribute__((address_space(3)))
typedef unsigned short bf16_t;
typedef short bf16x8 __attribute__((ext_vector_type(8)));
typedef float f32x4 __attribute__((ext_vector_type(4)));
typedef unsigned u32x4 __attribute__((ext_vector_type(4)));
constexpr int BM = 256, BK = 64, HALF = 128, HTB = HALF * BK * 2  , STAGE_BYTES = 8 * HTB, NXCD = 8, WGM = 8;

__host__ __device__ __forceinline__ int lds_byte(int r, int c) { const int st = (r >> 4) * 2 + (c >> 5), rr = r & 15, cc = c & 31, ob = rr * 64 + cc * 2; return st * 1024 + (ob ^ (((ob >> 9) & 1) << 5)); }
__host__ __device__ __forceinline__ void stage_rc(int b, int& R, int& C) { const int st = b / 1024, sb = b % 1024, swz = sb ^ (((sb >> 9) & 1) << 5); R = (st >> 1) * 16 + swz / 64; C = (st & 1) * 32 + (swz % 64) / 2; }
__host__ __device__ __forceinline__ int perm32(int rho) { const int n = rho >> 4, i = rho & 15; return 8 * (i >> 2) + 4 * n + (i & 3); }

struct Unit { int pm, pn, g, ui; };
struct Gemm { const bf16_t* A; const bf16_t* Bt; int M, N, K, lda, ldb; size_t a_goff, b_goff; };

struct StaticOrder {
    int nM, nN, nwg, G, c;
    __host__ __device__ void init(int M, int N, int G_, int c_) { nM = M / BM; nN = N / BM; nwg = nM * nN; G = G_; c = c_; }
    __host__ __device__ bool next(int i, Unit& u) const {
        const long L = (long)i * G + c; if (L >= nwg) return false;
        int wgid = (int)L; { const int q = nwg / NXCD, r = nwg % NXCD, xcd = wgid % NXCD, off = wgid / NXCD; wgid = (xcd < r ? xcd * (q + 1) : r * (q + 1) + (xcd - r) * q) + off; }
        const int nig = WGM * nN, gid = wgid / nig, fm = gid * WGM, gsz = (nM - fm) < WGM ? (nM - fm) : WGM;
        u.pm = fm + ((wgid % nig) % gsz); u.pn = (wgid % nig) / gsz; u.g = 0; return true;
    }
    __device__ __forceinline__ void a_ready(const Unit&) const {}
    __device__ __forceinline__ void done(const Unit&) const {}
};
struct GroupOrder {
    int nM, nN, ng, G, c;
    __host__ __device__ void init(int M, int N, int ng_, int G_, int c_) { nM = M / BM; nN = N / BM; ng = ng_; G = G_; c = c_; }
    __host__ __device__ bool next(int i, Unit& u) const {
        const long L = (long)i * G + c; if (L >= (long)nM * nN * ng) return false;
        const int per = nM * nN, l = (int)L; u.g = l / per; const int r = l % per; u.pm = r % nM; u.pn = r / nM; return true;
    }
    __device__ __forceinline__ void a_ready(const Unit&) const {}
    __device__ __forceinline__ void done(const Unit&) const {}
};

typedef __bf16 hwbf16x2 __attribute__((ext_vector_type(2))); typedef float f32x2c __attribute__((ext_vector_type(2)));
__device__ __forceinline__ unsigned cvt_pk_bf16(float lo, float hi) { return __builtin_bit_cast(unsigned, __builtin_convertvector((f32x2c){lo, hi}, hwbf16x2)); }
__device__ __forceinline__ float silu_f(float x) { return x * __builtin_amdgcn_rcpf(1.0f + __expf(-x)); }

__device__ __forceinline__ f32x4 bf4_to_f32(unsigned lo, unsigned hi) { return (f32x4){__builtin_bit_cast(float, lo << 16), __builtin_bit_cast(float, lo & 0xffff0000u), __builtin_bit_cast(float, hi << 16), __builtin_bit_cast(float, hi & 0xffff0000u)}; }
constexpr int KTAB_OFF = 135168;
__device__ __forceinline__ void kscale_acc(f32x4 (&acc)[2][2][4][2], const PG8_LAS float* col, int wr, int fr) {
#pragma unroll
    for (int ai = 0; ai < 2; ++ai)
#pragma unroll
        for (int m = 0; m < 4; ++m) { const float f = col[ai * HALF + wr * 64 + m * 16 + fr];
#pragma unroll
            for (int bj = 0; bj < 2; ++bj)
#pragma unroll
                for (int n = 0; n < 2; ++n) acc[ai][bj][m][n] = acc[ai][bj][m][n] * f; }
}
struct EpiSlab {
    static constexpr bool PERM = false, AFTER_DRAIN = false, KHOOK = false;
    float* C; int ldc; size_t gstride;
    __device__ __forceinline__ void operator()(const f32x4 (&acc)[2][2][4][2], const Unit& u, int wr, int wc, int fr, int fq) const {
        asm volatile("" : "+v"(fr), "+v"(fq));
        const int row0 = u.pm * BM + wr * 64 + fr, col0 = u.pn * BM + wc * 32 + 4 * fq; float* Cg = C + (size_t)u.g * gstride;
#pragma unroll
        for (int ai = 0; ai < 2; ++ai)
#pragma unroll
            for (int m = 0; m < 4; ++m) { float* rowp = Cg + (size_t)(row0 + ai * HALF + m * 16) * ldc + col0;
#pragma unroll
                for (int bj = 0; bj < 2; ++bj)
#pragma unroll
                    for (int n = 0; n < 2; ++n) *(f32x4*)(rowp + bj * HALF + n * 16) = acc[ai][bj][m][n]; }
    }
};
struct EpiPool {
    static constexpr bool PERM = true, AFTER_DRAIN = false, KHOOK = false;
    bf16_t* O; int ldo; const bf16_t* sg; int ldp; const float* pscale;
    __device__ __forceinline__ void operator()(const f32x4 (&acc)[2][2][4][2], const Unit& u, int wr, int wc, int fr, int fq) const {
        asm volatile("" : "+v"(fr), "+v"(fq));
        const int row0 = u.pm * BM + wr * 64 + fr, col0 = u.g * 512 + u.pn * BM + wc * 32 + 8 * fq;
        f32x4 ps[2][2];
#pragma unroll
        for (int bj = 0; bj < 2; ++bj)
#pragma unroll
            for (int n = 0; n < 2; ++n) ps[bj][n] = *(const f32x4*)(pscale + col0 + bj * HALF + 4 * n);
#pragma unroll
        for (int ai = 0; ai < 2; ++ai)
#pragma unroll
            for (int m = 0; m < 4; ++m) { const size_t row = (size_t)(row0 + ai * HALF + m * 16);
#pragma unroll
                for (int bj = 0; bj < 2; ++bj) { const int c = col0 + bj * HALF;
                    const u32x4 gq = *(const u32x4*)(sg + row * ldp + c);
                    const f32x4 v0 = acc[ai][bj][m][0] * ps[bj][0] * bf4_to_f32(gq.x, gq.y), v1 = acc[ai][bj][m][1] * ps[bj][1] * bf4_to_f32(gq.z, gq.w);
                    u32x4 w; w.x = cvt_pk_bf16(v0[0], v0[1]); w.y = cvt_pk_bf16(v0[2], v0[3]); w.z = cvt_pk_bf16(v1[0], v1[1]); w.w = cvt_pk_bf16(v1[2], v1[3]);
                    *(u32x4*)(O + row * ldo + c) = w; } }
    }
};
struct EpiResid {
    static constexpr bool PERM = true, AFTER_DRAIN = false, KHOOK = true;
    bf16_t* R; int ldr; const float* xp; const float* gate; int ldg; float alpha; PG8_LAS unsigned char* lds;
    __device__ __forceinline__ void khook(f32x4 (&acc)[2][2][4][2], const Unit& u, int t, int wr, int fr) const {
        if (t >= 32 && (t - 32) % 12 == 0) kscale_acc(acc, (const PG8_LAS float*)(lds + KTAB_OFF) + (u.ui * 9 + (t - 32) / 12) * 256, wr, fr);
    }
    __device__ __forceinline__ void operator()(const f32x4 (&acc)[2][2][4][2], const Unit& u, int wr, int wc, int fr, int fq) const {
        asm volatile("" : "+v"(fr), "+v"(fq));
        const int row0 = u.pm * BM + wr * 64 + fr, col0 = u.pn * BM + wc * 32 + 8 * fq;
        const float* gr = gate + (size_t)(u.pm >> 3) * ldg + col0;
        f32x4 gv[2][2];
#pragma unroll
        for (int bj = 0; bj < 2; ++bj)
#pragma unroll
            for (int n = 0; n < 2; ++n) gv[bj][n] = *(const f32x4*)(gr + bj * HALF + 4 * n);
        u32x4 pk[2][4][2];
#pragma unroll
        for (int ai = 0; ai < 2; ++ai)
#pragma unroll
            for (int m = 0; m < 4; ++m) { const float s7 = ((const PG8_LAS float*)(lds + KTAB_OFF))[(u.ui * 9 + 8) * 256 + ai * HALF + wr * 64 + m * 16 + fr];
#pragma unroll
                for (int bj = 0; bj < 2; ++bj) { const f32x4 v0 = acc[ai][bj][m][0] * gv[bj][0] * s7, v1 = acc[ai][bj][m][1] * gv[bj][1] * s7;
                    pk[ai][m][bj] = (u32x4){cvt_pk_bf16(v0[0], v0[1]), cvt_pk_bf16(v0[2], v0[3]), cvt_pk_bf16(v1[0], v1[1]), cvt_pk_bf16(v1[2], v1[3])}; } }
#pragma unroll
        for (int ai = 0; ai < 2; ++ai) { f32x4 xv[4][2][2];
            __builtin_amdgcn_sched_barrier(0);
#pragma unroll
            for (int m = 0; m < 4; ++m) { const float* xr = xp + (size_t)(row0 + ai * HALF + m * 16) * 4096 + col0;
#pragma unroll
                for (int bj = 0; bj < 2; ++bj)
#pragma unroll
                    for (int n = 0; n < 2; ++n) xv[m][bj][n] = *(const f32x4*)(xr + bj * HALF + 4 * n); }
            __builtin_amdgcn_sched_barrier(0);
#pragma unroll
            for (int m = 0; m < 4; ++m) { bf16_t* rr = R + (size_t)(row0 + ai * HALF + m * 16) * ldr + col0;
#pragma unroll
                for (int bj = 0; bj < 2; ++bj) { const u32x4 t = pk[ai][m][bj];
                    const f32x4 o0 = xv[m][bj][0] * alpha + bf4_to_f32(t.x, t.y), o1 = xv[m][bj][1] * alpha + bf4_to_f32(t.z, t.w);
                    u32x4 w; w.x = cvt_pk_bf16(o0[0], o0[1]); w.y = cvt_pk_bf16(o0[2], o0[3]); w.z = cvt_pk_bf16(o1[0], o1[1]); w.w = cvt_pk_bf16(o1[2], o1[3]);
                    *(u32x4*)(rr + bj * HALF) = w; } } }
    }
};

template <class Epi, class Sched, bool ALIGN_EPI = false, bool SP2 = false>
__device__ __forceinline__ void gemm_phase(PG8_LAS unsigned char* lds, const Gemm g, const Sched& S, const Epi& E, const int tid) {
    const int wid = __builtin_amdgcn_readfirstlane(tid >> 6), lane = tid & 63, wr = wid >> 2, wc = wid & 3, fr = lane & 15, fq = lane >> 4;
    const int K = g.K, nt = K / BK;
    unsigned voffA[2], voffB[2];
#pragma unroll
    for (int i = 0; i < 2; ++i) { int R, C; stage_rc(tid * 16 + i * 8192, R, C); const int Rb = Epi::PERM ? ((R & ~31) + perm32(R & 31)) : R;
        voffA[i] = (unsigned)(R * g.lda + C) * 2u; voffB[i] = (unsigned)(Rb * g.ldb + C) * 2u; }
    const size_t kstep = (size_t)(BK * 2);
    const size_t hstepA = (size_t)HALF * g.lda * 2, hstepB = (size_t)HALF * g.ldb * 2;
    const size_t tstepA = 2 * hstepA, tstepB = 2 * hstepB;
    const unsigned ldsw = (unsigned)wid * 1024u;
    const int aoff = lds_byte(wr * 64 + fr, fq * 8), boff = lds_byte(wc * 32 + fr, fq * 8);
#define PG8_SA(b, h) (((b) * 2 + (h)) * HTB)
#define PG8_SB(b, h) ((4 + (b) * 2 + (h)) * HTB)
#define PG8_STAGE(bufoff, gbase, voff) do { _Pragma("unroll") for (int _i = 0; _i < 2; ++_i) \
        __builtin_amdgcn_global_load_lds((const unsigned*)((const char*)(gbase) + (voff)[_i]), (PG8_LAS unsigned*)(lds + (bufoff) + ldsw + _i * 8192), 16, 0, 0); } while (0)
#define PG8_LDA(dst, b, h) do { _Pragma("unroll") for (int m = 0; m < 4; ++m) _Pragma("unroll") for (int k = 0; k < 2; ++k) dst[m][k] = *(const PG8_LAS bf16x8*)(lds + PG8_SA(b, h) + aoff + m * 2048 + k * 1024); } while (0)
#define PG8_LDB(dst, b, h) do { _Pragma("unroll") for (int n = 0; n < 2; ++n) _Pragma("unroll") for (int k = 0; k < 2; ++k) dst[n][k] = *(const PG8_LAS bf16x8*)(lds + PG8_SB(b, h) + boff + n * 2048 + k * 1024); } while (0)
#define PG8_MMA(ai, bj, At, Bt) do { __builtin_amdgcn_s_setprio(1); _Pragma("unroll") for (int m = 0; m < 4; ++m) _Pragma("unroll") for (int n = 0; n < 2; ++n) _Pragma("unroll") for (int k = 0; k < 2; ++k) \
        acc[ai][bj][m][n] = __builtin_amdgcn_mfma_f32_16x16x32_bf16(Bt[n][k], At[m][k], acc[ai][bj][m][n], 0, 0, 0); __builtin_amdgcn_s_setprio(0); } while (0)
#define PG8_WAIT_V(n) asm volatile("s_waitcnt vmcnt(" #n ")" ::: "memory")
#define PG8_WAIT_L(n) asm volatile("s_waitcnt lgkmcnt(" #n ")" ::: "memory")
#define PG8_BAR __builtin_amdgcn_s_barrier()
#define PG8_SCHED __builtin_amdgcn_sched_barrier(0)
    Unit cur, nxt; int ui = 0;
    if (!S.next(0, cur)) return;
    cur.ui = 0;
    f32x4 acc[2][2][4][2];
#pragma unroll
    for (int a = 0; a < 2; ++a)
#pragma unroll
        for (int b = 0; b < 2; ++b)
#pragma unroll
            for (int m = 0; m < 4; ++m)
#pragma unroll
                for (int n = 0; n < 2; ++n) acc[a][b][m][n] = (f32x4){0.f, 0.f, 0.f, 0.f};
    bf16x8 At[4][2], B0[2][2], B1[2][2];
    const char* cA = (const char*)g.A + (size_t)cur.g * g.a_goff * 2 + (size_t)cur.pm * tstepA; const char* cB = (const char*)g.Bt + (size_t)cur.g * g.b_goff * 2 + (size_t)cur.pn * tstepB;
    S.a_ready(cur);
    if constexpr (SP2) {
        PG8_STAGE(PG8_SB(0, 0), cB, voffB); PG8_STAGE(PG8_SB(0, 1), cB + hstepB, voffB); PG8_STAGE(PG8_SA(0, 0), cA, voffA); PG8_STAGE(PG8_SA(0, 1), cA + hstepA, voffA);
        if (wr == 1) PG8_BAR;
        PG8_WAIT_V(2); PG8_BAR;
        PG8_STAGE(PG8_SB(1, 0), cB + kstep, voffB); PG8_STAGE(PG8_SA(1, 0), cA + kstep, voffA); PG8_STAGE(PG8_SB(1, 1), cB + hstepB + kstep, voffB);
        PG8_WAIT_V(6); PG8_BAR;
    } else {
        PG8_STAGE(PG8_SB(0, 0), cB, voffB); PG8_STAGE(PG8_SA(0, 0), cA, voffA); PG8_STAGE(PG8_SB(0, 1), cB + hstepB, voffB); PG8_STAGE(PG8_SA(0, 1), cA + hstepA, voffA);
        if (wr == 1) PG8_BAR;
        PG8_WAIT_V(4); PG8_BAR;
        PG8_STAGE(PG8_SB(1, 0), cB + kstep, voffB); PG8_STAGE(PG8_SA(1, 0), cA + kstep, voffA); PG8_STAGE(PG8_SB(1, 1), cB + hstepB + kstep, voffB);
        PG8_WAIT_V(6); PG8_BAR;
    }
    for (;;) {
        const bool has_next = S.next(ui + 1, nxt); nxt.ui = ui + 1;
        const char* nA = has_next ? (const char*)g.A + (size_t)nxt.g * g.a_goff * 2 + (size_t)nxt.pm * tstepA : cA; const char* nB = has_next ? (const char*)g.Bt + (size_t)nxt.g * g.b_goff * 2 + (size_t)nxt.pn * tstepB : cB;
        for (int t = 0; t < nt; t += 2) {
            const bool last = (t == nt - 2);
            const char* a1 = cA + (size_t)(t + 1) * kstep;
            const char* a2 = last ? nA : cA + (size_t)(t + 2) * kstep; const char* b2 = last ? nB : cB + (size_t)(t + 2) * kstep;
            const char* a3 = a2 + kstep; const char* b3 = b2 + kstep;
            if (last && has_next) S.a_ready(nxt);
            if constexpr (Epi::KHOOK) E.khook(acc, cur, t, wr, fr);
            if constexpr (SP2) {
            PG8_LDB(B0, 0, 0); PG8_LDB(B1, 0, 1); PG8_SCHED; PG8_LDA(At, 0, 0); PG8_STAGE(PG8_SA(1, 1), a1 + hstepA, voffA);
            PG8_WAIT_V(8); PG8_WAIT_L(0); PG8_BAR; PG8_MMA(0, 0, At, B0); PG8_MMA(0, 1, At, B1); PG8_BAR; PG8_SCHED;
            PG8_LDA(At, 0, 1); PG8_STAGE(PG8_SB(0, 0), b2, voffB); PG8_STAGE(PG8_SB(0, 1), b2 + hstepB, voffB); PG8_STAGE(PG8_SA(0, 0), a2, voffA);
            PG8_WAIT_V(8); PG8_WAIT_L(0); PG8_BAR; PG8_MMA(1, 0, At, B0); PG8_MMA(1, 1, At, B1); PG8_BAR; PG8_SCHED;
            PG8_LDB(B0, 1, 0); PG8_LDB(B1, 1, 1); PG8_SCHED; PG8_LDA(At, 1, 0); PG8_STAGE(PG8_SA(0, 1), a2 + hstepA, voffA);
            PG8_WAIT_V(8); PG8_WAIT_L(0); PG8_BAR; PG8_MMA(0, 0, At, B0); PG8_MMA(0, 1, At, B1); PG8_BAR; PG8_SCHED;
            PG8_LDA(At, 1, 1); PG8_STAGE(PG8_SB(1, 0), b3, voffB); PG8_STAGE(PG8_SB(1, 1), b3 + hstepB, voffB); PG8_STAGE(PG8_SA(1, 0), a3, voffA);
            PG8_WAIT_V(8); PG8_WAIT_L(0); PG8_BAR; PG8_MMA(1, 0, At, B0); PG8_MMA(1, 1, At, B1); PG8_BAR; PG8_SCHED;
            } else {
            PG8_LDB(B0, 0, 0); PG8_SCHED; PG8_LDA(At, 0, 0); PG8_STAGE(PG8_SA(1, 1), a1 + hstepA, voffA);
            PG8_WAIT_L(8); PG8_BAR; PG8_WAIT_L(0); PG8_MMA(0, 0, At, B0); PG8_BAR; PG8_SCHED;
            PG8_LDB(B1, 0, 1); PG8_STAGE(PG8_SB(0, 0), b2, voffB);
            PG8_BAR; PG8_WAIT_L(0); PG8_MMA(0, 1, At, B1); PG8_BAR;
            PG8_LDA(At, 0, 1); PG8_STAGE(PG8_SA(0, 0), a2, voffA);
            PG8_BAR; PG8_WAIT_L(0); PG8_MMA(1, 0, At, B0); PG8_BAR; PG8_SCHED;
            PG8_STAGE(PG8_SB(0, 1), b2 + hstepB, voffB);
            PG8_WAIT_V(6); PG8_BAR; PG8_MMA(1, 1, At, B1); PG8_BAR;
            PG8_LDB(B0, 1, 0); PG8_SCHED; PG8_LDA(At, 1, 0); PG8_STAGE(PG8_SA(0, 1), a2 + hstepA, voffA);
            PG8_WAIT_L(8); PG8_BAR; PG8_WAIT_L(0); PG8_MMA(0, 0, At, B0); PG8_BAR; PG8_SCHED;
            PG8_LDB(B1, 1, 1); PG8_STAGE(PG8_SB(1, 0), b3, voffB);
            PG8_BAR; PG8_WAIT_L(0); PG8_MMA(0, 1, At, B1); PG8_BAR;
            PG8_LDA(At, 1, 1); PG8_STAGE(PG8_SA(1, 0), a3, voffA);
            PG8_BAR; PG8_WAIT_L(0); PG8_MMA(1, 0, At, B0); PG8_BAR; PG8_SCHED;
            PG8_STAGE(PG8_SB(1, 1), b3 + hstepB, voffB);
            PG8_WAIT_V(6); PG8_BAR; PG8_MMA(1, 1, At, B1); PG8_BAR;
            }
        }
        if constexpr (ALIGN_EPI) { if (wr == 0) PG8_BAR; }
        if constexpr (!Epi::AFTER_DRAIN) { E(acc, cur, wr, wc, fr, fq); S.done(cur); }
        if (!has_next) break;
#pragma unroll
        for (int a = 0; a < 2; ++a)
#pragma unroll
            for (int b = 0; b < 2; ++b)
#pragma unroll
                for (int m = 0; m < 4; ++m)
#pragma unroll
                    for (int n = 0; n < 2; ++n) acc[a][b][m][n] = (f32x4){0.f, 0.f, 0.f, 0.f};
        cur = nxt; cA = nA; cB = nB; ++ui;
        if constexpr (ALIGN_EPI) { if (wr == 1) PG8_BAR; }
    }
    PG8_WAIT_V(0);
    if constexpr (!ALIGN_EPI) { if (wr == 0) PG8_BAR; }
    PG8_BAR;
    if constexpr (Epi::AFTER_DRAIN) { E.fused(acc, cur, wr, wc, fr, fq, lds, wid, lane); S.done(cur); }
#undef PG8_SA
#undef PG8_SB
#undef PG8_STAGE
#undef PG8_LDA
#undef PG8_LDB
#undef PG8_MMA
#undef PG8_WAIT_V
#undef PG8_WAIT_L
#undef PG8_BAR
#undef PG8_SCHED
}
}

constexpr int DM = 4096, NBP = 4, SEQ = 2048, NBS = 16, DSEQ = 32, PAST = 1024;
constexpr int MP = NBP * SEQ, MS = NBS * DSEQ, M = MP + MS, NBT = NBP + NBS;
constexpr int WPOOL = 2048, WSSD = 6144, HD = 64, NH = 96, NS = 128, CONVD = 8192, IN_DIM = 18528, NPAD = 18688, DIN = 8192;
constexpr int C_U = 0, C_G = 2048, C_Z = 4096, C_X = 10240, C_B = C_X + 6144, C_C = C_B + 1024, C_DT = 18432;
constexpr float LN_EPS = 1e-5f, RMS_EPS = 1e-5f, ALPHA = 1.41421356237f;
constexpr size_t O_Y = 0, O_PP = 35651584, O_CP = 35897344, O_SP = 36093952, O_PS = 42385408, O_CS = 43368448, O_SS = 44154880, O_END = 69320704;
constexpr size_t MiB = 1u << 20;
constexpr size_t WS_CTL = 0, CTL_ZERO_BYTES = 1 * MiB, WS_MODF = 1 * MiB, WS_WIN = 4 * MiB, WIN_L = 146 * MiB, WS_WOUT = 296 * MiB, WOUT_L = 64 * MiB, WS_WP = 424 * MiB,
                 WS_H = 428 * MiB, WS_UP = 496 * MiB, WS_SG = 530 * MiB, WS_SZ = 564 * MiB, WS_XP = 666 * MiB, WS_XBC = 802 * MiB, WS_POOLED = 938 * MiB, WS_DTV = 972 * MiB,
                 WS_YG = 976 * MiB, WS_MIXED = 1078 * MiB, WS_R = 1214 * MiB, WS_X1 = 1350 * MiB, WS_SLAB = 1486 * MiB, WS_END = 1550 * MiB;
static_assert((size_t)NPAD * DM * 2 == WIN_L && (size_t)DM * DIN * 2 == WOUT_L && WS_SZ + (size_t)M * WSSD * 2 <= WS_XP && WS_XP + (size_t)M * CONVD * 2 <= WS_XBC && WS_SLAB + (size_t)8 * MS * DM * 4 <= WS_END, "ws map");
constexpr int CW_MOD = 8128;
constexpr int CW_BAR = 4096;
constexpr int RING_BYTES = 131072, LDSCTL_OFF = RING_BYTES, MISC_OFF = LDSCTL_OFF + 320, LDS_BYTES = 155648;
constexpr int NWAVES = 8;
constexpr int NPHASE = 9;

struct EpiProj {
    typedef pg8::bf16_t bf16_t; typedef pg8::f32x4 f32x4; typedef pg8::u32x4 u32x4; typedef pg8::Unit Unit; static constexpr int BM = pg8::BM, HALF = pg8::HALF;
    static constexpr bool PERM = true, AFTER_DRAIN = false, KHOOK = false;
    unsigned char* ws; float* out; const float* dtb; int l;
    __device__ __forceinline__ void operator()(const f32x4 (&acc)[2][2][4][2], const Unit& u, int wr, int wc, int fr, int fq) const {
        asm volatile("" : "+v"(fr), "+v"(fq));
        const int pn = u.pn, row0 = u.pm * BM + wr * 64 + fr, cl = wc * 32 + 8 * fq;
        if (pn < 8 || (pn >= 40 && pn < 72)) {
            const bool pool = pn < 8; bf16_t* O = (bf16_t*)(ws + (pool ? WS_UP : WS_XP)); const int ldo = pool ? 2048 : 8192, c0 = (pool ? pn : pn - 40) * BM + cl, hist = pool ? 15 : 3;
#pragma unroll
            for (int ai = 0; ai < 2; ++ai)
#pragma unroll
                for (int m = 0; m < 4; ++m) { const int row = row0 + ai * HALF + m * 16;
#pragma unroll
                    for (int bj = 0; bj < 2; ++bj) { const f32x4 v0 = acc[ai][bj][m][0], v1 = acc[ai][bj][m][1];
                        u32x4 w; w.x = pg8::cvt_pk_bf16(v0[0], v0[1]); w.y = pg8::cvt_pk_bf16(v0[2], v0[3]); w.z = pg8::cvt_pk_bf16(v1[0], v1[1]); w.w = pg8::cvt_pk_bf16(v1[2], v1[3]);
                        *(u32x4*)(O + (size_t)row * ldo + c0 + bj * HALF) = w; }
                    asm volatile("" ::: "memory"); }
            if (u.pm >= 32 || (u.pm & 7) == 7) {
#pragma unroll
                for (int ai = 0; ai < 2; ++ai)
#pragma unroll
                    for (int m = 0; m < 4; ++m) { const int row = row0 + ai * HALF + m * 16;
                        const bool samp = row >= 8192; const int t = samp ? ((row - 8192) & 31) : (row & 2047), L = samp ? 32 : 2048, b = samp ? ((row - 8192) >> 5) : (row >> 11);
                        if (t >= L - hist) { float* nb = out + (samp ? (pool ? O_PS : O_CS) : (pool ? O_PP : O_CP)) + ((size_t)(l * (samp ? NBS : NBP) + b) * hist + (t - (L - hist))) * ldo + c0;
#pragma unroll
                            for (int bj = 0; bj < 2; ++bj) { *(f32x4*)(nb + bj * HALF) = acc[ai][bj][m][0]; *(f32x4*)(nb + bj * HALF + 4) = acc[ai][bj][m][1]; } }
                        asm volatile("" ::: "memory"); }
            }
        } else if (pn < 40) {
            const bool gp = pn < 16; bf16_t* O = (bf16_t*)(ws + (gp ? WS_SG : WS_SZ)); const int ldo = gp ? 2048 : 6144, c0 = (gp ? pn - 8 : pn - 16) * BM + cl;
#pragma unroll
            for (int ai = 0; ai < 2; ++ai)
#pragma unroll
                for (int m = 0; m < 4; ++m) { const int row = row0 + ai * HALF + m * 16;
#pragma unroll
                    for (int bj = 0; bj < 2; ++bj) { f32x4 v0 = acc[ai][bj][m][0], v1 = acc[ai][bj][m][1];
#pragma unroll
                        for (int j = 0; j < 4; ++j) { v0[j] = pg8::silu_f(v0[j]); v1[j] = pg8::silu_f(v1[j]); }
                        u32x4 w; w.x = pg8::cvt_pk_bf16(v0[0], v0[1]); w.y = pg8::cvt_pk_bf16(v0[2], v0[3]); w.z = pg8::cvt_pk_bf16(v1[0], v1[1]); w.w = pg8::cvt_pk_bf16(v1[2], v1[3]);
                        *(u32x4*)(O + (size_t)row * ldo + c0 + bj * HALF) = w; }
                    asm volatile("" ::: "memory"); }
        } else {
            if (cl < 96) {
#pragma unroll
                for (int n = 0; n < 2; ++n)
#pragma unroll
                    for (int j = 0; j < 4; ++j) { const int c = cl + 4 * n + j; const float bias = dtb[c];
#pragma unroll
                        for (int ai = 0; ai < 2; ++ai)
#pragma unroll
                            for (int m = 0; m < 4; ++m) { const float x = acc[ai][0][m][n][j] + bias;
                                ((float*)(ws + WS_DTV))[(size_t)c * 8704 + row0 + ai * HALF + m * 16] = fmaxf(x, 0.f) + log1pf(expf(-fabsf(x))); } }
            }
        }
    }
};

#define GAS __attribute__((address_space(1)))
#define LAS __attribute__((address_space(3)))
typedef unsigned short bf16;
typedef unsigned v4u __attribute__((ext_vector_type(4)));
typedef unsigned v2u __attribute__((ext_vector_type(2)));
typedef float f32x4 __attribute__((ext_vector_type(4)));
typedef float f32x2 __attribute__((ext_vector_type(2)));
#define LDS_WAIT() asm volatile("s_waitcnt lgkmcnt(0)" ::: "memory")
#define VM_WAIT() asm volatile("s_waitcnt vmcnt(0)" ::: "memory")
__device__ __forceinline__ unsigned f2bf(float f) { unsigned u = __builtin_bit_cast(unsigned, f); return (u + 0x7fffu + ((u >> 16) & 1u)) >> 16; }
typedef __bf16 hwbf16x2 __attribute__((ext_vector_type(2)));
__device__ __forceinline__ unsigned pk2(float lo, float hi) { return __builtin_bit_cast(unsigned, __builtin_convertvector((f32x2){lo, hi}, hwbf16x2)); }
__device__ __forceinline__ float bf2f(unsigned short b) { return __builtin_bit_cast(float, ((unsigned)b) << 16); }
__device__ __forceinline__ float silu(float x) { return x / (1.0f + __expf(-x)); }
__device__ __forceinline__ int fresh_lane() { int l; asm volatile("v_mbcnt_lo_u32_b32 %0, -1, 0\n\tv_mbcnt_hi_u32_b32 %0, -1, %0" : "=v"(l)); return l; }
__device__ __forceinline__ float wave_sum(float v) {
#pragma unroll
    for (int o = 1; o < 64; o <<= 1) v += __shfl_xor(v, o);
    return v;
}

#define XB_TMO      128
#define XB_XCNT(j)  (256  + 64 * (j))
#define XB_XSUB(j)  (1280 + 64 * (j))
#define XB_XGEN(j)  (2304 + 64 * (j))
#define XB_TOP      3328
#define XB_TOPGEN   3392
#define XCD_BAR_WORDS 3456
#define XB_SPIN_CAP (1u << 18)
__device__ __forceinline__ unsigned xb_ld(unsigned* p)              { return __hip_atomic_load(p, __ATOMIC_RELAXED, __HIP_MEMORY_SCOPE_AGENT); }
__device__ __forceinline__ unsigned xb_add(unsigned* p, unsigned v) { return __hip_atomic_fetch_add(p, v, __ATOMIC_RELAXED, __HIP_MEMORY_SCOPE_AGENT); }
__device__ __forceinline__ unsigned xb_xcc_id() { return (unsigned)__builtin_amdgcn_s_getreg((3 << 11) | 20) & 0xFu; }
#define XB_SPIN(cond, bar) do { unsigned _sp = 0; while (cond) { __builtin_amdgcn_s_sleep(1); \
    if ((++_sp & 255u) == 0u) { if (xb_ld(&(bar)[XB_TMO])) break; if (_sp > XB_SPIN_CAP) { atomicAdd(&(bar)[XB_TMO], 1u); break; } } } } while (0)
struct XcdBarrier { unsigned* bar; unsigned x; volatile LAS unsigned* st; unsigned w0; };
__device__ __forceinline__ XcdBarrier xcd_barrier_post(unsigned* bar, volatile LAS unsigned* st, unsigned w0) {
    XcdBarrier b; b.bar = bar; b.x = xb_xcc_id(); b.st = st; b.w0 = w0;
    if (w0 && fresh_lane() == 0) (void)xb_add(&bar[XB_XCNT(b.x)], 1u);
    return b;
}
__device__ __forceinline__ void xcd_barrier_complete(unsigned* bar, unsigned x, unsigned& nloc, unsigned& nx) {
    const unsigned G = gridDim.x * gridDim.y * gridDim.z;
    unsigned sum, cnt, mine, sp = 0u;
    for (;;) {
        sum = 0u; cnt = 0u; mine = 0u;
#pragma unroll
        for (unsigned j = 0; j < 16; ++j) { const unsigned c = xb_ld(&bar[XB_XCNT(j)]); sum += c; cnt += (c > 0u) ? 1u : 0u; mine = (j == x) ? c : mine; }
        if (sum == G) break;
        __builtin_amdgcn_s_sleep(1);
        if ((++sp & 255u) == 0u) { if (xb_ld(&bar[XB_TMO])) break; if (sp > XB_SPIN_CAP) { atomicAdd(&bar[XB_TMO], 1u); break; } }
    }
    nloc = mine > 0u ? mine : 1u; nx = cnt > 0u ? cnt : 1u;
}
__device__ __forceinline__ void xcd_barrier(const XcdBarrier& b) {
    asm volatile("s_waitcnt vmcnt(0)" ::: "memory");
    __syncthreads();
    if (b.w0 && fresh_lane() == 0) {
        unsigned* bar = b.bar;
        __builtin_amdgcn_s_waitcnt(0);
        unsigned nloc = b.st[0], nx = b.st[1];
        if (nloc == 0u) { xcd_barrier_complete(bar, b.x, nloc, nx); b.st[0] = nloc; b.st[1] = nx; }
        const unsigned old = xb_add(&bar[XB_XSUB(b.x)], 1u);
        const unsigned gen = old / nloc;
        if (old + 1u == (gen + 1u) * nloc) {
            __builtin_amdgcn_fence(__ATOMIC_RELEASE, "agent");
            asm volatile("s_waitcnt vmcnt(0)" ::: "memory");
            const unsigned og = xb_add(&bar[XB_TOP], 1u);
            const unsigned tg = og / nx;
            if (og + 1u == (tg + 1u) * nx) xb_add(&bar[XB_TOPGEN], 1u);
            else XB_SPIN(xb_ld(&bar[XB_TOPGEN]) == tg, bar);
            __builtin_amdgcn_fence(__ATOMIC_ACQUIRE, "agent");
            xb_add(&bar[XB_XGEN(b.x)], 1u);
            asm volatile("s_waitcnt vmcnt(0)" ::: "memory");
        } else {
            XB_SPIN(xb_ld(&bar[XB_XGEN(b.x)]) == gen, bar);
            __builtin_amdgcn_fence(__ATOMIC_ACQUIRE, "agent");
            asm volatile("s_waitcnt vmcnt(0)" ::: "memory");
        }
    }
    __syncthreads();
}

struct Args { const float* in[21]; float* out; unsigned char* ws; int ph_lo, ph_hi; };

struct TItem { const float* W; bf16* WT; const float* ksc; int N, ldt, k0, n0, nvalid; };
__device__ __forceinline__ void p0_titem_load(const TItem& d, float (&v)[64], int lane) {
    const int col = lane < d.nvalid ? lane : d.nvalid - 1;
#pragma unroll
    for (int i = 0; i < 64; ++i) v[i] = d.W[(size_t)(d.k0 + i) * d.N + d.n0 + col];
}
__device__ __forceinline__ void p0_titem_finish(const TItem& d, const float (&v)[64], LAS float* scr, int lane) {
#pragma unroll
    for (int i = 0; i < 64; ++i) scr[i * 65 + lane] = v[i];
    LDS_WAIT(); asm volatile("" ::: "memory");
    const int c = lane & 7;
    f32x4 ka = (f32x4){1.f, 1.f, 1.f, 1.f}, kb4 = ka;
    if (d.ksc && d.k0 >= WPOOL) { ka = *(const f32x4*)(d.ksc + d.k0 + 8 * c - WPOOL); kb4 = *(const f32x4*)(d.ksc + d.k0 + 8 * c - WPOOL + 4); }
#pragma unroll
    for (int j = 0; j < 8; ++j) { const int n = (lane >> 3) + 8 * j; const LAS float* s = scr + (8 * c) * 65 + n;
        v4u o; o.x = pk2(s[0 * 65] * ka.x, s[1 * 65] * ka.y); o.y = pk2(s[2 * 65] * ka.z, s[3 * 65] * ka.w); o.z = pk2(s[4 * 65] * kb4.x, s[5 * 65] * kb4.y); o.w = pk2(s[6 * 65] * kb4.z, s[7 * 65] * kb4.w);
        if (n < d.nvalid) *(GAS v4u*)(d.WT + (size_t)(d.n0 + n) * d.ldt + d.k0 + 8 * c) = o; }
    LDS_WAIT(); asm volatile("" ::: "memory");
}
__device__ __forceinline__ void p0_mod_item(const Args& a, LAS unsigned char* lds, int item, int tid, int lane, int wave) {
    const int l = item >> 7, cb = item & 127, e0 = cb * 96;
    const float* W = a.in[7] + (size_t)l * DM * 3 * DM;
    const float* cp = a.in[5]; const float* cs = a.in[6];
    LAS float* sl = (LAS float*)(lds + wave * 8192);
    f32x4 acc[20];
#pragma unroll
    for (int b = 0; b < 20; ++b) acc[b] = (f32x4){0.f, 0.f, 0.f, 0.f};
    const bool act = lane < 48; const int rs = lane >= 24 ? 1 : 0, c4 = lane - 24 * rs;
    const float* wl = W + (size_t)(wave * 512 + rs) * (3 * DM) + e0 + 4 * (act ? c4 : 0);
    f32x4 nxt[8];
#define MOD_LOAD(t_) do { _Pragma("unroll") for (int j_ = 0; j_ < 8; ++j_) nxt[j_] = act ? *(const f32x4*)(wl + (size_t)(16 * (t_) + 2 * j_) * (3 * DM)) : (f32x4){0.f, 0.f, 0.f, 0.f}; } while (0)
    MOD_LOAD(0);
    for (int ch = 0; ch < 8; ++ch) {
        const int d0 = wave * 512 + ch * 64;
#pragma unroll
        for (int b = 0; b < 20; ++b) { const float c = b < 4 ? cp[b * DM + d0 + lane] : cs[(b - 4) * DM + d0 + lane]; sl[lane * 20 + b] = c / (1.0f + expf(-c)); }
        LDS_WAIT(); asm volatile("" ::: "memory");
        for (int rb = 0; rb < 4; ++rb) {
            f32x4 wv[8];
#pragma unroll
            for (int j = 0; j < 8; ++j) wv[j] = nxt[j];
            const int tn = ch * 4 + rb + 1;
            if (tn < 32) MOD_LOAD(tn);
#pragma unroll
            for (int j = 0; j < 8; ++j) { const LAS f32x4* sp = (const LAS f32x4*)(sl + (16 * rb + 2 * j + rs) * 20);
#pragma unroll
                for (int q = 0; q < 5; ++q) { const f32x4 s4 = sp[q];
#pragma unroll
                    for (int c = 0; c < 4; ++c) acc[q * 4 + c] += wv[j] * s4[c]; } }
        }
        LDS_WAIT(); asm volatile("" ::: "memory");
    }
#undef MOD_LOAD
#pragma unroll
    for (int b = 0; b < 20; ++b)
#pragma unroll
        for (int c = 0; c < 4; ++c) acc[b][c] += __shfl_down(acc[b][c], 24);
    LAS float* red = (LAS float*)(lds + 65536 + wave * 7680);
    if (lane < 24) {
#pragma unroll
        for (int b = 0; b < 20; ++b) *(LAS f32x4*)(red + b * 96 + 4 * lane) = acc[b]; }
    __syncthreads();
    float* modf = (float*)(a.ws + WS_MODF);
    for (int idx = tid; idx < 20 * 96; idx += NWAVES * 64) { float s = 0.f;
#pragma unroll
        for (int w = 0; w < 8; ++w) s += ((LAS float*)(lds + 65536 + w * 7680))[idx];
        const int b = idx / 96, e = idx % 96; modf[(size_t)(l * 20 + b) * (3 * DM) + e0 + e] = s + a.in[8][(size_t)l * 3 * DM + e0 + e]; }
    __syncthreads();
}
__device__ __forceinline__ void p0_prologue(const Args& a, LAS unsigned char* lds, int G, int bid, int tid, int lane, int wave) {
    for (int it = bid; it < 256; it += G) p0_mod_item(a, lds, it, tid, lane, wave);
    VM_WAIT(); __syncthreads();
    if (wave == 0 && lane == 0) { __builtin_amdgcn_fence(__ATOMIC_RELEASE, "agent"); VM_WAIT(); __hip_atomic_fetch_add((unsigned*)(a.ws + WS_CTL) + CW_MOD, 1u, __ATOMIC_RELAXED, __HIP_MEMORY_SCOPE_AGENT); }
    LAS float* scr = (LAS float*)(lds + (wave < 7 ? wave * 16640 : 135168));
    const int gw = bid * NWAVES + wave, NGW = G * NWAVES;
    constexpr int NB_IN = (IN_DIM + 63) / 64, I_IN = 64 * NB_IN, I_OUT = 128 * 64, I_P = 8 * 8;
    constexpr int NITEMS = 2 * I_IN + 2 * I_OUT + 8 * I_P;
#define P0_DECODE(d, it_) do { int r = (it_); \
        if (r < 2 * I_IN) { const int l = r / I_IN; r -= l * I_IN; const int nb = 2 * (r / 128) + (r & 1), kb = 4 * ((r >> 3) & 15) + ((r >> 1) & 3); d = TItem{a.in[9] + (size_t)l * DM * IN_DIM, (bf16*)(a.ws + WS_WIN + l * WIN_L), nullptr, IN_DIM, DM, 64 * kb, 64 * nb, IN_DIM - 64 * nb < 64 ? IN_DIM - 64 * nb : 64}; } \
        else { r -= 2 * I_IN; if (r < 2 * I_OUT) { const int l = r / I_OUT; r -= l * I_OUT; const int nb = 2 * (r / 256) + (r & 1), kb = 4 * ((r >> 3) & 31) + ((r >> 1) & 3); d = TItem{a.in[18] + (size_t)l * DIN * DM, (bf16*)(a.ws + WS_WOUT + l * WOUT_L), a.in[17] + (size_t)l * WSSD, DM, DIN, 64 * kb, 64 * nb, 64}; } \
               else { r -= 2 * I_OUT; const int lg = r / I_P; r -= lg * I_P; d = TItem{a.in[10] + (size_t)lg * 512 * 512, (bf16*)(a.ws + WS_WP) + (size_t)lg * 512 * 512, nullptr, 512, 512, 64 * (r / 8), 64 * (r % 8), 64}; } } } while (0)
    { int it = gw; TItem d{}; float nx[64];
      if (it < NITEMS) { P0_DECODE(d, it); p0_titem_load(d, nx, lane); }
      while (it < NITEMS) {
          float cur[64];
#pragma unroll
          for (int i = 0; i < 64; ++i) cur[i] = nx[i];
          const TItem dc = d; const int itn = it + NGW;
          if (itn < NITEMS) { P0_DECODE(d, itn); p0_titem_load(d, nx, lane); }
          p0_titem_finish(dc, cur, scr, lane);
          it = itn; } }
#undef P0_DECODE
    for (int i = bid * NWAVES * 64 + tid; i < 2 * (NPAD - IN_DIM) * (DM / 8); i += G * NWAVES * 64) { const int l = i / ((NPAD - IN_DIM) * (DM / 8)), r = i % ((NPAD - IN_DIM) * (DM / 8));
        *(GAS v4u*)((bf16*)(a.ws + WS_WIN + l * WIN_L) + (size_t)IN_DIM * DM + (size_t)r * 8) = (v4u){0u, 0u, 0u, 0u}; }
}

__device__ __forceinline__ void row_stats(const f32x4 (&v)[16], float& mean, float& rstd) {
    float s = 0.f;
#pragma unroll
    for (int j = 0; j < 16; ++j) s += (v[j].x + v[j].y) + (v[j].z + v[j].w);
    mean = wave_sum(s) * (1.f / DM); float q = 0.f;
#pragma unroll
    for (int j = 0; j < 16; ++j) { const f32x4 d = v[j] - mean; q += (d.x * d.x + d.y * d.y) + (d.z * d.z + d.w * d.w); }
    rstd = 1.f / sqrtf(wave_sum(q) * (1.f / DM) + LN_EPS);
}
__device__ __forceinline__ int batch_of(int m) { return m < MP ? (m >> 11) : NBP + ((m - MP) >> 5); }
template <typename VP>
__device__ __forceinline__ void mod_row_to_bf16(const f32x4 (&v)[16], VP sh4, VP sc4, bf16* hrow, int lane) {
    float mean, rstd; row_stats(v, mean, rstd);
#pragma unroll
    for (int j = 0; j < 16; ++j) { const f32x4 sh = sh4[lane + 64 * j], sc = sc4[lane + 64 * j];
        const f32x4 o = (v[j] - mean) * rstd * (sc + 1.0f) + sh;
        ((GAS v2u*)hrow)[lane + 64 * j] = (v2u){pk2(o.x, o.y), pk2(o.z, o.w)};
        if ((j & 3) == 3) asm volatile("" ::: "memory"); }
}
__device__ __forceinline__ void lds_fill_vec(LAS unsigned char* lds, int slot, const float* src, int tid) {
#pragma unroll
    for (int i = 0; i < DM / 4 / (NWAVES * 64); ++i) ((LAS f32x4*)(lds + slot * 16384))[tid + i * NWAVES * 64] = ((const f32x4*)src)[tid + i * NWAVES * 64];
}
__device__ __forceinline__ void phase_a(const Args& a, LAS unsigned char* lds, int G, int bid, int lane, int wave) {
    const int gw = bid * NWAVES + wave, NGW = G * NWAVES;
    const float* modf = (const float*)(a.ws + WS_MODF); bf16* H = (bf16*)(a.ws + WS_H);
    if (G == 256) {
        { const float* md = modf + (size_t)(bid >> 6) * 3 * DM; const int tid = wave * 64 + lane;
          lds_fill_vec(lds, 0, md, tid); lds_fill_vec(lds, 1, md + DM, tid); }
        LDS_WAIT(); __syncthreads();
        const LAS f32x4* shl = (const LAS f32x4*)lds; const LAS f32x4* scl = (const LAS f32x4*)(lds + 16384);
        const int nrow = wave < 2 ? 5 : 4;
#define A_ROW(k) ((k) < 4 ? 32 * bid + wave + 8 * (k) : MP + 2 * bid + wave)
#define A_SRC(m) ((m) < MP ? a.in[0] + (size_t)(m) * DM : a.in[1] + (size_t)((m) - MP) * DM)
        f32x4 nx[16];
        { const float* xr = A_SRC(A_ROW(0));
#pragma unroll
          for (int j = 0; j < 16; ++j) nx[j] = ((const f32x4*)xr)[lane + 64 * j]; }
        for (int k = 0; k < 4; ++k) {
            const int m = A_ROW(k);
            f32x4 v[16];
#pragma unroll
            for (int j = 0; j < 16; ++j) v[j] = nx[j];
            if (k + 1 < nrow) { const int mn = A_ROW(k + 1); const float* xr = A_SRC(mn);
#pragma unroll
                for (int j = 0; j < 16; ++j) nx[j] = ((const f32x4*)xr)[lane + 64 * j]; }
            mod_row_to_bf16(v, shl, scl, H + (size_t)m * DM, lane);
        }
        if (wave < 2) { const int m = A_ROW(4); const float* md = modf + (size_t)batch_of(m) * 3 * DM;
            mod_row_to_bf16(nx, (const f32x4*)md, (const f32x4*)(md + DM), H + (size_t)m * DM, lane); }
#undef A_ROW
#undef A_SRC
        return;
    }
    f32x4 nx[16]; int m = gw;
    if (m < M) { const float* xr = m < MP ? a.in[0] + (size_t)m * DM : a.in[1] + (size_t)(m - MP) * DM;
#pragma unroll
        for (int j = 0; j < 16; ++j) nx[j] = ((const f32x4*)xr)[lane + 64 * j]; }
    while (m < M) {
        f32x4 v[16];
#pragma unroll
        for (int j = 0; j < 16; ++j) v[j] = nx[j];
        const int mn = m + NGW;
        if (mn < M) { const float* xr = mn < MP ? a.in[0] + (size_t)mn * DM : a.in[1] + (size_t)(mn - MP) * DM;
#pragma unroll
            for (int j = 0; j < 16; ++j) nx[j] = ((const f32x4*)xr)[lane + 64 * j]; }
        const float* md = modf + (size_t)batch_of(m) * 3 * DM;
        mod_row_to_bf16(v, (const f32x4*)md, (const f32x4*)(md + DM), H + (size_t)m * DM, lane);
        m = mn;
    }
}
template <typename LP, typename VP>
__device__ __forceinline__ void g_process(f32x4 (&v)[16], LP lg4, LP lb4, float* xrow, bool do_h, VP sh4, VP sc4, bf16* hrow, int lane) {
    float mean, rstd; row_stats(v, mean, rstd);
#pragma unroll
    for (int j = 0; j < 16; ++j) { v[j] = (v[j] - mean) * rstd * lg4[lane + 64 * j] + lb4[lane + 64 * j];
        ((GAS f32x4*)xrow)[lane + 64 * j] = v[j];
        if ((j & 3) == 3) asm volatile("" ::: "memory"); }
    if (do_h) mod_row_to_bf16(v, sh4, sc4, hrow, lane);
}
template <bool EVEN>
__device__ __forceinline__ void g_prompt_rows(const Args& a, LAS unsigned char* lds, int l, int G, int bid, int lane, int wave) {
    const int gw = bid * NWAVES + wave, NGW = G * NWAVES;
    const float* modf = (const float*)(a.ws + WS_MODF); bf16* H = (bf16*)(a.ws + WS_H);
    const bf16* R = (const bf16*)(a.ws + WS_R); float* xo = l == 0 ? (float*)(a.ws + WS_X1) : a.out + O_Y;
    const LAS f32x4* lgl = (const LAS f32x4*)lds; const LAS f32x4* lbl = (const LAS f32x4*)(lds + 16384); const LAS f32x4* shl = (const LAS f32x4*)(lds + 32768); const LAS f32x4* scl = (const LAS f32x4*)(lds + 49152);
    v2u nx[16];
    const int nrow = EVEN ? (wave < 2 ? 3 : (wave < 4 ? 5 : 4)) : (MP - gw + NGW - 1) / NGW;
#define G_ROW(k) (EVEN ? 32 * bid + ((k) == 4 ? 24 + (wave - 2) : wave + 8 * (k)) : gw + (k) * NGW)
    int k = 0;
    if (k < nrow) { const int m = G_ROW(0);
#pragma unroll
        for (int j = 0; j < 16; ++j) nx[j] = *(const v2u*)(R + (size_t)m * DM + 4 * (lane + 64 * j)); }
    for (; k < nrow; ++k) {
        const int m = G_ROW(k);
        f32x4 v[16];
#pragma unroll
        for (int j = 0; j < 16; ++j) v[j] = pg8::bf4_to_f32(nx[j].x, nx[j].y);
        if (k + 1 < nrow) { const int mn = G_ROW(k + 1);
#pragma unroll
            for (int j = 0; j < 16; ++j) nx[j] = *(const v2u*)(R + (size_t)mn * DM + 4 * (lane + 64 * j)); }
        if (EVEN) g_process(v, lgl, lbl, xo + (size_t)m * DM, l == 0, shl, scl, H + (size_t)m * DM, lane);
        else { const float* lg = a.in[19] + (size_t)l * DM; const float* lb = a.in[20] + (size_t)l * DM; const float* md = modf + (size_t)(NBT + batch_of(m)) * 3 * DM;
            g_process(v, (const f32x4*)lg, (const f32x4*)lb, xo + (size_t)m * DM, l == 0, (const f32x4*)md, (const f32x4*)(md + DM), H + (size_t)m * DM, lane); } }
#undef G_ROW
}
__device__ __forceinline__ void phase_g(const Args& a, LAS unsigned char* lds, int l, int G, int bid, int lane, int wave) {
    const int gw = bid * NWAVES + wave, NGW = G * NWAVES;
    const float* modf = (const float*)(a.ws + WS_MODF); bf16* H = (bf16*)(a.ws + WS_H);
    const bf16* R = (const bf16*)(a.ws + WS_R); float* xo = l == 0 ? (float*)(a.ws + WS_X1) : a.out + O_Y;
    const float* lg = a.in[19] + (size_t)l * DM; const float* lb = a.in[20] + (size_t)l * DM;
    const bool even = (G == 256);
    const LAS f32x4* lgl = (const LAS f32x4*)lds; const LAS f32x4* lbl = (const LAS f32x4*)(lds + 16384); const LAS f32x4* shl = (const LAS f32x4*)(lds + 32768); const LAS f32x4* scl = (const LAS f32x4*)(lds + 49152);
    if (even) {
        const int tid = wave * 64 + lane;
        lds_fill_vec(lds, 0, lg, tid); lds_fill_vec(lds, 1, lb, tid);
        if (l == 0) { const float* md = modf + (size_t)(NBT + (bid >> 6)) * 3 * DM; lds_fill_vec(lds, 2, md, tid); lds_fill_vec(lds, 3, md + DM, tid); }
        LDS_WAIT(); __syncthreads();
    }
    if (even ? wave < 2 : gw < MS) {
        const int m = even ? MP + 2 * bid + wave : MP + gw; f32x4 v[16];
        const float* xr = (l == 0 ? a.in[1] : (const float*)(a.ws + WS_X1) + (size_t)MP * DM) + (size_t)(m - MP) * DM;
        const float* gr = modf + (size_t)(l * NBT + batch_of(m)) * 3 * DM + 2 * DM; const float* sl = (const float*)(a.ws + WS_SLAB) + (size_t)(m - MP) * DM;
#pragma unroll
        for (int j2 = 0; j2 < 16; j2 += 2) { f32x4 t[2][8], xv[2], gv[2];
#pragma unroll
            for (int jj = 0; jj < 2; ++jj) { xv[jj] = ((const f32x4*)xr)[lane + 64 * (j2 + jj)]; gv[jj] = ((const f32x4*)gr)[lane + 64 * (j2 + jj)];
#pragma unroll
                for (int k2 = 0; k2 < 8; ++k2) t[jj][k2] = ((const f32x4*)(sl + (size_t)k2 * MS * DM))[lane + 64 * (j2 + jj)]; }
#pragma unroll
            for (int jj = 0; jj < 2; ++jj) { const f32x4 o = ((t[jj][0] + t[jj][1]) + (t[jj][2] + t[jj][3])) + ((t[jj][4] + t[jj][5]) + (t[jj][6] + t[jj][7]));
                v[j2 + jj] = xv[jj] * ALPHA + gv[jj] * o; }
            asm volatile("" ::: "memory"); }
        const float* md = modf + (size_t)(NBT + batch_of(m)) * 3 * DM;
        if (even) g_process(v, lgl, lbl, xo + (size_t)m * DM, l == 0, (const f32x4*)md, (const f32x4*)(md + DM), H + (size_t)m * DM, lane);
        else g_process(v, (const f32x4*)lg, (const f32x4*)lb, xo + (size_t)m * DM, l == 0, (const f32x4*)md, (const f32x4*)(md + DM), H + (size_t)m * DM, lane);
    }
    if (even) g_prompt_rows<true>(a, lds, l, G, bid, lane, wave); else g_prompt_rows<false>(a, lds, l, G, bid, lane, wave);
}
__device__ __forceinline__ f32x4 ld_bf4(const bf16* p) { const v2u q = *(const v2u*)p; return (f32x4){bf2f((unsigned short)(q.x & 0xffffu)), bf2f((unsigned short)(q.x >> 16)), bf2f((unsigned short)(q.y & 0xffffu)), bf2f((unsigned short)(q.y >> 16))}; }
__device__ __forceinline__ f32x4 pool_hist(const bf16* pc, const float* st, bool samp, int t) {
    if (t >= 0) return ld_bf4(pc + (size_t)t * WPOOL);
    if (samp) return *(const f32x4*)(st + (size_t)(15 + t) * WPOOL);
    return (f32x4){0.f, 0.f, 0.f, 0.f};
}
__device__ __forceinline__ void c1_elem(const Args& a, int l, int e, v2u& out, bf16*& dst) {
    const int c4 = e % 2560, r = (e / 2560) & 31, ss = e / (2560 * 32);
    const bool samp = ss >= 4; const int b = samp ? ss - 4 : ss, m0 = samp ? MP + b * DSEQ : b * SEQ;
    if (c4 < 512) { const int j0 = 4 * c4, w = 2 << (j0 >> 9);
        const bf16* pc = (const bf16*)(a.ws + WS_UP) + (size_t)m0 * WPOOL + j0; const float* st = a.in[2] + (size_t)(l * NBS + b) * 15 * WPOOL + j0;
        const f32x4 u = ld_bf4(pc + (size_t)r * WPOOL); f32x4 S = u;
        for (int i = 1; i < w; ++i) S += pool_hist(pc, st, samp, r - i);
        const int pos = (samp ? PAST : 0) + r; const float cnt = (float)(pos + 1 < w ? pos + 1 : w);
        const f32x4 p = S / cnt - u;
        out = (v2u){pk2(p.x, p.y), pk2(p.z, p.w)}; dst = (bf16*)(a.ws + WS_POOLED) + (size_t)(m0 + r) * WPOOL + j0;
    } else { const int j0 = 4 * (c4 - 512);
        const float* cw = a.in[12] + (size_t)l * 4 * CONVD + j0; const bf16* pc = (const bf16*)(a.ws + WS_XP) + (size_t)m0 * CONVD + j0; const float* st = a.in[3] + (size_t)(l * NBS + b) * 3 * CONVD + j0;
        f32x4 o = *(const f32x4*)(a.in[13] + (size_t)l * CONVD + j0);
#pragma unroll
        for (int k = 0; k < 4; ++k) { const int t = r - 3 + k;
            const f32x4 x = t >= 0 ? ld_bf4(pc + (size_t)t * CONVD) : (samp ? *(const f32x4*)(st + (size_t)(3 + t) * CONVD) : (f32x4){0.f, 0.f, 0.f, 0.f});
            o += *(const f32x4*)(cw + (size_t)k * CONVD) * x; }
        o.x = silu(o.x); o.y = silu(o.y); o.z = silu(o.z); o.w = silu(o.w);
        out = (v2u){pk2(o.x, o.y), pk2(o.z, o.w)}; dst = (bf16*)(a.ws + WS_XBC) + (size_t)(m0 + r) * CONVD + j0;
    }
}
__device__ __forceinline__ void c_zero_ssq(const Args& a, int G, int bid, int tid) {
    for (int i = bid * NWAVES * 64 + tid; i < M * 16; i += G * NWAVES * 64) ((GAS f32x4*)(a.ws + WS_YG))[i] = (f32x4){0.f, 0.f, 0.f, 0.f};
}
__device__ __forceinline__ void c1_range(const Args& a, int l, int e_lo, int e_hi, int first, int stride) {
    for (int e0 = e_lo + first; e0 < e_hi; e0 += 4 * stride) { v2u res[4]; bf16* dst[4];
#pragma unroll
        for (int u4 = 0; u4 < 4; ++u4) { const int e = e0 + u4 * stride; dst[u4] = nullptr; res[u4] = (v2u){0u, 0u};
            if (e < e_hi) c1_elem(a, l, e, res[u4], dst[u4]); }
#pragma unroll
        for (int u4 = 0; u4 < 4; ++u4) if (dst[u4]) *(GAS v2u*)dst[u4] = res[u4]; }
}
constexpr int C1_PROMPT_ELEMS = 4 * 32 * 2560, C1_ALL_ELEMS = 20 * 32 * 2560, C_ITEMS2 = 252 * 3, C_ITEMS1 = C1_PROMPT_ELEMS / 2048, C_QITEMS = C_ITEMS2 + C_ITEMS1;
__device__ __forceinline__ void c_sample_elems(const Args& a, int l, int G, int bid, int tid) { c1_range(a, l, C1_PROMPT_ELEMS, C1_ALL_ELEMS, bid * NWAVES * 64 + tid, G * NWAVES * 64); }
__device__ __forceinline__ void c_prompt_item(const Args& a, int l, int it, int tid) {
    if (it >= C_ITEMS2) { c1_range(a, l, (it - C_ITEMS2) * 2048, (it - C_ITEMS2 + 1) * 2048, tid, NWAVES * 64); return; }
    {
        const int sq = it / 3, cblk = it % 3, b = sq / 63, t0 = 32 * (1 + sq % 63), m0 = b * SEQ + t0;
        if (cblk == 0) {
            const int j0 = 4 * tid, w = 2 << (j0 >> 9);
            const bf16* p0 = (const bf16*)(a.ws + WS_UP) + (size_t)m0 * WPOOL + j0;
            bf16* po = (bf16*)(a.ws + WS_POOLED) + (size_t)m0 * WPOOL + j0;
            f32x4 S = (f32x4){0.f, 0.f, 0.f, 0.f};
            for (int i = 1; i < w; ++i) S += ld_bf4(p0 - (size_t)i * WPOOL);
            const float inv = 1.0f / (float)w;
            f32x4 nu[8], no[8];
#pragma unroll
            for (int k = 0; k < 8; ++k) { nu[k] = ld_bf4(p0 + (size_t)k * WPOOL); no[k] = ld_bf4(p0 + (ptrdiff_t)(k - w + 1) * WPOOL); }
#pragma unroll
            for (int r0 = 0; r0 < 32; r0 += 8) { f32x4 u[8], o[8];
#pragma unroll
                for (int k = 0; k < 8; ++k) { u[k] = nu[k]; o[k] = no[k]; }
                if (r0 + 8 < 32) {
#pragma unroll
                    for (int k = 0; k < 8; ++k) { nu[k] = ld_bf4(p0 + (size_t)(r0 + 8 + k) * WPOOL); no[k] = ld_bf4(p0 + (ptrdiff_t)(r0 + 8 + k - w + 1) * WPOOL); } }
#pragma unroll
                for (int k = 0; k < 8; ++k) { S += u[k]; const f32x4 p = S * inv - u[k];
                    *(GAS v2u*)(po + (size_t)(r0 + k) * WPOOL) = (v2u){pk2(p.x, p.y), pk2(p.z, p.w)}; S -= o[k]; } }
        } else {
            const int j0 = (cblk - 1) * 4096 + 8 * tid;
            const float* cw = a.in[12] + (size_t)l * 4 * CONVD + j0; const float* cb = a.in[13] + (size_t)l * CONVD + j0;
            f32x4 wt[4][2], bs[2];
#pragma unroll
            for (int hh = 0; hh < 2; ++hh) { bs[hh] = *(const f32x4*)(cb + 4 * hh);
#pragma unroll
                for (int k = 0; k < 4; ++k) wt[k][hh] = *(const f32x4*)(cw + (size_t)k * CONVD + 4 * hh); }
            const bf16* pc = (const bf16*)(a.ws + WS_XP) + (size_t)m0 * CONVD + j0;
            bf16* xo = (bf16*)(a.ws + WS_XBC) + (size_t)m0 * CONVD + j0;
            v4u h3 = *(const v4u*)(pc - 3 * (size_t)CONVD), h2 = *(const v4u*)(pc - 2 * (size_t)CONVD), h1 = *(const v4u*)(pc - (size_t)CONVD);
            f32x4 p3[2] = {pg8::bf4_to_f32(h3.x, h3.y), pg8::bf4_to_f32(h3.z, h3.w)}, p2[2] = {pg8::bf4_to_f32(h2.x, h2.y), pg8::bf4_to_f32(h2.z, h2.w)}, p1[2] = {pg8::bf4_to_f32(h1.x, h1.y), pg8::bf4_to_f32(h1.z, h1.w)};
            v4u nc[4];
#pragma unroll
            for (int k = 0; k < 4; ++k) nc[k] = *(const v4u*)(pc + (size_t)k * CONVD);
#pragma unroll
            for (int r0 = 0; r0 < 32; r0 += 4) { v4u cq[4];
#pragma unroll
                for (int k = 0; k < 4; ++k) cq[k] = nc[k];
                if (r0 + 4 < 32) {
#pragma unroll
                    for (int k = 0; k < 4; ++k) nc[k] = *(const v4u*)(pc + (size_t)(r0 + 4 + k) * CONVD); }
#pragma unroll
                for (int k = 0; k < 4; ++k) { const f32x4 cur[2] = {pg8::bf4_to_f32(cq[k].x, cq[k].y), pg8::bf4_to_f32(cq[k].z, cq[k].w)}; unsigned ow[4];
#pragma unroll
                    for (int hh = 0; hh < 2; ++hh) { f32x4 o = wt[0][hh] * p3[hh] + wt[1][hh] * p2[hh] + wt[2][hh] * p1[hh] + wt[3][hh] * cur[hh] + bs[hh];
                        o.x = silu(o.x); o.y = silu(o.y); o.z = silu(o.z); o.w = silu(o.w);
                        ow[2 * hh] = pk2(o.x, o.y); ow[2 * hh + 1] = pk2(o.z, o.w);
                        p3[hh] = p2[hh]; p2[hh] = p1[hh]; p1[hh] = cur[hh]; }
                    *(GAS v4u*)(xo + (size_t)(r0 + k) * CONVD) = (v4u){ow[0], ow[1], ow[2], ow[3]}; } }
        }
    }
}
typedef short s16x4 __attribute__((ext_vector_type(4)));
typedef short s16x8 __attribute__((ext_vector_type(8)));
constexpr int SSD_XX = 0, SSD_BS = 32768, SSD_CS = 49152, SSD_HB = 65536, SSD_TAB = 135168;
__device__ __forceinline__ unsigned off_b(unsigned row, unsigned ch) { return 256u * row + 16u * (ch ^ (((row & 3u) << 2) | ((row >> 2) & 3u))); }
__device__ __forceinline__ s16x8 tr_frag(LAS unsigned char* img, int lane, int c, int ks) {
    const unsigned g = (unsigned)lane >> 4, qq = ((unsigned)lane & 15u) >> 2, pp = (unsigned)lane & 3u;
    const unsigned a0 = off_b(32u * ks + 8u * g + qq, 2u * c + (pp >> 1)) + 8u * (pp & 1u), a1 = off_b(32u * ks + 8u * g + 4u + qq, 2u * c + (pp >> 1)) + 8u * (pp & 1u);
    const s16x4 lo = __builtin_amdgcn_ds_read_tr16_b64_v4i16((LAS s16x4*)(img + a0)), hi = __builtin_amdgcn_ds_read_tr16_b64_v4i16((LAS s16x4*)(img + a1));
    return __builtin_shufflevector(lo, hi, 0, 1, 2, 3, 4, 5, 6, 7);
}
__device__ __forceinline__ s16x8 row_frag(LAS unsigned char* img, int row, int ch) { return *(const LAS s16x8*)(img + off_b((unsigned)row, (unsigned)ch)); }
__device__ __forceinline__ float ex2(float x) { return __builtin_amdgcn_exp2f(x); }
template <int CTRL, int RM, int BMK> __device__ __forceinline__ float dpp0(float v) { return __builtin_bit_cast(float, __builtin_amdgcn_update_dpp(0, __builtin_bit_cast(int, v), CTRL, RM, BMK, true)); }
__device__ __forceinline__ float wave_scan(float x) {
    float v = x + dpp0<0x111, 0xf, 0xf>(x); v += dpp0<0x112, 0xf, 0xf>(x); v += dpp0<0x113, 0xf, 0xf>(x);
    v += dpp0<0x114, 0xf, 0xe>(v); v += dpp0<0x118, 0xf, 0xc>(v); v += dpp0<0x142, 0xa, 0xf>(v); v += dpp0<0x143, 0xc, 0xf>(v);
    return v;
}
__device__ __forceinline__ unsigned scale_pk(unsigned v, float w) { return pk2(bf2f((unsigned short)(v & 0xffffu)) * w, bf2f((unsigned short)(v >> 16)) * w); }

__device__ __forceinline__ void ssd_unit(const Args& a, LAS unsigned char* lds, int l, int unit0, int nunits, int tid) {
    int lane = tid & 63, r16 = lane & 15, q = lane >> 4; const int wave = __builtin_amdgcn_readfirstlane(tid >> 6);
    const int lt = wave & 3, ph = wave >> 2;
    const bool samp = unit0 >= NBP * 48;
    const int nchunk = samp ? 1 : SEQ / 64, vr = samp ? DSEQ : 64;
#define SSD_DECODE(u_, b_, hp_, mb_) do { const int u2_ = samp ? (u_) - NBP * 48 : (u_); b_ = u2_ / 48; hp_ = u2_ % 48; mb_ = samp ? MP + b_ * DSEQ : b_ * SEQ; } while (0)
    int b, hp, mbase; SSD_DECODE(unit0, b, hp, mbase);
    const bf16* xbc = (const bf16*)(a.ws + WS_XBC); const bf16* sz = (const bf16*)(a.ws + WS_SZ); bf16* yg = (bf16*)(a.ws + WS_MIXED) + WPOOL;
    int xrow = tid >> 3, xch = tid & 7, brow = tid >> 4, bch = tid & 15;
    int lrow = 16 * lt + r16;
    v4u xr[2], br[2], cr[2]; v2u zr[2][2]; float dtl = 0.f;
    const v4u zero4 = (v4u){0u, 0u, 0u, 0u};
#define SSD_LOAD(c, MB_, HP_) do { const size_t m0_ = (size_t)(MB_) + 64 * (size_t)(c); const int h0_ = 2 * (HP_), g_ = (HP_) / 6; \
        { const bf16* xp_ = xbc + (m0_ + (xrow < vr ? xrow : 0)) * CONVD + h0_ * HD + 8 * xch; xr[0] = *(const v4u*)xp_; xr[1] = *(const v4u*)(xp_ + HD); } \
        _Pragma("unroll") for (int i_ = 0; i_ < 2; ++i_) { const int row_ = brow + 32 * i_; const bf16* rp_ = xbc + (m0_ + (row_ < vr ? row_ : 0)) * CONVD + WSSD + g_ * NS + 8 * bch; \
            br[i_] = *(const v4u*)rp_; cr[i_] = *(const v4u*)(rp_ + 1024); } \
        _Pragma("unroll") for (int hd_ = 0; hd_ < 2; ++hd_) _Pragma("unroll") for (int j_ = 0; j_ < 2; ++j_) \
            zr[hd_][j_] = *(const v2u*)(sz + (m0_ + (lrow < vr ? lrow : 0)) * WSSD + (h0_ + hd_) * HD + 16 * (2 * ph + j_) + 4 * q); \
        if (wave < 2) dtl = ((const float*)(a.ws + WS_DTV) + (size_t)(h0_ + (wave & 1)) * M)[m0_ + (lane < vr ? lane : 0)]; } while (0)     \

#define SSD_LOADH(B_, HP_) do { _Pragma("unroll") for (int hd_ = 0; hd_ < 2; ++hd_) _Pragma("unroll") for (int i_ = 0; i_ < 2; ++i_) _Pragma("unroll") for (int j_ = 0; j_ < 2; ++j_) \
        Hin[hd_][i_][j_] = samp ? *(const f32x4*)(a.in[4] + ((size_t)((l * NBS + (B_)) * NH + 2 * (HP_) + hd_) * HD + 16 * (2 * ph + j_) + r16) * NS + 16 * (2 * lt + i_) + 4 * q) : (f32x4){0.f, 0.f, 0.f, 0.f}; } while (0)
#define SSD_SCAN(i_) do { if (wave < 2) { LAS float* tb_ = (LAS float*)(lds + SSD_TAB + (2 * (i_) + wave) * 1024); const float d_ = lane < vr ? dtl : 0.f; \
            const float cs_ = wave_scan(d_ * (wave == 0 ? A2[0] : A2[1])); const float tot_ = __builtin_bit_cast(float, __builtin_amdgcn_readlane(__builtin_bit_cast(int, cs_), 63)); \
            const float c31_ = __builtin_bit_cast(float, __builtin_amdgcn_readlane(__builtin_bit_cast(int, cs_), 31)); \
            tb_[lane] = cs_; tb_[64 + lane] = d_; tb_[128 + lane] = d_ * ex2(tot_ - cs_); tb_[192 + lane] = lane < 32 ? d_ * ex2(c31_ - cs_) : 0.f; } } while (0)
#define SSD_STAGE_WRITE(i_) do { \
        _Pragma("unroll") for (int hd_ = 0; hd_ < 2; ++hd_) { const float w_ = ((const LAS float*)(lds + SSD_TAB + (2 * (i_) + hd_) * 1024))[128 + xrow]; const v4u x_ = xrow < vr ? xr[hd_] : zero4; \
            *(LAS v4u*)(lds + SSD_XX + hd_ * 16384 + off_b(xrow, xch)) = x_; \
            *(LAS v4u*)(lds + SSD_XX + hd_ * 16384 + off_b(xrow, 8 + xch)) = (v4u){scale_pk(x_.x, w_), scale_pk(x_.y, w_), scale_pk(x_.z, w_), scale_pk(x_.w, w_)}; } \
        _Pragma("unroll") for (int i2_ = 0; i2_ < 2; ++i2_) { const bool ok_ = brow + 32 * i2_ < vr; \
            *(LAS v4u*)(lds + SSD_BS + off_b(brow + 32 * i2_, bch)) = ok_ ? br[i2_] : zero4; *(LAS v4u*)(lds + SSD_CS + off_b(brow + 32 * i2_, bch)) = ok_ ? cr[i2_] : zero4; } } while (0)
#define SSD_BAR() do { asm volatile("s_waitcnt lgkmcnt(0)" ::: "memory"); __builtin_amdgcn_s_barrier(); asm volatile("" ::: "memory"); } while (0)
    f32x4 Hacc[2][2][2], Hin[2][2][2];
#define SSD_HWRITE(i_) do { _Pragma("unroll") for (int hd_ = 0; hd_ < 2; ++hd_) { LAS unsigned char* hb_ = lds + SSD_HB + (2 * (i_) + hd_) * 16384; \
        _Pragma("unroll") for (int i2_ = 0; i2_ < 2; ++i2_) _Pragma("unroll") for (int j2_ = 0; j2_ < 2; ++j2_) { const f32x4 v_ = Hacc[hd_][i2_][j2_]; \
            *(LAS v2u*)(hb_ + off_b(16 * (2 * ph + j2_) + r16, 2 * (2 * lt + i2_) + (q >> 1)) + 8 * (q & 1)) = (v2u){pk2(v_.x, v_.y), pk2(v_.z, v_.w)}; } } } while (0)
    SSD_LOAD(0, mbase, hp); SSD_LOADH(b, hp);
    for (int ui = 0; ui < nunits; ++ui) {
    asm volatile("" : "+v"(lane), "+v"(r16), "+v"(q), "+v"(xrow), "+v"(xch), "+v"(brow), "+v"(bch), "+v"(lrow));
    const int h0 = 2 * hp, g = hp / 6;
    float A2[2], Dk[2];
#pragma unroll
    for (int hd = 0; hd < 2; ++hd) { A2[hd] = -expf(a.in[15][l * NH + h0 + hd]) * 1.44269504089f; Dk[hd] = a.in[16][l * NH + h0 + hd]; }
    float* ssq = (float*)(a.ws + WS_YG) + g * 8 + hp % 6;
#pragma unroll
    for (int hd = 0; hd < 2; ++hd)
#pragma unroll
        for (int i = 0; i < 2; ++i)
#pragma unroll
            for (int j = 0; j < 2; ++j) Hacc[hd][i][j] = Hin[hd][i][j];
    v2u zc[2][2] = {{zr[0][0], zr[0][1]}, {zr[1][0], zr[1][1]}};
    SSD_SCAN(0); SSD_HWRITE(0);
    SSD_BAR();
    SSD_STAGE_WRITE(0);
    SSD_BAR();
    v2u ypk[2][2] = {{(v2u){0u, 0u}, (v2u){0u, 0u}}, {(v2u){0u, 0u}, (v2u){0u, 0u}}}; float ssk[2] = {0.f, 0.f};
    for (int c = 0; c < nchunk; ++c) {
        const bool more = c + 1 < nchunk;
        if (c > 0 && lrow < vr) {
#pragma unroll
            for (int hd = 0; hd < 2; ++hd)
#pragma unroll
                for (int j = 0; j < 2; ++j) *(GAS v2u*)(yg + ((size_t)mbase + 64 * (c - 1) + lrow) * DIN + (h0 + hd) * HD + 16 * (2 * ph + j) + 4 * q) = ypk[hd][j];
            if (q == 0) __hip_atomic_fetch_add(ssq + ((size_t)mbase + 64 * (c - 1) + lrow) * 64, ssk[0] + ssk[1], __ATOMIC_RELAXED, __HIP_MEMORY_SCOPE_AGENT); }
        if (more) SSD_LOAD(c + 1, mbase, hp);
        LAS unsigned char* hbc = lds + SSD_HB + 2 * (c & 1) * 16384; const LAS float* tb = (const LAS float*)(lds + SSD_TAB + 2 * (c & 1) * 1024);
#define SB() __builtin_amdgcn_sched_barrier(0)
        s16x8 cf[4]; float acl[2], cdv[2];
#pragma unroll
        for (int kk = 0; kk < 4; ++kk) cf[kk] = row_frag(lds + SSD_CS, lrow, 4 * kk + q);
        f32x4 acc[2][2] = {{(f32x4){0.f, 0.f, 0.f, 0.f}, (f32x4){0.f, 0.f, 0.f, 0.f}}, {(f32x4){0.f, 0.f, 0.f, 0.f}, (f32x4){0.f, 0.f, 0.f, 0.f}}};
#pragma unroll
        for (int hd = 0; hd < 2; ++hd) { s16x8 hf[2][4];
            SB();
            acl[hd] = tb[hd * 256 + lrow]; cdv[hd] = tb[hd * 256 + 63];
#pragma unroll
            for (int j = 0; j < 2; ++j)
#pragma unroll
                for (int kk = 0; kk < 4; ++kk) hf[j][kk] = row_frag(hbc + hd * 16384, 16 * (2 * ph + j) + r16, 4 * kk + q);
            SB();
#pragma unroll
            for (int kk = 0; kk < 4; ++kk)
#pragma unroll
                for (int j = 0; j < 2; ++j) acc[hd][j] = __builtin_amdgcn_mfma_f32_16x16x32_bf16(hf[j][kk], cf[kk], acc[hd][j], 0, 0, 0);
            const float el = ex2(acl[hd]); acc[hd][0] = acc[hd][0] * el; acc[hd][1] = acc[hd][1] * el; }
#pragma unroll
        for (int k2 = 0; k2 < 2; ++k2) if (k2 <= (lt >> 1)) {
            const int sx = 32 * k2 + 8 * (r16 >> 2) + (r16 & 3), s0 = 32 * k2 + 8 * q;
            s16x8 bx[4], by[4], xf[2][2];
            SB();
#pragma unroll
            for (int kk = 0; kk < 4; ++kk) { bx[kk] = row_frag(lds + SSD_BS, sx, 4 * kk + q); by[kk] = row_frag(lds + SSD_BS, sx + 4, 4 * kk + q); }
            SB();
            f32x4 gx = (f32x4){0.f, 0.f, 0.f, 0.f}, gy = gx;
#pragma unroll
            for (int kk = 0; kk < 4; ++kk) { gx = __builtin_amdgcn_mfma_f32_16x16x32_bf16(bx[kk], cf[kk], gx, 0, 0, 0); gy = __builtin_amdgcn_mfma_f32_16x16x32_bf16(by[kk], cf[kk], gy, 0, 0, 0); }
#pragma unroll
            for (int hd = 0; hd < 2; ++hd)
#pragma unroll
                for (int j = 0; j < 2; ++j) xf[hd][j] = tr_frag(lds + SSD_XX + hd * 16384, lane, 2 * ph + j, k2);
#pragma unroll
            for (int hd = 0; hd < 2; ++hd) { f32x4 mx, my;
                if (k2 != (lt >> 1)) {
                    const float rowf = ex2(acl[hd] - tb[hd * 256 + 31]);
                    const f32x4 c0 = *(const LAS f32x4*)(tb + hd * 256 + 192 + s0), c1 = *(const LAS f32x4*)(tb + hd * 256 + 192 + s0 + 4);
                    mx = gx * (c0 * rowf); my = gy * (c1 * rowf);
                } else {
                const f32x4 as0 = *(const LAS f32x4*)(tb + hd * 256 + s0), as1 = *(const LAS f32x4*)(tb + hd * 256 + s0 + 4), d0 = *(const LAS f32x4*)(tb + hd * 256 + 64 + s0), d1 = *(const LAS f32x4*)(tb + hd * 256 + 64 + s0 + 4);
#pragma unroll
                for (int e = 0; e < 4; ++e) { mx[e] = (s0 + e <= lrow) ? gx[e] * ex2(acl[hd] - as0[e]) * d0[e] : 0.f; my[e] = (s0 + 4 + e <= lrow) ? gy[e] * ex2(acl[hd] - as1[e]) * d1[e] : 0.f; }
                }
                const s16x8 gms = __builtin_bit_cast(s16x8, (v4u){pk2(mx[0], mx[1]), pk2(mx[2], mx[3]), pk2(my[0], my[1]), pk2(my[2], my[3])});
#pragma unroll
                for (int j = 0; j < 2; ++j) acc[hd][j] = __builtin_amdgcn_mfma_f32_16x16x32_bf16(xf[hd][j], gms, acc[hd][j], 0, 0, 0); }
        }
        v2u xwv[2][2]; s16x8 bt[2], xs[2][2];
        SB();
#pragma unroll
        for (int hd = 0; hd < 2; ++hd)
#pragma unroll
            for (int j = 0; j < 2; ++j) { const int p0 = 16 * (2 * ph + j) + 4 * q; xwv[hd][j] = *(const LAS v2u*)(lds + SSD_XX + hd * 16384 + off_b(lrow, p0 >> 3) + 2 * (p0 & 7)); xs[hd][j] = tr_frag(lds + SSD_XX + hd * 16384, lane, 4 + 2 * ph + j, 0); }
#pragma unroll
        for (int i = 0; i < 2; ++i) bt[i] = tr_frag(lds + SSD_BS, lane, 2 * lt + i, 0);
        SB();
#pragma unroll
        for (int hd = 0; hd < 2; ++hd) { float ss = 0.f;
#pragma unroll
            for (int j = 0; j < 2; ++j) { const v2u xw = xwv[hd][j];
                f32x4 y = acc[hd][j] + Dk[hd] * (f32x4){bf2f((unsigned short)(xw.x & 0xffffu)), bf2f((unsigned short)(xw.x >> 16)), bf2f((unsigned short)(xw.y & 0xffffu)), bf2f((unsigned short)(xw.y >> 16))};
                y = y * (f32x4){bf2f((unsigned short)(zc[hd][j].x & 0xffffu)), bf2f((unsigned short)(zc[hd][j].x >> 16)), bf2f((unsigned short)(zc[hd][j].y & 0xffffu)), bf2f((unsigned short)(zc[hd][j].y >> 16))};
                ss += (y.x * y.x + y.y * y.y) + (y.z * y.z + y.w * y.w);
                ypk[hd][j] = (v2u){pk2(y.x, y.y), pk2(y.z, y.w)}; }
            ss += __shfl_xor(ss, 16); ss += __shfl_xor(ss, 32); ssk[hd] = ss; }
#pragma unroll
        for (int hd = 0; hd < 2; ++hd) { const float cd = ex2(cdv[hd]);
#pragma unroll
            for (int i = 0; i < 2; ++i)
#pragma unroll
                for (int j = 0; j < 2; ++j) Hacc[hd][i][j] = Hacc[hd][i][j] * cd; }
#pragma unroll
        for (int hd = 0; hd < 2; ++hd)
#pragma unroll
            for (int i = 0; i < 2; ++i)
#pragma unroll
                for (int j = 0; j < 2; ++j) Hacc[hd][i][j] = __builtin_amdgcn_mfma_f32_16x16x32_bf16(bt[i], xs[hd][j], Hacc[hd][i][j], 0, 0, 0);
        SB();
#pragma unroll
        for (int i = 0; i < 2; ++i) bt[i] = tr_frag(lds + SSD_BS, lane, 2 * lt + i, 1);
#pragma unroll
        for (int hd = 0; hd < 2; ++hd)
#pragma unroll
            for (int j = 0; j < 2; ++j) xs[hd][j] = tr_frag(lds + SSD_XX + hd * 16384, lane, 4 + 2 * ph + j, 1);
        SB();
#pragma unroll
        for (int hd = 0; hd < 2; ++hd)
#pragma unroll
            for (int i = 0; i < 2; ++i)
#pragma unroll
                for (int j = 0; j < 2; ++j) Hacc[hd][i][j] = __builtin_amdgcn_mfma_f32_16x16x32_bf16(bt[i], xs[hd][j], Hacc[hd][i][j], 0, 0, 0);
#undef SB
        if (more) { SSD_HWRITE((c + 1) & 1); SSD_SCAN((c + 1) & 1); }
        SSD_BAR();
        if (more) { SSD_STAGE_WRITE((c + 1) & 1);
#pragma unroll
            for (int hd = 0; hd < 2; ++hd) { zc[hd][0] = zr[hd][0]; zc[hd][1] = zr[hd][1]; }
            SSD_BAR(); }
    }
    int nb = b, nhp = hp, nmb = mbase;
    asm volatile("" : "+v"(lane), "+v"(r16), "+v"(q), "+v"(xrow), "+v"(xch), "+v"(brow), "+v"(bch), "+v"(lrow));
    if (ui + 1 < nunits) { SSD_DECODE(unit0 + ui + 1, nb, nhp, nmb); SSD_LOAD(0, nmb, nhp); SSD_LOADH(nb, nhp); }
    else {
        asm volatile("" : "=v"(xr[0]), "=v"(xr[1]), "=v"(br[0]), "=v"(br[1]), "=v"(cr[0]), "=v"(cr[1]));
        asm volatile("" : "=v"(zr[0][0]), "=v"(zr[0][1]), "=v"(zr[1][0]), "=v"(zr[1][1]), "=v"(dtl));
#pragma unroll
        for (int hd = 0; hd < 2; ++hd)
#pragma unroll
            for (int i = 0; i < 2; ++i) asm volatile("" : "=v"(Hin[hd][i][0]), "=v"(Hin[hd][i][1])); }
    if (lrow < vr) {
#pragma unroll
        for (int hd = 0; hd < 2; ++hd)
#pragma unroll
            for (int j = 0; j < 2; ++j) *(GAS v2u*)(yg + ((size_t)mbase + 64 * (nchunk - 1) + lrow) * DIN + (h0 + hd) * HD + 16 * (2 * ph + j) + 4 * q) = ypk[hd][j];
        if (q == 0) __hip_atomic_fetch_add(ssq + ((size_t)mbase + 64 * (nchunk - 1) + lrow) * 64, ssk[0] + ssk[1], __ATOMIC_RELAXED, __HIP_MEMORY_SCOPE_AGENT); }
#pragma unroll
    for (int hd = 0; hd < 2; ++hd) { float* so = a.out + (samp ? O_SS : O_SP) + (size_t)((l * (samp ? NBS : NBP) + b) * NH + h0 + hd) * HD * NS;
#pragma unroll
        for (int i = 0; i < 2; ++i)
#pragma unroll
            for (int j = 0; j < 2; ++j) *(GAS f32x4*)(so + (size_t)(16 * (2 * ph + j) + r16) * NS + 16 * (2 * lt + i) + 4 * q) = Hacc[hd][i][j]; }
    b = nb; hp = nhp; mbase = nmb;
    }
#undef SSD_DECODE
#undef SSD_LOADH
#undef SSD_LOAD
#undef SSD_SCAN
#undef SSD_STAGE_WRITE
#undef SSD_HWRITE
#undef SSD_BAR
}
__device__ __forceinline__ void ktab_build(const float* ssq, LAS float* tab, int row0, int sbase, int gfirst, int tid) {
    const int r = tid >> 1, g0 = 4 * (tid & 1);
    const float* p = ssq + (size_t)(row0 + r) * 64;
    float sprev = 1.f;
#pragma unroll
    for (int gg = -1; gg < 4; ++gg) { const int g = g0 + gg; if (g < 0) continue;
        const f32x4* q4 = (const f32x4*)(p + 8 * g); const f32x4 t = q4[0] + q4[1];
        const float sg = 1.f / sqrtf(((t.x + t.y) + (t.z + t.w)) * (1.f / 768.f) + RMS_EPS);
        if (gg >= 0) { tab[g * 256 + r] = sprev / sg; if (g >= gfirst) tab[(sbase + g - gfirst) * 256 + r] = sg; }
        sprev = sg; }
}

constexpr int CW_SAMP = 8192;
__device__ __forceinline__ void sample_norm(const Args& a, int l, int G, int bid, int lane, int wave) {
    const float* ssq = (const float*)(a.ws + WS_YG); bf16* mx = (bf16*)(a.ws + WS_MIXED);
    for (int rr = bid; rr < MS / 2; rr += G) {
        const int m = MP + 2 * rr + (wave >> 2);
#pragma unroll
        for (int gg = 0; gg < 2; ++gg) { const int g = 2 * (wave & 3) + gg;
            const float part = lane < 8 ? ssq[(size_t)m * 64 + 8 * g + lane] : 0.f;
            const float rstd = 1.f / sqrtf(wave_sum(part) * (1.f / 768.f) + RMS_EPS);
            unsigned long long* p = (unsigned long long*)(mx + (size_t)m * DIN + WPOOL + g * 768) + lane;
#pragma unroll
            for (int j = 0; j < 3; ++j) { const unsigned long long q = p[64 * j]; const f32x4 v = pg8::bf4_to_f32((unsigned)q, (unsigned)(q >> 32)) * rstd;
                __hip_atomic_store(p + 64 * j, (unsigned long long)pk2(v.x, v.y) | ((unsigned long long)pk2(v.z, v.w) << 32), __ATOMIC_RELAXED, __HIP_MEMORY_SCOPE_AGENT); } }
    }
    VM_WAIT(); __syncthreads();
    if (wave == 0 && lane == 0) __hip_atomic_fetch_add((unsigned*)(a.ws + WS_CTL) + CW_SAMP, 1u, __ATOMIC_RELAXED, __HIP_MEMORY_SCOPE_AGENT);
}
__device__ __forceinline__ void sample_wait(const Args& a, unsigned target, int lane, int wave) {
    if (wave == 0) { unsigned* cnt = (unsigned*)(a.ws + WS_CTL) + CW_SAMP; unsigned sp = 0;
        while ((unsigned)__builtin_amdgcn_readfirstlane(__hip_atomic_load(cnt, __ATOMIC_RELAXED, __HIP_MEMORY_SCOPE_AGENT)) < target) { __builtin_amdgcn_s_sleep(2); if (++sp > (1u << 22)) break; }
        __builtin_amdgcn_fence(__ATOMIC_ACQUIRE, "agent"); VM_WAIT(); }
    __syncthreads();
}

constexpr int CW_PDONE = 8448, CW_ADONE = 8576, CW_CQ = 8704;
constexpr int PROJ_UNITS1 = (MP / 256) * 72, PROJ_UNITS2 = (MP / 256) + 2 * 73;
struct ProjOrder {
    pg8::StaticOrder so; int G, c, ilast; volatile LAS unsigned* lcnt; unsigned* pdone; unsigned ltarget;
    __device__ void init(int G_, int c_, volatile LAS unsigned* lcnt_, unsigned* pdone_, unsigned ltarget_) { so.init(MP, 72 * 256, G_, c_); G = G_; c = c_; ilast = (PROJ_UNITS1 - 1 - c_) / G_; lcnt = lcnt_; pdone = pdone_; ltarget = ltarget_; }
    __device__ bool next(int i, pg8::Unit& u) const {
        const long L = (long)i * G + c;
        if (L < PROJ_UNITS1) return so.next(i, u);
        const int t = (int)(L - PROJ_UNITS1); if (t >= PROJ_UNITS2) return false;
        if (t < MP / 256) { u.pm = t; u.pn = 72; } else { const int r = t - MP / 256; u.pm = MP / 256 + (r & 1); u.pn = r >> 1; }
        u.g = 0; return true;
    }
    __device__ __forceinline__ void a_ready(const pg8::Unit&) const {}
    __device__ __forceinline__ void done(const pg8::Unit& u) const {
        if (u.ui == ilast) {
            asm volatile("s_waitcnt vmcnt(0)" ::: "memory");
            if (fresh_lane() == 0) {
                const unsigned old = __hip_atomic_fetch_add((LAS unsigned*)lcnt, 1u, __ATOMIC_RELAXED, __HIP_MEMORY_SCOPE_WORKGROUP);
                if (old + 1u == ltarget) {
                    __builtin_amdgcn_fence(__ATOMIC_RELEASE, "agent"); asm volatile("s_waitcnt vmcnt(0)" ::: "memory");
                    __hip_atomic_fetch_add(pdone, 1u, __ATOMIC_RELAXED, __HIP_MEMORY_SCOPE_AGENT); } } }
    }
};
__device__ __forceinline__ void wait_count(unsigned* cnt, unsigned target, int wave) {
    if (wave == 0) { unsigned sp = 0;
        while ((unsigned)__builtin_amdgcn_readfirstlane(__hip_atomic_load(cnt, __ATOMIC_RELAXED, __HIP_MEMORY_SCOPE_AGENT)) < target) { __builtin_amdgcn_s_sleep(2); if (++sp > (1u << 22)) break; }
        __builtin_amdgcn_fence(__ATOMIC_ACQUIRE, "agent"); VM_WAIT(); }
    __syncthreads();
}

__global__ void __launch_bounds__(NWAVES * 64, 2) trunk_fwd(Args args) {
    extern __shared__ __attribute__((aligned(16))) unsigned char lds_raw[];
    LAS unsigned char* lds = (LAS unsigned char*)lds_raw;
    volatile LAS unsigned* MISC = (volatile LAS unsigned*)(lds + MISC_OFF);
    const int wave = __builtin_amdgcn_readfirstlane((int)threadIdx.x >> 6);
    const int tid = wave * 64 + fresh_lane();
    const int G = gridDim.x, bid = blockIdx.x;
    unsigned* ctl = (unsigned*)(args.ws + WS_CTL);
    for (int u = tid; u < (LDS_BYTES - LDSCTL_OFF) / 4; u += NWAVES * 64) ((LAS unsigned*)(lds + LDSCTL_OFF))[u] = 0u;
    __syncthreads();
    const int lo = args.ph_lo, hi = args.ph_hi;
    XcdBarrier bar; bar.bar = ctl + CW_BAR; bar.x = 0; bar.st = MISC + 8; bar.w0 = (wave == 0);
    if (hi - lo > 1) bar = xcd_barrier_post(ctl + CW_BAR, MISC + 8, wave == 0);
#ifndef PROBE_MASK
#define PROBE_MASK 0
#endif
#define REP(kind) for (int _r = 0; _r < (((PROBE_MASK) >> (kind)) & 1 ? 2 : 1); ++_r)
#define IN(k) (lo <= (k) && (k) < hi)
#define BOTH(k) (IN(k) && IN((k) + 1))
#define SEAM(k) do { if (BOTH(k)) xcd_barrier(bar); } while (0)
#ifndef PROBE_SEL
#define PROBE_SEL 0
#endif
#ifndef PROBE_MULT
#define PROBE_MULT 4
#endif
#if PROBE_SEL > 0
    volatile LAS unsigned long long* tsw = (volatile LAS unsigned long long*)(lds + MISC_OFF + 64);
    if (bid == 0 && wave == 0 && fresh_lane() == 0) { tsw[0] = __builtin_amdgcn_s_memrealtime(); tsw[1] = 0ull; }
#define STAMP(kind) do { if (bid == 0 && wave == 0 && fresh_lane() == 0) { const unsigned long long t_ = __builtin_amdgcn_s_memrealtime(); if ((PROBE_SEL >> (kind)) & 1) tsw[1] = tsw[1] + (t_ - tsw[0]); tsw[0] = t_; } } while (0)
#else
#define STAMP(kind) do { } while (0)
#endif

    if (IN(0)) { const int l0 = fresh_lane(); p0_prologue(args, lds, G, bid, wave * 64 + l0, l0, wave); STAMP(0);
                 wait_count(ctl + CW_MOD, (unsigned)G, wave);
                 phase_a(args, lds, G, bid, fresh_lane(), wave); SEAM(0); STAMP(1); }
    for (int l = 0; l < 2; ++l) {
        const int pb = 1 + 4 * l;
#define TL (wave * 64 + fresh_lane())
        if (IN(pb)) {
            pg8::Gemm g{(const pg8::bf16_t*)(args.ws + WS_H), (const pg8::bf16_t*)(args.ws + WS_WIN + (size_t)l * WIN_L), M, NPAD, DM, DM, DM, 0, 0};
            ProjOrder S; S.init(G, bid, MISC + 25, ctl + CW_PDONE + 64 * l, 8u * (unsigned)(l + 1));
            EpiProj E{args.ws, args.out, args.in[14] + (size_t)l * NH, l};
            pg8::gemm_phase<EpiProj, ProjOrder, true, true>(lds, g, S, E, TL);
            if (wave == 0 && fresh_lane() == 0) { __builtin_amdgcn_fence(__ATOMIC_RELEASE, "agent"); asm volatile("s_waitcnt vmcnt(0)" ::: "memory");
                __hip_atomic_fetch_add(ctl + CW_ADONE + 64 * l, 1u, __ATOMIC_RELAXED, __HIP_MEMORY_SCOPE_AGENT); }
            c_zero_ssq(args, G, bid, TL);
            wait_count(ctl + CW_PDONE + 64 * l, (unsigned)G, wave);
            for (;;) {
                if (wave == 0 && fresh_lane() == 0) MISC[24] = __hip_atomic_fetch_add(ctl + CW_CQ + 64 * l, 1u, __ATOMIC_RELAXED, __HIP_MEMORY_SCOPE_AGENT);
                __syncthreads();
                const int it = __builtin_amdgcn_readfirstlane((int)MISC[24]);
                __syncthreads();
                if (it >= C_QITEMS) break;
                c_prompt_item(args, l, it, TL); }
            wait_count(ctl + CW_ADONE + 64 * l, (unsigned)G, wave);
            c_sample_elems(args, l, G, bid, TL);
            SEAM(pb); STAMP(2);
        }
        if (IN(pb + 1)) {
            { pg8::Gemm g{(const pg8::bf16_t*)(args.ws + WS_POOLED), (const pg8::bf16_t*)(args.ws + WS_WP) + (size_t)l * 4 * 512 * 512, M, 512, 512, WPOOL, 512, 512, (size_t)512 * 512};
              pg8::GroupOrder S; S.init(M, 512, 4, G, (bid + 64) % G);
              pg8::EpiPool E{(pg8::bf16_t*)(args.ws + WS_MIXED), DIN, (const pg8::bf16_t*)(args.ws + WS_SG), WPOOL, args.in[11] + (size_t)l * WPOOL};
              pg8::gemm_phase<pg8::EpiPool, pg8::GroupOrder, true, true>(lds, g, S, E, TL);
#if (PROBE_MASK >> 4) & 1
            __syncthreads(); pg8::gemm_phase<pg8::EpiPool, pg8::GroupOrder, true, true>(lds, g, S, E, TL);
#endif
 }
            __syncthreads();
            REP(5) for (int k = 0; ; ++k) {
                int u, nu = 1;
                if (G == 256) { if (k >= 1) break; u = bid < 192 ? bid : NBP * 48 + (bid - 192) * 12; nu = bid < 192 ? 1 : 12; }
                else { u = bid + k * G; if (u >= (NBP + NBS) * 48) break; }
                ssd_unit(args, lds, l, u, nu, TL); }
            SEAM(pb + 1); STAMP(4);
        }
        if (IN(pb + 2)) {   sample_norm(args, l, G, bid, fresh_lane(), wave);
            { pg8::Gemm g{(const pg8::bf16_t*)(args.ws + WS_MIXED), (const pg8::bf16_t*)(args.ws + WS_WOUT + (size_t)l * WOUT_L), MP, DM, DIN, DIN, DIN, 0, 0};
              pg8::StaticOrder S; S.init(MP, DM, G, bid);
              pg8::EpiResid E{(pg8::bf16_t*)(args.ws + WS_R), DM, l == 0 ? args.in[0] : (const float*)(args.ws + WS_X1), (const float*)(args.ws + WS_MODF) + (size_t)l * NBT * 3 * DM + 2 * DM, 3 * DM, ALPHA, lds};
              { const int tt = TL; pg8::Unit u0;
                for (int ui = 0; ui < 2; ++ui) if (S.next(ui, u0)) ktab_build((const float*)(args.ws + WS_YG), (LAS float*)(lds + pg8::KTAB_OFF) + ui * 9 * 256, u0.pm * 256, 8, 7, tt);
                __syncthreads(); }
              pg8::gemm_phase<pg8::EpiResid, pg8::StaticOrder, true, true>(lds, g, S, E, TL);
#if (PROBE_MASK >> 7) & 1
              __syncthreads(); pg8::gemm_phase<pg8::EpiResid, pg8::StaticOrder, true, true>(lds, g, S, E, TL);
#endif
            }
            __syncthreads();
            { pg8::Gemm g{(const pg8::bf16_t*)(args.ws + WS_MIXED) + (size_t)MP * DIN, (const pg8::bf16_t*)(args.ws + WS_WOUT + (size_t)l * WOUT_L), MS, DM, DIN / 8, DIN, DIN, (size_t)(DIN / 8), (size_t)(DIN / 8)};
              pg8::GroupOrder S; S.init(MS, DM, 8, G, bid);
              pg8::EpiSlab E{(float*)(args.ws + WS_SLAB), DM, (size_t)MS * DM};
              sample_wait(args, (unsigned)G * (unsigned)(l + 1), fresh_lane(), wave);
              pg8::gemm_phase<pg8::EpiSlab, pg8::GroupOrder, true, true>(lds, g, S, E, TL); }
            SEAM(pb + 2); STAMP(6);
        }
        if (IN(pb + 3)) { REP(8) phase_g(args, lds, l, G, bid, fresh_lane(), wave); if (pb + 3 < NPHASE - 1) SEAM(pb + 3); STAMP(7); }
    }
#if PROBE_SEL > 0
    if (bid == 0 && wave == 0 && fresh_lane() == 0) { const unsigned long long t_end = __builtin_amdgcn_s_memrealtime() + (unsigned long long)PROBE_MULT * tsw[1]; while (__builtin_amdgcn_s_memrealtime() < t_end) __builtin_amdgcn_s_sleep(8); }
#endif
#undef IN
#undef BOTH
#undef SEAM
}

#ifndef MK_SPLIT
#define MK_SPLIT 0
#endif
extern "C" void kernel_launch(void* const* d_in, const int* in_sizes, int n_in, void* d_out, int out_size, void* d_ws, size_t ws_size, hipStream_t stream) {
    static int grid = 0;
    if (grid == 0) {
        if (n_in != 21 || (size_t)out_size != O_END || ws_size < WS_END) { fprintf(stderr, "kernel_launch: unexpected shapes: n_in %d out %d ws %zu; nothing launched\n", n_in, out_size, ws_size); grid = -1; return; }
        int dev = 0, cus = 0, per_cu = 0;
        if (hipGetDevice(&dev) != hipSuccess || hipDeviceGetAttribute(&cus, hipDeviceAttributeMultiprocessorCount, dev) != hipSuccess) { grid = -1; return; }
        if (hipFuncSetAttribute((const void*)trunk_fwd, hipFuncAttributeMaxDynamicSharedMemorySize, LDS_BYTES) != hipSuccess) { fprintf(stderr, "kernel_launch: hipFuncSetAttribute failed\n"); grid = -1; return; }
        if (hipOccupancyMaxActiveBlocksPerMultiprocessor(&per_cu, (const void*)trunk_fwd, NWAVES * 64, LDS_BYTES) != hipSuccess || per_cu < 1) { fprintf(stderr, "kernel_launch: occupancy query says %d blocks per CU\n", per_cu); (void)hipGetLastError(); grid = -1; return; }
        grid = cus;
    }
    if (grid < 0) return;
    if (hipMemsetAsync((char*)d_ws + WS_CTL, 0, CTL_ZERO_BYTES, stream) != hipSuccess) return;
    Args a{};
    for (int i = 0; i < 21; ++i) a.in[i] = (const float*)d_in[i];
    a.out = (float*)d_out; a.ws = (unsigned char*)d_ws;
#if MK_SPLIT
    for (int ph = 0; ph < NPHASE; ++ph) { a.ph_lo = ph; a.ph_hi = ph + 1; hipLaunchKernelGGL(trunk_fwd, dim3(grid), dim3(NWAVES * 64), LDS_BYTES, stream, a); }
#else
    a.ph_lo = 0; a.ph_hi = NPHASE; hipLaunchKernelGGL(trunk_fwd, dim3(grid), dim3(NWAVES * 64), LDS_BYTES, stream, a);
#endif
}
```

```cpp
#ifndef PROBE_MASK
#define PROBE_MASK 0
#endif
#include <hip/hip_runtime.h>
#include <cstdio>
#include <cstdint>
namespace pg8 {
#define PG8_LAS __attribute__((address_space(3)))
typedef unsigned short bf16_t;
typedef short bf16x8 __attribute__((ext_vector_type(8)));
typedef float f32x4 __attribute__((ext_vector_type(4)));
typedef unsigned u32x4 __attribute__((ext_vector_type(4)));
constexpr int BM = 256, BK = 64, HALF = 128, HTB = HALF * BK * 2  , STAGE_BYTES = 8 * HTB, NXCD = 8, WGM = 8;

__host__ __device__ __forceinline__ int lds_byte(int r, int c) { const int st = (r >> 4) * 2 + (c >> 5), rr = r & 15, cc = c & 31, ob = rr * 64 + cc * 2; return st * 1024 + (ob ^ (((ob >> 9) & 1) << 5)); }
__host__ __device__ __forceinline__ void stage_rc(int b, int& R, int& C) { const int st = b / 1024, sb = b % 1024, swz = sb ^ (((sb >> 9) & 1) << 5); R = (st >> 1) * 16 + swz / 64; C = (st & 1) * 32 + (swz % 64) / 2; }
__host__ __device__ __forceinline__ int perm32(int rho) { const int n = rho >> 4, i = rho & 15; return 8 * (i >> 2) + 4 * n + (i & 3); }

struct Unit { int pm, pn, g, ui; };
struct Gemm { const bf16_t* A; const bf16_t* Bt; int M, N, K, lda, ldb; size_t a_goff, b_goff; };

struct StaticOrder {
    int nM, nN, nwg, G, c;
    __host__ __device__ void init(int M, int N, int G_, int c_) { nM = M / BM; nN = N / BM; nwg = nM * nN; G = G_; c = c_; }
    __host__ __device__ bool next(int i, Unit& u) const {
        const long L = (long)i * G + c; if (L >= nwg) return false;
        int wgid = (int)L; { const int q = nwg / NXCD, r = nwg % NXCD, xcd = wgid % NXCD, off = wgid / NXCD; wgid = (xcd < r ? xcd * (q + 1) : r * (q + 1) + (xcd - r) * q) + off; }
        const int nig = WGM * nN, gid = wgid / nig, fm = gid * WGM, gsz = (nM - fm) < WGM ? (nM - fm) : WGM;
        u.pm = fm + ((wgid % nig) % gsz); u.pn = (wgid % nig) / gsz; u.g = 0; return true;
    }
    __device__ __forceinline__ void a_ready(const Unit&) const {}
    __device__ __forceinline__ void done(const Unit&) const {}
};
struct GroupOrder {
    int nM, nN, ng, G, c;
    __host__ __device__ void init(int M, int N, int ng_, int G_, int c_) { nM = M / BM; nN = N / BM; ng = ng_; G = G_; c = c_; }
    __host__ __device__ bool next(int i, Unit& u) const {
        const long L = (long)i * G + c; if (L >= (long)nM * nN * ng) return false;
        const int per = nM * nN, l = (int)L; u.g = l / per; const int r = l % per; u.pm = r % nM; u.pn = r / nM; return true;
    }
    __device__ __forceinline__ void a_ready(const Unit&) const {}
    __device__ __forceinline__ void done(const Unit&) const {}
};

typedef __bf16 hwbf16x2 __attribute__((ext_vector_type(2))); typedef float f32x2c __attribute__((ext_vector_type(2)));
__device__ __forceinline__ unsigned cvt_pk_bf16(float lo, float hi) { return __builtin_bit_cast(unsigned, __builtin_convertvector((f32x2c){lo, hi}, hwbf16x2)); }
__device__ __forceinline__ float silu_f(float x) { return x * __builtin_amdgcn_rcpf(1.0f + __expf(-x)); }

__device__ __forceinline__ f32x4 bf4_to_f32(unsigned lo, unsigned hi) { return (f32x4){__builtin_bit_cast(float, lo << 16), __builtin_bit_cast(float, lo & 0xffff0000u), __builtin_bit_cast(float, hi << 16), __builtin_bit_cast(float, hi & 0xffff0000u)}; }
constexpr int KTAB_OFF = 135168;
__device__ __forceinline__ void kscale_acc(f32x4 (&acc)[2][2][4][2], const PG8_LAS float* col, int wr, int fr) {
#pragma unroll
    for (int ai = 0; ai < 2; ++ai)
#pragma unroll
        for (int m = 0; m < 4; ++m) { const float f = col[ai * HALF + wr * 64 + m * 16 + fr];
#pragma unroll
            for (int bj = 0; bj < 2; ++bj)
#pragma unroll
                for (int n = 0; n < 2; ++n) acc[ai][bj][m][n] = acc[ai][bj][m][n] * f; }
}
struct EpiSlab {
    static constexpr bool PERM = false, AFTER_DRAIN = false, KHOOK = false;
    float* C; int ldc; size_t gstride;
    __device__ __forceinline__ void operator()(const f32x4 (&acc)[2][2][4][2], const Unit& u, int wr, int wc, int fr, int fq) const {
        asm volatile("" : "+v"(fr), "+v"(fq));
        const int row0 = u.pm * BM + wr * 64 + fr, col0 = u.pn * BM + wc * 32 + 4 * fq; float* Cg = C + (size_t)u.g * gstride;
#pragma unroll
        for (int ai = 0; ai < 2; ++ai)
#pragma unroll
            for (int m = 0; m < 4; ++m) { float* rowp = Cg + (size_t)(row0 + ai * HALF + m * 16) * ldc + col0;
#pragma unroll
                for (int bj = 0; bj < 2; ++bj)
#pragma unroll
                    for (int n = 0; n < 2; ++n) *(f32x4*)(rowp + bj * HALF + n * 16) = acc[ai][bj][m][n]; }
    }
};
struct EpiPool {
    static constexpr bool PERM = true, AFTER_DRAIN = false, KHOOK = false;
    bf16_t* O; int ldo; const bf16_t* sg; int ldp; const float* pscale;
    __device__ __forceinline__ void operator()(const f32x4 (&acc)[2][2][4][2], const Unit& u, int wr, int wc, int fr, int fq) const {
        asm volatile("" : "+v"(fr), "+v"(fq));
        const int row0 = u.pm * BM + wr * 64 + fr, col0 = u.g * 512 + u.pn * BM + wc * 32 + 8 * fq;
        f32x4 ps[2][2];
#pragma unroll
        for (int bj = 0; bj < 2; ++bj)
#pragma unroll
            for (int n = 0; n < 2; ++n) ps[bj][n] = *(const f32x4*)(pscale + col0 + bj * HALF + 4 * n);
#pragma unroll
        for (int ai = 0; ai < 2; ++ai)
#pragma unroll
            for (int m = 0; m < 4; ++m) { const size_t row = (size_t)(row0 + ai * HALF + m * 16);
#pragma unroll
                for (int bj = 0; bj < 2; ++bj) { const int c = col0 + bj * HALF;
                    const u32x4 gq = *(const u32x4*)(sg + row * ldp + c);
                    const f32x4 v0 = acc[ai][bj][m][0] * ps[bj][0] * bf4_to_f32(gq.x, gq.y), v1 = acc[ai][bj][m][1] * ps[bj][1] * bf4_to_f32(gq.z, gq.w);
                    u32x4 w; w.x = cvt_pk_bf16(v0[0], v0[1]); w.y = cvt_pk_bf16(v0[2], v0[3]); w.z = cvt_pk_bf16(v1[0], v1[1]); w.w = cvt_pk_bf16(v1[2], v1[3]);
                    *(u32x4*)(O + row * ldo + c) = w; } }
    }
};
struct EpiResid {
    static constexpr bool PERM = true, AFTER_DRAIN = false, KHOOK = true;
    bf16_t* R; int ldr; const float* xp; const float* gate; int ldg; float alpha; PG8_LAS unsigned char* lds;
    __device__ __forceinline__ void khook(f32x4 (&acc)[2][2][4][2], const Unit& u, int t, int wr, int fr) const {
        if (t >= 32 && (t - 32) % 12 == 0) kscale_acc(acc, (const PG8_LAS float*)(lds + KTAB_OFF) + (u.ui * 9 + (t - 32) / 12) * 256, wr, fr);
    }
    __device__ __forceinline__ void operator()(const f32x4 (&acc)[2][2][4][2], const Unit& u, int wr, int wc, int fr, int fq) const {
        asm volatile("" : "+v"(fr), "+v"(fq));
        const int row0 = u.pm * BM + wr * 64 + fr, col0 = u.pn * BM + wc * 32 + 8 * fq;
        const float* gr = gate + (size_t)(u.pm >> 3) * ldg + col0;
        f32x4 gv[2][2];
#pragma unroll
        for (int bj = 0; bj < 2; ++bj)
#pragma unroll
            for (int n = 0; n < 2; ++n) gv[bj][n] = *(const f32x4*)(gr + bj * HALF + 4 * n);
        u32x4 pk[2][4][2];
#pragma unroll
        for (int ai = 0; ai < 2; ++ai)
#pragma unroll
            for (int m = 0; m < 4; ++m) { const float s7 = ((const PG8_LAS float*)(lds + KTAB_OFF))[(u.ui * 9 + 8) * 256 + ai * HALF + wr * 64 + m * 16 + fr];
#pragma unroll
                for (int bj = 0; bj < 2; ++bj) { const f32x4 v0 = acc[ai][bj][m][0] * gv[bj][0] * s7, v1 = acc[ai][bj][m][1] * gv[bj][1] * s7;
                    pk[ai][m][bj] = (u32x4){cvt_pk_bf16(v0[0], v0[1]), cvt_pk_bf16(v0[2], v0[3]), cvt_pk_bf16(v1[0], v1[1]), cvt_pk_bf16(v1[2], v1[3])}; } }
#pragma unroll
        for (int ai = 0; ai < 2; ++ai) { f32x4 xv[4][2][2];
            __builtin_amdgcn_sched_barrier(0);
#pragma unroll
            for (int m = 0; m < 4; ++m) { const float* xr = xp + (size_t)(row0 + ai * HALF + m * 16) * 4096 + col0;
#pragma unroll
                for (int bj = 0; bj < 2; ++bj)
#pragma unroll
                    for (int n = 0; n < 2; ++n) xv[m][bj][n] = *(const f32x4*)(xr + bj * HALF + 4 * n); }
            __builtin_amdgcn_sched_barrier(0);
#pragma unroll
            for (int m = 0; m < 4; ++m) { bf16_t* rr = R + (size_t)(row0 + ai * HALF + m * 16) * ldr + col0;
#pragma unroll
                for (int bj = 0; bj < 2; ++bj) { const u32x4 t = pk[ai][m][bj];
                    const f32x4 o0 = xv[m][bj][0] * alpha + bf4_to_f32(t.x, t.y), o1 = xv[m][bj][1] * alpha + bf4_to_f32(t.z, t.w);
                    u32x4 w; w.x = cvt_pk_bf16(o0[0], o0[1]); w.y = cvt_pk_bf16(o0[2], o0[3]); w.z = cvt_pk_bf16(o1[0], o1[1]); w.w = cvt_pk_bf16(o1[2], o1[3]);
                    *(u32x4*)(rr + bj * HALF) = w; } } }
    }
};

template <class Epi, class Sched, bool ALIGN_EPI = false, bool SP2 = false>
__device__ __forceinline__ void gemm_phase(PG8_LAS unsigned char* lds, const Gemm g, const Sched& S, const Epi& E, const int tid) {
    const int wid = __builtin_amdgcn_readfirstlane(tid >> 6), lane = tid & 63, wr = wid >> 2, wc = wid & 3, fr = lane & 15, fq = lane >> 4;
    const int K = g.K, nt = K / BK;
    unsigned voffA[2], voffB[2];
#pragma unroll
    for (int i = 0; i < 2; ++i) { int R, C; stage_rc(tid * 16 + i * 8192, R, C); const int Rb = Epi::PERM ? ((R & ~31) + perm32(R & 31)) : R;
        voffA[i] = (unsigned)(R * g.lda + C) * 2u; voffB[i] = (unsigned)(Rb * g.ldb + C) * 2u; }
    const size_t kstep = (size_t)(BK * 2);
    const size_t hstepA = (size_t)HALF * g.lda * 2, hstepB = (size_t)HALF * g.ldb * 2;
    const size_t tstepA = 2 * hstepA, tstepB = 2 * hstepB;
    const unsigned ldsw = (unsigned)wid * 1024u;
    const int aoff = lds_byte(wr * 64 + fr, fq * 8), boff = lds_byte(wc * 32 + fr, fq * 8);
#define PG8_SA(b, h) (((b) * 2 + (h)) * HTB)
#define PG8_SB(b, h) ((4 + (b) * 2 + (h)) * HTB)
#define PG8_STAGE(bufoff, gbase, voff) do { _Pragma("unroll") for (int _i = 0; _i < 2; ++_i) \
        __builtin_amdgcn_global_load_lds((const unsigned*)((const char*)(gbase) + (voff)[_i]), (PG8_LAS unsigned*)(lds + (bufoff) + ldsw + _i * 8192), 16, 0, 0); } while (0)
#define PG8_LDA(dst, b, h) do { _Pragma("unroll") for (int m = 0; m < 4; ++m) _Pragma("unroll") for (int k = 0; k < 2; ++k) dst[m][k] = *(const PG8_LAS bf16x8*)(lds + PG8_SA(b, h) + aoff + m * 2048 + k * 1024); } while (0)
#define PG8_LDB(dst, b, h) do { _Pragma("unroll") for (int n = 0; n < 2; ++n) _Pragma("unroll") for (int k = 0; k < 2; ++k) dst[n][k] = *(const PG8_LAS bf16x8*)(lds + PG8_SB(b, h) + boff + n * 2048 + k * 1024); } while (0)
#define PG8_MMA(ai, bj, At, Bt) do { __builtin_amdgcn_s_setprio(1); _Pragma("unroll") for (int m = 0; m < 4; ++m) _Pragma("unroll") for (int n = 0; n < 2; ++n) _Pragma("unroll") for (int k = 0; k < 2; ++k) \
        acc[ai][bj][m][n] = __builtin_amdgcn_mfma_f32_16x16x32_bf16(Bt[n][k], At[m][k], acc[ai][bj][m][n], 0, 0, 0); __builtin_amdgcn_s_setprio(0); } while (0)
#define PG8_WAIT_V(n) asm volatile("s_waitcnt vmcnt(" #n ")" ::: "memory")
#define PG8_WAIT_L(n) asm volatile("s_waitcnt lgkmcnt(" #n ")" ::: "memory")
#define PG8_BAR __builtin_amdgcn_s_barrier()
#define PG8_SCHED __builtin_amdgcn_sched_barrier(0)
    Unit cur, nxt; int ui = 0;
    if (!S.next(0, cur)) return;
    cur.ui = 0;
    f32x4 acc[2][2][4][2];
#pragma unroll
    for (int a = 0; a < 2; ++a)
#pragma unroll
        for (int b = 0; b < 2; ++b)
#pragma unroll
            for (int m = 0; m < 4; ++m)
#pragma unroll
                for (int n = 0; n < 2; ++n) acc[a][b][m][n] = (f32x4){0.f, 0.f, 0.f, 0.f};
    bf16x8 At[4][2], B0[2][2], B1[2][2];
    const char* cA = (const char*)g.A + (size_t)cur.g * g.a_goff * 2 + (size_t)cur.pm * tstepA; const char* cB = (const char*)g.Bt + (size_t)cur.g * g.b_goff * 2 + (size_t)cur.pn * tstepB;
    S.a_ready(cur);
    if constexpr (SP2) {
        PG8_STAGE(PG8_SB(0, 0), cB, voffB); PG8_STAGE(PG8_SB(0, 1), cB + hstepB, voffB); PG8_STAGE(PG8_SA(0, 0), cA, voffA); PG8_STAGE(PG8_SA(0, 1), cA + hstepA, voffA);
        if (wr == 1) PG8_BAR;
        PG8_WAIT_V(2); PG8_BAR;
        PG8_STAGE(PG8_SB(1, 0), cB + kstep, voffB); PG8_STAGE(PG8_SA(1, 0), cA + kstep, voffA); PG8_STAGE(PG8_SB(1, 1), cB + hstepB + kstep, voffB);
        PG8_WAIT_V(6); PG8_BAR;
    } else {
        PG8_STAGE(PG8_SB(0, 0), cB, voffB); PG8_STAGE(PG8_SA(0, 0), cA, voffA); PG8_STAGE(PG8_SB(0, 1), cB + hstepB, voffB); PG8_STAGE(PG8_SA(0, 1), cA + hstepA, voffA);
        if (wr == 1) PG8_BAR;
        PG8_WAIT_V(4); PG8_BAR;
        PG8_STAGE(PG8_SB(1, 0), cB + kstep, voffB); PG8_STAGE(PG8_SA(1, 0), cA + kstep, voffA); PG8_STAGE(PG8_SB(1, 1), cB + hstepB + kstep, voffB);
        PG8_WAIT_V(6); PG8_BAR;
    }
    for (;;) {
        const bool has_next = S.next(ui + 1, nxt); nxt.ui = ui + 1;
        const char* nA = has_next ? (const char*)g.A + (size_t)nxt.g * g.a_goff * 2 + (size_t)nxt.pm * tstepA : cA; const char* nB = has_next ? (const char*)g.Bt + (size_t)nxt.g * g.b_goff * 2 + (size_t)nxt.pn * tstepB : cB;
        for (int t = 0; t < nt; t += 2) {
            const bool last = (t == nt - 2);
            const char* a1 = cA + (size_t)(t + 1) * kstep;
            const char* a2 = last ? nA : cA + (size_t)(t + 2) * kstep; const char* b2 = last ? nB : cB + (size_t)(t + 2) * kstep;
            const char* a3 = a2 + kstep; const char* b3 = b2 + kstep;
            if (last && has_next) S.a_ready(nxt);
            if constexpr (Epi::KHOOK) E.khook(acc, cur, t, wr, fr);
            if constexpr (SP2) {
            PG8_LDB(B0, 0, 0); PG8_LDB(B1, 0, 1); PG8_SCHED; PG8_LDA(At, 0, 0); PG8_STAGE(PG8_SA(1, 1), a1 + hstepA, voffA);
            PG8_WAIT_V(8); PG8_WAIT_L(0); PG8_BAR; PG8_MMA(0, 0, At, B0); PG8_MMA(0, 1, At, B1); PG8_BAR; PG8_SCHED;
            PG8_LDA(At, 0, 1); PG8_STAGE(PG8_SB(0, 0), b2, voffB); PG8_STAGE(PG8_SB(0, 1), b2 + hstepB, voffB); PG8_STAGE(PG8_SA(0, 0), a2, voffA);
            PG8_WAIT_V(8); PG8_WAIT_L(0); PG8_BAR; PG8_MMA(1, 0, At, B0); PG8_MMA(1, 1, At, B1); PG8_BAR; PG8_SCHED;
            PG8_LDB(B0, 1, 0); PG8_LDB(B1, 1, 1); PG8_SCHED; PG8_LDA(At, 1, 0); PG8_STAGE(PG8_SA(0, 1), a2 + hstepA, voffA);
            PG8_WAIT_V(8); PG8_WAIT_L(0); PG8_BAR; PG8_MMA(0, 0, At, B0); PG8_MMA(0, 1, At, B1); PG8_BAR; PG8_SCHED;
            PG8_LDA(At, 1, 1); PG8_STAGE(PG8_SB(1, 0), b3, voffB); PG8_STAGE(PG8_SB(1, 1), b3 + hstepB, voffB); PG8_STAGE(PG8_SA(1, 0), a3, voffA);
            PG8_WAIT_V(8); PG8_WAIT_L(0); PG8_BAR; PG8_MMA(1, 0, At, B0); PG8_MMA(1, 1, At, B1); PG8_BAR; PG8_SCHED;
            } else {
            PG8_LDB(B0, 0, 0); PG8_SCHED; PG8_LDA(At, 0, 0); PG8_STAGE(PG8_SA(1, 1), a1 + hstepA, voffA);
            PG8_WAIT_L(8); PG8_BAR; PG8_WAIT_L(0); PG8_MMA(0, 0, At, B0); PG8_BAR; PG8_SCHED;
            PG8_LDB(B1, 0, 1); PG8_STAGE(PG8_SB(0, 0), b2, voffB);
            PG8_BAR; PG8_WAIT_L(0); PG8_MMA(0, 1, At, B1); PG8_BAR;
            PG8_LDA(At, 0, 1); PG8_STAGE(PG8_SA(0, 0), a2, voffA);
            PG8_BAR; PG8_WAIT_L(0); PG8_MMA(1, 0, At, B0); PG8_BAR; PG8_SCHED;
            PG8_STAGE(PG8_SB(0, 1), b2 + hstepB, voffB);
            PG8_WAIT_V(6); PG8_BAR; PG8_MMA(1, 1, At, B1); PG8_BAR;
            PG8_LDB(B0, 1, 0); PG8_SCHED; PG8_LDA(At, 1, 0); PG8_STAGE(PG8_SA(0, 1), a2 + hstepA, voffA);
            PG8_WAIT_L(8); PG8_BAR; PG8_WAIT_L(0); PG8_MMA(0, 0, At, B0); PG8_BAR; PG8_SCHED;
            PG8_LDB(B1, 1, 1); PG8_STAGE(PG8_SB(1, 0), b3, voffB);
            PG8_BAR; PG8_WAIT_L(0); PG8_MMA(0, 1, At, B1); PG8_BAR;
            PG8_LDA(At, 1, 1); PG8_STAGE(PG8_SA(1, 0), a3, voffA);
            PG8_BAR; PG8_WAIT_L(0); PG8_MMA(1, 0, At, B0); PG8_BAR; PG8_SCHED;
            PG8_STAGE(PG8_SB(1, 1), b3 + hstepB, voffB);
            PG8_WAIT_V(6); PG8_BAR; PG8_MMA(1, 1, At, B1); PG8_BAR;
            }
        }
        if constexpr (ALIGN_EPI) { if (wr == 0) PG8_BAR; }
        if constexpr (!Epi::AFTER_DRAIN) { E(acc, cur, wr, wc, fr, fq); S.done(cur); }
        if (!has_next) break;
#pragma unroll
        for (int a = 0; a < 2; ++a)
#pragma unroll
            for (int b = 0; b < 2; ++b)
#pragma unroll
                for (int m = 0; m < 4; ++m)
#pragma unroll
                    for (int n = 0; n < 2; ++n) acc[a][b][m][n] = (f32x4){0.f, 0.f, 0.f, 0.f};
        cur = nxt; cA = nA; cB = nB; ++ui;
        if constexpr (ALIGN_EPI) { if (wr == 1) PG8_BAR; }
    }
    PG8_WAIT_V(0);
    if constexpr (!ALIGN_EPI) { if (wr == 0) PG8_BAR; }
    PG8_BAR;
    if constexpr (Epi::AFTER_DRAIN) { E.fused(acc, cur, wr, wc, fr, fq, lds, wid, lane); S.done(cur); }
#undef PG8_SA
#undef PG8_SB
#undef PG8_STAGE
#undef PG8_LDA
#undef PG8_LDB
#undef PG8_MMA
#undef PG8_WAIT_V
#undef PG8_WAIT_L
#undef PG8_BAR
#undef PG8_SCHED
}
}

constexpr int DM = 4096, NBP = 4, SEQ = 2048, NBS = 16, DSEQ = 32, PAST = 1024;
constexpr int MP = NBP * SEQ, MS = NBS * DSEQ, M = MP + MS, NBT = NBP + NBS;
constexpr int WPOOL = 2048, WSSD = 6144, HD = 64, NH = 96, NS = 128, CONVD = 8192, IN_DIM = 18528, NPAD = 18688, DIN = 8192;
constexpr int C_U = 0, C_G = 2048, C_Z = 4096, C_X = 10240, C_B = C_X + 6144, C_C = C_B + 1024, C_DT = 18432;
constexpr float LN_EPS = 1e-5f, RMS_EPS = 1e-5f, ALPHA = 1.41421356237f;
constexpr size_t O_Y = 0, O_PP = 35651584, O_CP = 35897344, O_SP = 36093952, O_PS = 42385408, O_CS = 43368448, O_SS = 44154880, O_END = 69320704;
constexpr size_t MiB = 1u << 20;
constexpr size_t WS_CTL = 0, CTL_ZERO_BYTES = 1 * MiB, WS_MODF = 1 * MiB, WS_WIN = 4 * MiB, WIN_L = 146 * MiB, WS_WOUT = 296 * MiB, WOUT_L = 64 * MiB, WS_WP = 424 * MiB,
                 WS_H = 428 * MiB, WS_UP = 496 * MiB, WS_SG = 530 * MiB, WS_SZ = 564 * MiB, WS_XP = 666 * MiB, WS_XBC = 802 * MiB, WS_POOLED = 938 * MiB, WS_DTV = 972 * MiB,
                 WS_YG = 976 * MiB, WS_MIXED = 1078 * MiB, WS_R = 1214 * MiB, WS_X1 = 1350 * MiB, WS_SLAB = 1486 * MiB, WS_END = 1550 * MiB;
static_assert((size_t)NPAD * DM * 2 == WIN_L && (size_t)DM * DIN * 2 == WOUT_L && WS_SZ + (size_t)M * WSSD * 2 <= WS_XP && WS_XP + (size_t)M * CONVD * 2 <= WS_XBC && WS_SLAB + (size_t)8 * MS * DM * 4 <= WS_END, "ws map");
constexpr int CW_MOD = 8128;
constexpr int CW_BAR = 4096;
constexpr int RING_BYTES = 131072, LDSCTL_OFF = RING_BYTES, MISC_OFF = LDSCTL_OFF + 320, LDS_BYTES = 155648;
constexpr int NWAVES = 8;
constexpr int NPHASE = 9;

struct EpiProj {
    typedef pg8::bf16_t bf16_t; typedef pg8::f32x4 f32x4; typedef pg8::u32x4 u32x4; typedef pg8::Unit Unit; static constexpr int BM = pg8::BM, HALF = pg8::HALF;
    static constexpr bool PERM = true, AFTER_DRAIN = false, KHOOK = false;
    unsigned char* ws; float* out; const float* dtb; int l;
    __device__ __forceinline__ void operator()(const f32x4 (&acc)[2][2][4][2], const Unit& u, int wr, int wc, int fr, int fq) const {
        asm volatile("" : "+v"(fr), "+v"(fq));
        const int pn = u.pn, row0 = u.pm * BM + wr * 64 + fr, cl = wc * 32 + 8 * fq;
        if (pn < 8 || (pn >= 40 && pn < 72)) {
            const bool pool = pn < 8; bf16_t* O = (bf16_t*)(ws + (pool ? WS_UP : WS_XP)); const int ldo = pool ? 2048 : 8192, c0 = (pool ? pn : pn - 40) * BM + cl, hist = pool ? 15 : 3;
#pragma unroll
            for (int ai = 0; ai < 2; ++ai)
#pragma unroll
                for (int m = 0; m < 4; ++m) { const int row = row0 + ai * HALF + m * 16;
#pragma unroll
                    for (int bj = 0; bj < 2; ++bj) { const f32x4 v0 = acc[ai][bj][m][0], v1 = acc[ai][bj][m][1];
                        u32x4 w; w.x = pg8::cvt_pk_bf16(v0[0], v0[1]); w.y = pg8::cvt_pk_bf16(v0[2], v0[3]); w.z = pg8::cvt_pk_bf16(v1[0], v1[1]); w.w = pg8::cvt_pk_bf16(v1[2], v1[3]);
                        *(u32x4*)(O + (size_t)row * ldo + c0 + bj * HALF) = w; }
                    asm volatile("" ::: "memory"); }
            if (u.pm >= 32 || (u.pm & 7) == 7) {
#pragma unroll
                for (int ai = 0; ai < 2; ++ai)
#pragma unroll
                    for (int m = 0; m < 4; ++m) { const int row = row0 + ai * HALF + m * 16;
                        const bool samp = row >= 8192; const int t = samp ? ((row - 8192) & 31) : (row & 2047), L = samp ? 32 : 2048, b = samp ? ((row - 8192) >> 5) : (row >> 11);
                        if (t >= L - hist) { float* nb = out + (samp ? (pool ? O_PS : O_CS) : (pool ? O_PP : O_CP)) + ((size_t)(l * (samp ? NBS : NBP) + b) * hist + (t - (L - hist))) * ldo + c0;
#pragma unroll
                            for (int bj = 0; bj < 2; ++bj) { *(f32x4*)(nb + bj * HALF) = acc[ai][bj][m][0]; *(f32x4*)(nb + bj * HALF + 4) = acc[ai][bj][m][1]; } }
                        asm volatile("" ::: "memory"); }
            }
        } else if (pn < 40) {
            const bool gp = pn < 16; bf16_t* O = (bf16_t*)(ws + (gp ? WS_SG : WS_SZ)); const int ldo = gp ? 2048 : 6144, c0 = (gp ? pn - 8 : pn - 16) * BM + cl;
#pragma unroll
            for (int ai = 0; ai < 2; ++ai)
#pragma unroll
                for (int m = 0; m < 4; ++m) { const int row = row0 + ai * HALF + m * 16;
#pragma unroll
                    for (int bj = 0; bj < 2; ++bj) { f32x4 v0 = acc[ai][bj][m][0], v1 = acc[ai][bj][m][1];
#pragma unroll
                        for (int j = 0; j < 4; ++j) { v0[j] = pg8::silu_f(v0[j]); v1[j] = pg8::silu_f(v1[j]); }
                        u32x4 w; w.x = pg8::cvt_pk_bf16(v0[0], v0[1]); w.y = pg8::cvt_pk_bf16(v0[2], v0[3]); w.z = pg8::cvt_pk_bf16(v1[0], v1[1]); w.w = pg8::cvt_pk_bf16(v1[2], v1[3]);
                        *(u32x4*)(O + (size_t)row * ldo + c0 + bj * HALF) = w; }
                    asm volatile("" ::: "memory"); }
        } else {
            if (cl < 96) {
#pragma unroll
                for (int n = 0; n < 2; ++n)
#pragma unroll
                    for (int j = 0; j < 4; ++j) { const int c = cl + 4 * n + j; const float bias = dtb[c];
#pragma unroll
                        for (int ai = 0; ai < 2; ++ai)
#pragma unroll
                            for (int m = 0; m < 4; ++m) { const float x = acc[ai][0][m][n][j] + bias;
                                ((float*)(ws + WS_DTV))[(size_t)c * 8704 + row0 + ai * HALF + m * 16] = fmaxf(x, 0.f) + log1pf(expf(-fabsf(x))); } }
            }
        }
    }
};

#define GAS __attribute__((address_space(1)))
#define LAS __attribute__((address_space(3)))
typedef unsigned short bf16;
typedef unsigned v4u __attribute__((ext_vector_type(4)));
typedef unsigned v2u __attribute__((ext_vector_type(2)));
typedef float f32x4 __attribute__((ext_vector_type(4)));
typedef float f32x2 __attribute__((ext_vector_type(2)));
#define LDS_WAIT() asm volatile("s_waitcnt lgkmcnt(0)" ::: "memory")
#define VM_WAIT() asm volatile("s_waitcnt vmcnt(0)" ::: "memory")
__device__ __forceinline__ unsigned f2bf(float f) { unsigned u = __builtin_bit_cast(unsigned, f); return (u + 0x7fffu + ((u >> 16) & 1u)) >> 16; }
typedef __bf16 hwbf16x2 __attribute__((ext_vector_type(2)));
__device__ __forceinline__ unsigned pk2(float lo, float hi) { return __builtin_bit_cast(unsigned, __builtin_convertvector((f32x2){lo, hi}, hwbf16x2)); }
__device__ __forceinline__ float bf2f(unsigned short b) { return __builtin_bit_cast(float, ((unsigned)b) << 16); }
__device__ __forceinline__ float silu(float x) { return x / (1.0f + __expf(-x)); }
__device__ __forceinline__ int fresh_lane() { int l; asm volatile("v_mbcnt_lo_u32_b32 %0, -1, 0\n\tv_mbcnt_hi_u32_b32 %0, -1, %0" : "=v"(l)); return l; }
__device__ __forceinline__ float wave_sum(float v) {
#pragma unroll
    for (int o = 1; o < 64; o <<= 1) v += __shfl_xor(v, o);
    return v;
}

#define XB_TMO      128
#define XB_XCNT(j)  (256  + 64 * (j))
#define XB_XSUB(j)  (1280 + 64 * (j))
#define XB_XGEN(j)  (2304 + 64 * (j))
#define XB_TOP      3328
#define XB_TOPGEN   3392
#define XCD_BAR_WORDS 3456
#define XB_SPIN_CAP (1u << 18)
__device__ __forceinline__ unsigned xb_ld(unsigned* p)              { return __hip_atomic_load(p, __ATOMIC_RELAXED, __HIP_MEMORY_SCOPE_AGENT); }
__device__ __forceinline__ unsigned xb_add(unsigned* p, unsigned v) { return __hip_atomic_fetch_add(p, v, __ATOMIC_RELAXED, __HIP_MEMORY_SCOPE_AGENT); }
__device__ __forceinline__ unsigned xb_xcc_id() { return (unsigned)__builtin_amdgcn_s_getreg((3 << 11) | 20) & 0xFu; }
#define XB_SPIN(cond, bar) do { unsigned _sp = 0; while (cond) { __builtin_amdgcn_s_sleep(1); \
    if ((++_sp & 255u) == 0u) { if (xb_ld(&(bar)[XB_TMO])) break; if (_sp > XB_SPIN_CAP) { atomicAdd(&(bar)[XB_TMO], 1u); break; } } } } while (0)
struct XcdBarrier { unsigned* bar; unsigned x; volatile LAS unsigned* st; unsigned w0; };
__device__ __forceinline__ XcdBarrier xcd_barrier_post(unsigned* bar, volatile LAS unsigned* st, unsigned w0) {
    XcdBarrier b; b.bar = bar; b.x = xb_xcc_id(); b.st = st; b.w0 = w0;
    if (w0 && fresh_lane() == 0) (void)xb_add(&bar[XB_XCNT(b.x)], 1u);
    return b;
}
__device__ __forceinline__ void xcd_barrier_complete(unsigned* bar, unsigned x, unsigned& nloc, unsigned& nx) {
    const unsigned G = gridDim.x * gridDim.y * gridDim.z;
    unsigned sum, cnt, mine, sp = 0u;
    for (;;) {
        sum = 0u; cnt = 0u; mine = 0u;
#pragma unroll
        for (unsigned j = 0; j < 16; ++j) { const unsigned c = xb_ld(&bar[XB_XCNT(j)]); sum += c; cnt += (c > 0u) ? 1u : 0u; mine = (j == x) ? c : mine; }
        if (sum == G) break;
        __builtin_amdgcn_s_sleep(1);
        if ((++sp & 255u) == 0u) { if (xb_ld(&bar[XB_TMO])) break; if (sp > XB_SPIN_CAP) { atomicAdd(&bar[XB_TMO], 1u); break; } }
    }
    nloc = mine > 0u ? mine : 1u; nx = cnt > 0u ? cnt : 1u;
}
__device__ __forceinline__ void xcd_barrier(const XcdBarrier& b) {
    asm volatile("s_waitcnt vmcnt(0)" ::: "memory");
    __syncthreads();
    if (b.w0 && fresh_lane() == 0) {
        unsigned* bar = b.bar;
        __builtin_amdgcn_s_waitcnt(0);
        unsigned nloc = b.st[0], nx = b.st[1];
        if (nloc == 0u) { xcd_barrier_complete(bar, b.x, nloc, nx); b.st[0] = nloc; b.st[1] = nx; }
        const unsigned old = xb_add(&bar[XB_XSUB(b.x)], 1u);
        const unsigned gen = old / nloc;
        if (old + 1u == (gen + 1u) * nloc) {
            __builtin_amdgcn_fence(__ATOMIC_RELEASE, "agent");
            asm volatile("s_waitcnt vmcnt(0)" ::: "memory");
            const unsigned og = xb_add(&bar[XB_TOP], 1u);
            const unsigned tg = og / nx;
            if (og + 1u == (tg + 1u) * nx) xb_add(&bar[XB_TOPGEN], 1u);
            else XB_SPIN(xb_ld(&bar[XB_TOPGEN]) == tg, bar);
            __builtin_amdgcn_fence(__ATOMIC_ACQUIRE, "agent");
            xb_add(&bar[XB_XGEN(b.x)], 1u);
            asm volatile("s_waitcnt vmcnt(0)" ::: "memory");
        } else {
            XB_SPIN(xb_ld(&bar[XB_XGEN(b.x)]) == gen, bar);
            __builtin_amdgcn_fence(__ATOMIC_ACQUIRE, "agent");
            asm volatile("s_waitcnt vmcnt(0)" ::: "memory");
        }
    }
    __syncthreads();
}

struct Args { const float* in[21]; float* out; unsigned char* ws; int ph_lo, ph_hi; };

struct TItem { const float* W; bf16* WT; const float* ksc; int N, ldt, k0, n0, nvalid; };
__device__ __forceinline__ void p0_titem_load(const TItem& d, float (&v)[64], int lane) {
    const int col = lane < d.nvalid ? lane : d.nvalid - 1;
#pragma unroll
    for (int i = 0; i < 64; ++i) v[i] = d.W[(size_t)(d.k0 + i) * d.N + d.n0 + col];
}
__device__ __forceinline__ void p0_titem_finish(const TItem& d, const float (&v)[64], LAS float* scr, int lane) {
#pragma unroll
    for (int i = 0; i < 64; ++i) scr[i * 65 + lane] = v[i];
    LDS_WAIT(); asm volatile("" ::: "memory");
    const int c = lane & 7;
    f32x4 ka = (f32x4){1.f, 1.f, 1.f, 1.f}, kb4 = ka;
    if (d.ksc && d.k0 >= WPOOL) { ka = *(const f32x4*)(d.ksc + d.k0 + 8 * c - WPOOL); kb4 = *(const f32x4*)(d.ksc + d.k0 + 8 * c - WPOOL + 4); }
#pragma unroll
    for (int j = 0; j < 8; ++j) { const int n = (lane >> 3) + 8 * j; const LAS float* s = scr + (8 * c) * 65 + n;
        v4u o; o.x = pk2(s[0 * 65] * ka.x, s[1 * 65] * ka.y); o.y = pk2(s[2 * 65] * ka.z, s[3 * 65] * ka.w); o.z = pk2(s[4 * 65] * kb4.x, s[5 * 65] * kb4.y); o.w = pk2(s[6 * 65] * kb4.z, s[7 * 65] * kb4.w);
        if (n < d.nvalid) *(GAS v4u*)(d.WT + (size_t)(d.n0 + n) * d.ldt + d.k0 + 8 * c) = o; }
    LDS_WAIT(); asm volatile("" ::: "memory");
}
__device__ __forceinline__ void p0_mod_item(const Args& a, LAS unsigned char* lds, int item, int tid, int lane, int wave) {
    const int l = item >> 7, cb = item & 127, e0 = cb * 96;
    const float* W = a.in[7] + (size_t)l * DM * 3 * DM;
    const float* cp = a.in[5]; const float* cs = a.in[6];
    LAS float* sl = (LAS float*)(lds + wave * 8192);
    f32x4 acc[20];
#pragma unroll
    for (int b = 0; b < 20; ++b) acc[b] = (f32x4){0.f, 0.f, 0.f, 0.f};
    const bool act = lane < 48; const int rs = lane >= 24 ? 1 : 0, c4 = lane - 24 * rs;
    const float* wl = W + (size_t)(wave * 512 + rs) * (3 * DM) + e0 + 4 * (act ? c4 : 0);
    f32x4 nxt[8];
#define MOD_LOAD(t_) do { _Pragma("unroll") for (int j_ = 0; j_ < 8; ++j_) nxt[j_] = act ? *(const f32x4*)(wl + (size_t)(16 * (t_) + 2 * j_) * (3 * DM)) : (f32x4){0.f, 0.f, 0.f, 0.f}; } while (0)
    MOD_LOAD(0);
    for (int ch = 0; ch < 8; ++ch) {
        const int d0 = wave * 512 + ch * 64;
#pragma unroll
        for (int b = 0; b < 20; ++b) { const float c = b < 4 ? cp[b * DM + d0 + lane] : cs[(b - 4) * DM + d0 + lane]; sl[lane * 20 + b] = c / (1.0f + expf(-c)); }
        LDS_WAIT(); asm volatile("" ::: "memory");
        for (int rb = 0; rb < 4; ++rb) {
            f32x4 wv[8];
#pragma unroll
            for (int j = 0; j < 8; ++j) wv[j] = nxt[j];
            const int tn = ch * 4 + rb + 1;
            if (tn < 32) MOD_LOAD(tn);
#pragma unroll
            for (int j = 0; j < 8; ++j) { const LAS f32x4* sp = (const LAS f32x4*)(sl + (16 * rb + 2 * j + rs) * 20);
#pragma unroll
                for (int q = 0; q < 5; ++q) { const f32x4 s4 = sp[q];
#pragma unroll
                    for (int c = 0; c < 4; ++c) acc[q * 4 + c] += wv[j] * s4[c]; } }
        }
        LDS_WAIT(); asm volatile("" ::: "memory");
    }
#undef MOD_LOAD
#pragma unroll
    for (int b = 0; b < 20; ++b)
#pragma unroll
        for (int c = 0; c < 4; ++c) acc[b][c] += __shfl_down(acc[b][c], 24);
    LAS float* red = (LAS float*)(lds + 65536 + wave * 7680);
    if (lane < 24) {
#pragma unroll
        for (int b = 0; b < 20; ++b) *(LAS f32x4*)(red + b * 96 + 4 * lane) = acc[b]; }
    __syncthreads();
    float* modf = (float*)(a.ws + WS_MODF);
    for (int idx = tid; idx < 20 * 96; idx += NWAVES * 64) { float s = 0.f;
#pragma unroll
        for (int w = 0; w < 8; ++w) s += ((LAS float*)(lds + 65536 + w * 7680))[idx];
        const int b = idx / 96, e = idx % 96; modf[(size_t)(l * 20 + b) * (3 * DM) + e0 + e] = s + a.in[8][(size_t)l * 3 * DM + e0 + e]; }
    __syncthreads();
}
__device__ __forceinline__ void p0_prologue(const Args& a, LAS unsigned char* lds, int G, int bid, int tid, int lane, int wave) {
    for (int it = bid; it < 256; it += G) p0_mod_item(a, lds, it, tid, lane, wave);
    VM_WAIT(); __syncthreads();
    if (wave == 0 && lane == 0) { __builtin_amdgcn_fence(__ATOMIC_RELEASE, "agent"); VM_WAIT(); __hip_atomic_fetch_add((unsigned*)(a.ws + WS_CTL) + CW_MOD, 1u, __ATOMIC_RELAXED, __HIP_MEMORY_SCOPE_AGENT); }
    LAS float* scr = (LAS float*)(lds + (wave < 7 ? wave * 16640 : 135168));
    const int gw = bid * NWAVES + wave, NGW = G * NWAVES;
    constexpr int NB_IN = (IN_DIM + 63) / 64, I_IN = 64 * NB_IN, I_OUT = 128 * 64, I_P = 8 * 8;
    constexpr int NITEMS = 2 * I_IN + 2 * I_OUT + 8 * I_P;
#define P0_DECODE(d, it_) do { int r = (it_); \
        if (r < 2 * I_IN) { const int l = r / I_IN; r -= l * I_IN; const int nb = 2 * (r / 128) + (r & 1), kb = 4 * ((r >> 3) & 15) + ((r >> 1) & 3); d = TItem{a.in[9] + (size_t)l * DM * IN_DIM, (bf16*)(a.ws + WS_WIN + l * WIN_L), nullptr, IN_DIM, DM, 64 * kb, 64 * nb, IN_DIM - 64 * nb < 64 ? IN_DIM - 64 * nb : 64}; } \
        else { r -= 2 * I_IN; if (r < 2 * I_OUT) { const int l = r / I_OUT; r -= l * I_OUT; const int nb = 2 * (r / 256) + (r & 1), kb = 4 * ((r >> 3) & 31) + ((r >> 1) & 3); d = TItem{a.in[18] + (size_t)l * DIN * DM, (bf16*)(a.ws + WS_WOUT + l * WOUT_L), a.in[17] + (size_t)l * WSSD, DM, DIN, 64 * kb, 64 * nb, 64}; } \
               else { r -= 2 * I_OUT; const int lg = r / I_P; r -= lg * I_P; d = TItem{a.in[10] + (size_t)lg * 512 * 512, (bf16*)(a.ws + WS_WP) + (size_t)lg * 512 * 512, nullptr, 512, 512, 64 * (r / 8), 64 * (r % 8), 64}; } } } while (0)
    { int it = gw; TItem d{}; float nx[64];
      if (it < NITEMS) { P0_DECODE(d, it); p0_titem_load(d, nx, lane); }
      while (it < NITEMS) {
          float cur[64];
#pragma unroll
          for (int i = 0; i < 64; ++i) cur[i] = nx[i];
          const TItem dc = d; const int itn = it + NGW;
          if (itn < NITEMS) { P0_DECODE(d, itn); p0_titem_load(d, nx, lane); }
          p0_titem_finish(dc, cur, scr, lane);
          it = itn; } }
#undef P0_DECODE
    for (int i = bid * NWAVES * 64 + tid; i < 2 * (NPAD - IN_DIM) * (DM / 8); i += G * NWAVES * 64) { const int l = i / ((NPAD - IN_DIM) * (DM / 8)), r = i % ((NPAD - IN_DIM) * (DM / 8));
        *(GAS v4u*)((bf16*)(a.ws + WS_WIN + l * WIN_L) + (size_t)IN_DIM * DM + (size_t)r * 8) = (v4u){0u, 0u, 0u, 0u}; }
}

__device__ __forceinline__ void row_stats(const f32x4 (&v)[16], float& mean, float& rstd) {
    float s = 0.f;
#pragma unroll
    for (int j = 0; j < 16; ++j) s += (v[j].x + v[j].y) + (v[j].z + v[j].w);
    mean = wave_sum(s) * (1.f / DM); float q = 0.f;
#pragma unroll
    for (int j = 0; j < 16; ++j) { const f32x4 d = v[j] - mean; q += (d.x * d.x + d.y * d.y) + (d.z * d.z + d.w * d.w); }
    rstd = 1.f / sqrtf(wave_sum(q) * (1.f / DM) + LN_EPS);
}
__device__ __forceinline__ int batch_of(int m) { return m < MP ? (m >> 11) : NBP + ((m - MP) >> 5); }
template <typename VP>
__device__ __forceinline__ void mod_row_to_bf16(const f32x4 (&v)[16], VP sh4, VP sc4, bf16* hrow, int lane) {
    float mean, rstd; row_stats(v, mean, rstd);
#pragma unroll
    for (int j = 0; j < 16; ++j) { const f32x4 sh = sh4[lane + 64 * j], sc = sc4[lane + 64 * j];
        const f32x4 o = (v[j] - mean) * rstd * (sc + 1.0f) + sh;
        ((GAS v2u*)hrow)[lane + 64 * j] = (v2u){pk2(o.x, o.y), pk2(o.z, o.w)};
        if ((j & 3) == 3) asm volatile("" ::: "memory"); }
}
__device__ __forceinline__ void lds_fill_vec(LAS unsigned char* lds, int slot, const float* src, int tid) {
#pragma unroll
    for (int i = 0; i < DM / 4 / (NWAVES * 64); ++i) ((LAS f32x4*)(lds + slot * 16384))[tid + i * NWAVES * 64] = ((const f32x4*)src)[tid + i * NWAVES * 64];
}
__device__ __forceinline__ void phase_a(const Args& a, LAS unsigned char* lds, int G, int bid, int lane, int wave) {
    const int gw = bid * NWAVES + wave, NGW = G * NWAVES;
    const float* modf = (const float*)(a.ws + WS_MODF); bf16* H = (bf16*)(a.ws + WS_H);
    if (G == 256) {
        { const float* md = modf + (size_t)(bid >> 6) * 3 * DM; const int tid = wave * 64 + lane;
          lds_fill_vec(lds, 0, md, tid); lds_fill_vec(lds, 1, md + DM, tid); }
        LDS_WAIT(); __syncthreads();
        const LAS f32x4* shl = (const LAS f32x4*)lds; const LAS f32x4* scl = (const LAS f32x4*)(lds + 16384);
        const int nrow = wave < 2 ? 5 : 4;
#define A_ROW(k) ((k) < 4 ? 32 * bid + wave + 8 * (k) : MP + 2 * bid + wave)
#define A_SRC(m) ((m) < MP ? a.in[0] + (size_t)(m) * DM : a.in[1] + (size_t)((m) - MP) * DM)
        f32x4 nx[16];
        { const float* xr = A_SRC(A_ROW(0));
#pragma unroll
          for (int j = 0; j < 16; ++j) nx[j] = ((const f32x4*)xr)[lane + 64 * j]; }
        for (int k = 0; k < 4; ++k) {
            const int m = A_ROW(k);
            f32x4 v[16];
#pragma unroll
            for (int j = 0; j < 16; ++j) v[j] = nx[j];
            if (k + 1 < nrow) { const int mn = A_ROW(k + 1); const float* xr = A_SRC(mn);
#pragma unroll
                for (int j = 0; j < 16; ++j) nx[j] = ((const f32x4*)xr)[lane + 64 * j]; }
            mod_row_to_bf16(v, shl, scl, H + (size_t)m * DM, lane);
        }
        if (wave < 2) { const int m = A_ROW(4); const float* md = modf + (size_t)batch_of(m) * 3 * DM;
            mod_row_to_bf16(nx, (const f32x4*)md, (const f32x4*)(md + DM), H + (size_t)m * DM, lane); }
#undef A_ROW
#undef A_SRC
        return;
    }
    f32x4 nx[16]; int m = gw;
    if (m < M) { const float* xr = m < MP ? a.in[0] + (size_t)m * DM : a.in[1] + (size_t)(m - MP) * DM;
#pragma unroll
        for (int j = 0; j < 16; ++j) nx[j] = ((const f32x4*)xr)[lane + 64 * j]; }
    while (m < M) {
        f32x4 v[16];
#pragma unroll
        for (int j = 0; j < 16; ++j) v[j] = nx[j];
        const int mn = m + NGW;
        if (mn < M) { const float* xr = mn < MP ? a.in[0] + (size_t)mn * DM : a.in[1] + (size_t)(mn - MP) * DM;
#pragma unroll
            for (int j = 0; j < 16; ++j) nx[j] = ((const f32x4*)xr)[lane + 64 * j]; }
        const float* md = modf + (size_t)batch_of(m) * 3 * DM;
        mod_row_to_bf16(v, (const f32x4*)md, (const f32x4*)(md + DM), H + (size_t)m * DM, lane);
        m = mn;
    }
}
template <typename LP, typename VP>
__device__ __forceinline__ void g_process(f32x4 (&v)[16], LP lg4, LP lb4, float* xrow, bool do_h, VP sh4, VP sc4, bf16* hrow, int lane) {
    float mean, rstd; row_stats(v, mean, rstd);
#pragma unroll
    for (int j = 0; j < 16; ++j) { v[j] = (v[j] - mean) * rstd * lg4[lane + 64 * j] + lb4[lane + 64 * j];
        ((GAS f32x4*)xrow)[lane + 64 * j] = v[j];
        if ((j & 3) == 3) asm volatile("" ::: "memory"); }
    if (do_h) mod_row_to_bf16(v, sh4, sc4, hrow, lane);
}
template <bool EVEN>
__device__ __forceinline__ void g_prompt_rows(const Args& a, LAS unsigned char* lds, int l, int G, int bid, int lane, int wave) {
    const int gw = bid * NWAVES + wave, NGW = G * NWAVES;
    const float* modf = (const float*)(a.ws + WS_MODF); bf16* H = (bf16*)(a.ws + WS_H);
    const bf16* R = (const bf16*)(a.ws + WS_R); float* xo = l == 0 ? (float*)(a.ws + WS_X1) : a.out + O_Y;
    const LAS f32x4* lgl = (const LAS f32x4*)lds; const LAS f32x4* lbl = (const LAS f32x4*)(lds + 16384); const LAS f32x4* shl = (const LAS f32x4*)(lds + 32768); const LAS f32x4* scl = (const LAS f32x4*)(lds + 49152);
    v2u nx[16];
    const int nrow = EVEN ? (wave < 2 ? 3 : (wave < 4 ? 5 : 4)) : (MP - gw + NGW - 1) / NGW;
#define G_ROW(k) (EVEN ? 32 * bid + ((k) == 4 ? 24 + (wave - 2) : wave + 8 * (k)) : gw + (k) * NGW)
    int k = 0;
    if (k < nrow) { const int m = G_ROW(0);
#pragma unroll
        for (int j = 0; j < 16; ++j) nx[j] = *(const v2u*)(R + (size_t)m * DM + 4 * (lane + 64 * j)); }
    for (; k < nrow; ++k) {
        const int m = G_ROW(k);
        f32x4 v[16];
#pragma unroll
        for (int j = 0; j < 16; ++j) v[j] = pg8::bf4_to_f32(nx[j].x, nx[j].y);
        if (k + 1 < nrow) { const int mn = G_ROW(k + 1);
#pragma unroll
            for (int j = 0; j < 16; ++j) nx[j] = *(const v2u*)(R + (size_t)mn * DM + 4 * (lane + 64 * j)); }
        if (EVEN) g_process(v, lgl, lbl, xo + (size_t)m * DM, l == 0, shl, scl, H + (size_t)m * DM, lane);
        else { const float* lg = a.in[19] + (size_t)l * DM; const float* lb = a.in[20] + (size_t)l * DM; const float* md = modf + (size_t)(NBT + batch_of(m)) * 3 * DM;
            g_process(v, (const f32x4*)lg, (const f32x4*)lb, xo + (size_t)m * DM, l == 0, (const f32x4*)md, (const f32x4*)(md + DM), H + (size_t)m * DM, lane); } }
#undef G_ROW
}
__device__ __forceinline__ void phase_g(const Args& a, LAS unsigned char* lds, int l, int G, int bid, int lane, int wave) {
    const int gw = bid * NWAVES + wave, NGW = G * NWAVES;
    const float* modf = (const float*)(a.ws + WS_MODF); bf16* H = (bf16*)(a.ws + WS_H);
    const bf16* R = (const bf16*)(a.ws + WS_R); float* xo = l == 0 ? (float*)(a.ws + WS_X1) : a.out + O_Y;
    const float* lg = a.in[19] + (size_t)l * DM; const float* lb = a.in[20] + (size_t)l * DM;
    const bool even = (G == 256);
    const LAS f32x4* lgl = (const LAS f32x4*)lds; const LAS f32x4* lbl = (const LAS f32x4*)(lds + 16384); const LAS f32x4* shl = (const LAS f32x4*)(lds + 32768); const LAS f32x4* scl = (const LAS f32x4*)(lds + 49152);
    if (even) {
        const int tid = wave * 64 + lane;
        lds_fill_vec(lds, 0, lg, tid); lds_fill_vec(lds, 1, lb, tid);
        if (l == 0) { const float* md = modf + (size_t)(NBT + (bid >> 6)) * 3 * DM; lds_fill_vec(lds, 2, md, tid); lds_fill_vec(lds, 3, md + DM, tid); }
        LDS_WAIT(); __syncthreads();
    }
    if (even ? wave < 2 : gw < MS) {
        const int m = even ? MP + 2 * bid + wave : MP + gw; f32x4 v[16];
        const float* xr = (l == 0 ? a.in[1] : (const float*)(a.ws + WS_X1) + (size_t)MP * DM) + (size_t)(m - MP) * DM;
        const float* gr = modf + (size_t)(l * NBT + batch_of(m)) * 3 * DM + 2 * DM; const float* sl = (const float*)(a.ws + WS_SLAB) + (size_t)(m - MP) * DM;
#pragma unroll
        for (int j2 = 0; j2 < 16; j2 += 2) { f32x4 t[2][8], xv[2], gv[2];
#pragma unroll
            for (int jj = 0; jj < 2; ++jj) { xv[jj] = ((const f32x4*)xr)[lane + 64 * (j2 + jj)]; gv[jj] = ((const f32x4*)gr)[lane + 64 * (j2 + jj)];
#pragma unroll
                for (int k2 = 0; k2 < 8; ++k2) t[jj][k2] = ((const f32x4*)(sl + (size_t)k2 * MS * DM))[lane + 64 * (j2 + jj)]; }
#pragma unroll
            for (int jj = 0; jj < 2; ++jj) { const f32x4 o = ((t[jj][0] + t[jj][1]) + (t[jj][2] + t[jj][3])) + ((t[jj][4] + t[jj][5]) + (t[jj][6] + t[jj][7]));
                v[j2 + jj] = xv[jj] * ALPHA + gv[jj] * o; }
            asm volatile("" ::: "memory"); }
        const float* md = modf + (size_t)(NBT + batch_of(m)) * 3 * DM;
        if (even) g_process(v, lgl, lbl, xo + (size_t)m * DM, l == 0, (const f32x4*)md, (const f32x4*)(md + DM), H + (size_t)m * DM, lane);
        else g_process(v, (const f32x4*)lg, (const f32x4*)lb, xo + (size_t)m * DM, l == 0, (const f32x4*)md, (const f32x4*)(md + DM), H + (size_t)m * DM, lane);
    }
    if (even) g_prompt_rows<true>(a, lds, l, G, bid, lane, wave); else g_prompt_rows<false>(a, lds, l, G, bid, lane, wave);
}
__device__ __forceinline__ f32x4 ld_bf4(const bf16* p) { const v2u q = *(const v2u*)p; return (f32x4){bf2f((unsigned short)(q.x & 0xffffu)), bf2f((unsigned short)(q.x >> 16)), bf2f((unsigned short)(q.y & 0xffffu)), bf2f((unsigned short)(q.y >> 16))}; }
__device__ __forceinline__ f32x4 pool_hist(const bf16* pc, const float* st, bool samp, int t) {
    if (t >= 0) return ld_bf4(pc + (size_t)t * WPOOL);
    if (samp) return *(const f32x4*)(st + (size_t)(15 + t) * WPOOL);
    return (f32x4){0.f, 0.f, 0.f, 0.f};
}
__device__ __forceinline__ void c1_elem(const Args& a, int l, int e, v2u& out, bf16*& dst) {
    const int c4 = e % 2560, r = (e / 2560) & 31, ss = e / (2560 * 32);
    const bool samp = ss >= 4; const int b = samp ? ss - 4 : ss, m0 = samp ? MP + b * DSEQ : b * SEQ;
    if (c4 < 512) { const int j0 = 4 * c4, w = 2 << (j0 >> 9);
        const bf16* pc = (const bf16*)(a.ws + WS_UP) + (size_t)m0 * WPOOL + j0; const float* st = a.in[2] + (size_t)(l * NBS + b) * 15 * WPOOL + j0;
        const f32x4 u = ld_bf4(pc + (size_t)r * WPOOL); f32x4 S = u;
        for (int i = 1; i < w; ++i) S += pool_hist(pc, st, samp, r - i);
        const int pos = (samp ? PAST : 0) + r; const float cnt = (float)(pos + 1 < w ? pos + 1 : w);
        const f32x4 p = S / cnt - u;
        out = (v2u){pk2(p.x, p.y), pk2(p.z, p.w)}; dst = (bf16*)(a.ws + WS_POOLED) + (size_t)(m0 + r) * WPOOL + j0;
    } else { const int j0 = 4 * (c4 - 512);
        const float* cw = a.in[12] + (size_t)l * 4 * CONVD + j0; const bf16* pc = (const bf16*)(a.ws + WS_XP) + (size_t)m0 * CONVD + j0; const float* st = a.in[3] + (size_t)(l * NBS + b) * 3 * CONVD + j0;
        f32x4 o = *(const f32x4*)(a.in[13] + (size_t)l * CONVD + j0);
#pragma unroll
        for (int k = 0; k < 4; ++k) { const int t = r - 3 + k;
            const f32x4 x = t >= 0 ? ld_bf4(pc + (size_t)t * CONVD) : (samp ? *(const f32x4*)(st + (size_t)(3 + t) * CONVD) : (f32x4){0.f, 0.f, 0.f, 0.f});
            o += *(const f32x4*)(cw + (size_t)k * CONVD) * x; }
        o.x = silu(o.x); o.y = silu(o.y); o.z = silu(o.z); o.w = silu(o.w);
        out = (v2u){pk2(o.x, o.y), pk2(o.z, o.w)}; dst = (bf16*)(a.ws + WS_XBC) + (size_t)(m0 + r) * CONVD + j0;
    }
}
__device__ __forceinline__ void c_zero_ssq(const Args& a, int G, int bid, int tid) {
    for (int i = bid * NWAVES * 64 + tid; i < M * 16; i += G * NWAVES * 64) ((GAS f32x4*)(a.ws + WS_YG))[i] = (f32x4){0.f, 0.f, 0.f, 0.f};
}
__device__ __forceinline__ void c1_range(const Args& a, int l, int e_lo, int e_hi, int first, int stride) {
    for (int e0 = e_lo + first; e0 < e_hi; e0 += 4 * stride) { v2u res[4]; bf16* dst[4];
#pragma unroll
        for (int u4 = 0; u4 < 4; ++u4) { const int e = e0 + u4 * stride; dst[u4] = nullptr; res[u4] = (v2u){0u, 0u};
            if (e < e_hi) c1_elem(a, l, e, res[u4], dst[u4]); }
#pragma unroll
        for (int u4 = 0; u4 < 4; ++u4) if (dst[u4]) *(GAS v2u*)dst[u4] = res[u4]; }
}
constexpr int C1_PROMPT_ELEMS = 4 * 32 * 2560, C1_ALL_ELEMS = 20 * 32 * 2560, C_ITEMS2 = 252 * 3, C_ITEMS1 = C1_PROMPT_ELEMS / 2048, C_QITEMS = C_ITEMS2 + C_ITEMS1;
__device__ __forceinline__ void c_sample_elems(const Args& a, int l, int G, int bid, int tid) { c1_range(a, l, C1_PROMPT_ELEMS, C1_ALL_ELEMS, bid * NWAVES * 64 + tid, G * NWAVES * 64); }
__device__ __forceinline__ void c_prompt_item(const Args& a, int l, int it, int tid) {
    if (it >= C_ITEMS2) { c1_range(a, l, (it - C_ITEMS2) * 2048, (it - C_ITEMS2 + 1) * 2048, tid, NWAVES * 64); return; }
    {
        const int sq = it / 3, cblk = it % 3, b = sq / 63, t0 = 32 * (1 + sq % 63), m0 = b * SEQ + t0;
        if (cblk == 0) {
            const int j0 = 4 * tid, w = 2 << (j0 >> 9);
            const bf16* p0 = (const bf16*)(a.ws + WS_UP) + (size_t)m0 * WPOOL + j0;
            bf16* po = (bf16*)(a.ws + WS_POOLED) + (size_t)m0 * WPOOL + j0;
            f32x4 S = (f32x4){0.f, 0.f, 0.f, 0.f};
            for (int i = 1; i < w; ++i) S += ld_bf4(p0 - (size_t)i * WPOOL);
            const float inv = 1.0f / (float)w;
            f32x4 nu[8], no[8];
#pragma unroll
            for (int k = 0; k < 8; ++k) { nu[k] = ld_bf4(p0 + (size_t)k * WPOOL); no[k] = ld_bf4(p0 + (ptrdiff_t)(k - w + 1) * WPOOL); }
#pragma unroll
            for (int r0 = 0; r0 < 32; r0 += 8) { f32x4 u[8], o[8];
#pragma unroll
                for (int k = 0; k < 8; ++k) { u[k] = nu[k]; o[k] = no[k]; }
                if (r0 + 8 < 32) {
#pragma unroll
                    for (int k = 0; k < 8; ++k) { nu[k] = ld_bf4(p0 + (size_t)(r0 + 8 + k) * WPOOL); no[k] = ld_bf4(p0 + (ptrdiff_t)(r0 + 8 + k - w + 1) * WPOOL); } }
#pragma unroll
                for (int k = 0; k < 8; ++k) { S += u[k]; const f32x4 p = S * inv - u[k];
                    *(GAS v2u*)(po + (size_t)(r0 + k) * WPOOL) = (v2u){pk2(p.x, p.y), pk2(p.z, p.w)}; S -= o[k]; } }
        } else {
            const int j0 = (cblk - 1) * 4096 + 8 * tid;
            const float* cw = a.in[12] + (size_t)l * 4 * CONVD + j0; const float* cb = a.in[13] + (size_t)l * CONVD + j0;
            f32x4 wt[4][2], bs[2];
#pragma unroll
            for (int hh = 0; hh < 2; ++hh) { bs[hh] = *(const f32x4*)(cb + 4 * hh);
#pragma unroll
                for (int k = 0; k < 4; ++k) wt[k][hh] = *(const f32x4*)(cw + (size_t)k * CONVD + 4 * hh); }
            const bf16* pc = (const bf16*)(a.ws + WS_XP) + (size_t)m0 * CONVD + j0;
            bf16* xo = (bf16*)(a.ws + WS_XBC) + (size_t)m0 * CONVD + j0;
            v4u h3 = *(const v4u*)(pc - 3 * (size_t)CONVD), h2 = *(const v4u*)(pc - 2 * (size_t)CONVD), h1 = *(const v4u*)(pc - (size_t)CONVD);
            f32x4 p3[2] = {pg8::bf4_to_f32(h3.x, h3.y), pg8::bf4_to_f32(h3.z, h3.w)}, p2[2] = {pg8::bf4_to_f32(h2.x, h2.y), pg8::bf4_to_f32(h2.z, h2.w)}, p1[2] = {pg8::bf4_to_f32(h1.x, h1.y), pg8::bf4_to_f32(h1.z, h1.w)};
            v4u nc[4];
#pragma unroll
            for (int k = 0; k < 4; ++k) nc[k] = *(const v4u*)(pc + (size_t)k * CONVD);
#pragma unroll
            for (int r0 = 0; r0 < 32; r0 += 4) { v4u cq[4];
#pragma unroll
                for (int k = 0; k < 4; ++k) cq[k] = nc[k];
                if (r0 + 4 < 32) {
#pragma unroll
                    for (int k = 0; k < 4; ++k) nc[k] = *(const v4u*)(pc + (size_t)(r0 + 4 + k) * CONVD); }
#pragma unroll
                for (int k = 0; k < 4; ++k) { const f32x4 cur[2] = {pg8::bf4_to_f32(cq[k].x, cq[k].y), pg8::bf4_to_f32(cq[k].z, cq[k].w)}; unsigned ow[4];
#pragma unroll
                    for (int hh = 0; hh < 2; ++hh) { f32x4 o = wt[0][hh] * p3[hh] + wt[1][hh] * p2[hh] + wt[2][hh] * p1[hh] + wt[3][hh] * cur[hh] + bs[hh];
                        o.x = silu(o.x); o.y = silu(o.y); o.z = silu(o.z); o.w = silu(o.w);
                        ow[2 * hh] = pk2(o.x, o.y); ow[2 * hh + 1] = pk2(o.z, o.w);
                        p3[hh] = p2[hh]; p2[hh] = p1[hh]; p1[hh] = cur[hh]; }
                    *(GAS v4u*)(xo + (size_t)(r0 + k) * CONVD) = (v4u){ow[0], ow[1], ow[2], ow[3]}; } }
        }
    }
}
typedef short s16x4 __attribute__((ext_vector_type(4)));
typedef short s16x8 __attribute__((ext_vector_type(8)));
constexpr int SSD_XX = 0, SSD_BS = 32768, SSD_CS = 49152, SSD_HB = 65536, SSD_TAB = 135168;
__device__ __forceinline__ unsigned off_b(unsigned row, unsigned ch) { return 256u * row + 16u * (ch ^ (((row & 3u) << 2) | ((row >> 2) & 3u))); }
__device__ __forceinline__ s16x8 tr_frag(LAS unsigned char* img, int lane, int c, int ks) {
    const unsigned g = (unsigned)lane >> 4, qq = ((unsigned)lane & 15u) >> 2, pp = (unsigned)lane & 3u;
    const unsigned a0 = off_b(32u * ks + 8u * g + qq, 2u * c + (pp >> 1)) + 8u * (pp & 1u), a1 = off_b(32u * ks + 8u * g + 4u + qq, 2u * c + (pp >> 1)) + 8u * (pp & 1u);
    const s16x4 lo = __builtin_amdgcn_ds_read_tr16_b64_v4i16((LAS s16x4*)(img + a0)), hi = __builtin_amdgcn_ds_read_tr16_b64_v4i16((LAS s16x4*)(img + a1));
    return __builtin_shufflevector(lo, hi, 0, 1, 2, 3, 4, 5, 6, 7);
}
__device__ __forceinline__ s16x8 row_frag(LAS unsigned char* img, int row, int ch) { return *(const LAS s16x8*)(img + off_b((unsigned)row, (unsigned)ch)); }
__device__ __forceinline__ float ex2(float x) { return __builtin_amdgcn_exp2f(x); }
template <int CTRL, int RM, int BMK> __device__ __forceinline__ float dpp0(float v) { return __builtin_bit_cast(float, __builtin_amdgcn_update_dpp(0, __builtin_bit_cast(int, v), CTRL, RM, BMK, true)); }
__device__ __forceinline__ float wave_scan(float x) {
    float v = x + dpp0<0x111, 0xf, 0xf>(x); v += dpp0<0x112, 0xf, 0xf>(x); v += dpp0<0x113, 0xf, 0xf>(x);
    v += dpp0<0x114, 0xf, 0xe>(v); v += dpp0<0x118, 0xf, 0xc>(v); v += dpp0<0x142, 0xa, 0xf>(v); v += dpp0<0x143, 0xc, 0xf>(v);
    return v;
}
__device__ __forceinline__ unsigned scale_pk(unsigned v, float w) { return pk2(bf2f((unsigned short)(v & 0xffffu)) * w, bf2f((unsigned short)(v >> 16)) * w); }

__device__ __forceinline__ void ssd_unit(const Args& a, LAS unsigned char* lds, int l, int unit, int tid) {
    const int lane = tid & 63, wave = __builtin_amdgcn_readfirstlane(tid >> 6), r16 = lane & 15, q = lane >> 4;
    const int lt = wave & 3, ph = wave >> 2;
    const bool samp = unit >= NBP * 48; const int u2 = samp ? unit - NBP * 48 : unit; const int b = u2 / 48, hp = u2 % 48, h0 = 2 * hp, g = hp / 6;
    const int nchunk = samp ? 1 : SEQ / 64, vr = samp ? DSEQ : 64, mbase = samp ? MP + b * DSEQ : b * SEQ;
    float A2[2], Dk[2];
#pragma unroll
    for (int hd = 0; hd < 2; ++hd) { A2[hd] = -expf(a.in[15][l * NH + h0 + hd]) * 1.44269504089f; Dk[hd] = a.in[16][l * NH + h0 + hd]; }
    const bf16* xbc = (const bf16*)(a.ws + WS_XBC); const bf16* sz = (const bf16*)(a.ws + WS_SZ); bf16* yg = (bf16*)(a.ws + WS_MIXED) + WPOOL; float* ssq = (float*)(a.ws + WS_YG) + g * 8 + hp % 6;
    const float* dtt = (const float*)(a.ws + WS_DTV) + (size_t)(h0 + (wave & 1)) * M + mbase;
    const int xrow = tid >> 3, xch = tid & 7, brow = tid >> 4, bch = tid & 15;
    const int lrow = 16 * lt + r16;
    v4u xr[2], br[2], cr[2]; v2u zr[2][2]; float dtl = 0.f;
    const v4u zero4 = (v4u){0u, 0u, 0u, 0u};
#define SSD_LOAD(c) do { const size_t m0_ = (size_t)mbase + 64 * (size_t)(c); \
        { const bf16* xp_ = xbc + (m0_ + (xrow < vr ? xrow : 0)) * CONVD + h0 * HD + 8 * xch; xr[0] = *(const v4u*)xp_; xr[1] = *(const v4u*)(xp_ + HD); } \
        _Pragma("unroll") for (int i_ = 0; i_ < 2; ++i_) { const int row_ = brow + 32 * i_; const bf16* rp_ = xbc + (m0_ + (row_ < vr ? row_ : 0)) * CONVD + WSSD + g * NS + 8 * bch; \
            br[i_] = *(const v4u*)rp_; cr[i_] = *(const v4u*)(rp_ + 1024); } \
        _Pragma("unroll") for (int hd_ = 0; hd_ < 2; ++hd_) _Pragma("unroll") for (int j_ = 0; j_ < 2; ++j_) \
            zr[hd_][j_] = *(const v2u*)(sz + (m0_ + (lrow < vr ? lrow : 0)) * WSSD + (h0 + hd_) * HD + 16 * (2 * ph + j_) + 4 * q); \
        if (wave < 2) dtl = dtt[64 * (c) + (lane < vr ? lane : 0)]; } while (0)
#define SSD_SCAN(i_) do { if (wave < 2) { LAS float* tb_ = (LAS float*)(lds + SSD_TAB + (2 * (i_) + wave) * 1024); const float d_ = lane < vr ? dtl : 0.f; \
            const float cs_ = wave_scan(d_ * (wave == 0 ? A2[0] : A2[1])); const float tot_ = __builtin_bit_cast(float, __builtin_amdgcn_readlane(__builtin_bit_cast(int, cs_), 63)); \
            const float c31_ = __builtin_bit_cast(float, __builtin_amdgcn_readlane(__builtin_bit_cast(int, cs_), 31)); \
            tb_[lane] = cs_; tb_[64 + lane] = d_; tb_[128 + lane] = d_ * ex2(tot_ - cs_); tb_[192 + lane] = lane < 32 ? d_ * ex2(c31_ - cs_) : 0.f; } } while (0)
#define SSD_STAGE_WRITE(i_) do { \
        _Pragma("unroll") for (int hd_ = 0; hd_ < 2; ++hd_) { const float w_ = ((const LAS float*)(lds + SSD_TAB + (2 * (i_) + hd_) * 1024))[128 + xrow]; const v4u x_ = xrow < vr ? xr[hd_] : zero4; \
            *(LAS v4u*)(lds + SSD_XX + hd_ * 16384 + off_b(xrow, xch)) = x_; \
            *(LAS v4u*)(lds + SSD_XX + hd_ * 16384 + off_b(xrow, 8 + xch)) = (v4u){scale_pk(x_.x, w_), scale_pk(x_.y, w_), scale_pk(x_.z, w_), scale_pk(x_.w, w_)}; } \
        _Pragma("unroll") for (int i2_ = 0; i2_ < 2; ++i2_) { const bool ok_ = brow + 32 * i2_ < vr; \
            *(LAS v4u*)(lds + SSD_BS + off_b(brow + 32 * i2_, bch)) = ok_ ? br[i2_] : zero4; *(LAS v4u*)(lds + SSD_CS + off_b(brow + 32 * i2_, bch)) = ok_ ? cr[i2_] : zero4; } } while (0)
#define SSD_BAR() do { asm volatile("s_waitcnt lgkmcnt(0)" ::: "memory"); __builtin_amdgcn_s_barrier(); asm volatile("" ::: "memory"); } while (0)
    f32x4 Hacc[2][2][2];
#pragma unroll
    for (int hd = 0; hd < 2; ++hd)
#pragma unroll
        for (int i = 0; i < 2; ++i)
#pragma unroll
            for (int j = 0; j < 2; ++j) Hacc[hd][i][j] = samp ? *(const f32x4*)(a.in[4] + ((size_t)((l * NBS + b) * NH + h0 + hd) * HD + 16 * (2 * ph + j) + r16) * NS + 16 * (2 * lt + i) + 4 * q) : (f32x4){0.f, 0.f, 0.f, 0.f};
#define SSD_HWRITE(i_) do { _Pragma("unroll") for (int hd_ = 0; hd_ < 2; ++hd_) { LAS unsigned char* hb_ = lds + SSD_HB + (2 * (i_) + hd_) * 16384; \
        _Pragma("unroll") for (int i2_ = 0; i2_ < 2; ++i2_) _Pragma("unroll") for (int j2_ = 0; j2_ < 2; ++j2_) { const f32x4 v_ = Hacc[hd_][i2_][j2_]; \
            *(LAS v2u*)(hb_ + off_b(16 * (2 * ph + j2_) + r16, 2 * (2 * lt + i2_) + (q >> 1)) + 8 * (q & 1)) = (v2u){pk2(v_.x, v_.y), pk2(v_.z, v_.w)}; } } } while (0)
    SSD_LOAD(0);
    v2u zc[2][2] = {{zr[0][0], zr[0][1]}, {zr[1][0], zr[1][1]}};
    SSD_SCAN(0); SSD_HWRITE(0);
    SSD_BAR();
    SSD_STAGE_WRITE(0);
    SSD_BAR();
    v2u ypk[2][2] = {{(v2u){0u, 0u}, (v2u){0u, 0u}}, {(v2u){0u, 0u}, (v2u){0u, 0u}}}; float ssk[2] = {0.f, 0.f};
    for (int c = 0; c < nchunk; ++c) {
        const bool more = c + 1 < nchunk;
        if (c > 0 && lrow < vr) {
#pragma unroll
            for (int hd = 0; hd < 2; ++hd)
#pragma unroll
                for (int j = 0; j < 2; ++j) *(GAS v2u*)(yg + ((size_t)mbase + 64 * (c - 1) + lrow) * DIN + (h0 + hd) * HD + 16 * (2 * ph + j) + 4 * q) = ypk[hd][j];
            if (q == 0) __hip_atomic_fetch_add(ssq + ((size_t)mbase + 64 * (c - 1) + lrow) * 64, ssk[0] + ssk[1], __ATOMIC_RELAXED, __HIP_MEMORY_SCOPE_AGENT); }
        if (more) SSD_LOAD(c + 1);
        LAS unsigned char* hbc = lds + SSD_HB + 2 * (c & 1) * 16384; const LAS float* tb = (const LAS float*)(lds + SSD_TAB + 2 * (c & 1) * 1024);
#define SB() __builtin_amdgcn_sched_barrier(0)
        s16x8 cf[4]; float acl[2], cdv[2];
#pragma unroll
        for (int kk = 0; kk < 4; ++kk) cf[kk] = row_frag(lds + SSD_CS, lrow, 4 * kk + q);
        f32x4 acc[2][2] = {{(f32x4){0.f, 0.f, 0.f, 0.f}, (f32x4){0.f, 0.f, 0.f, 0.f}}, {(f32x4){0.f, 0.f, 0.f, 0.f}, (f32x4){0.f, 0.f, 0.f, 0.f}}};
#pragma unroll
        for (int hd = 0; hd < 2; ++hd) { s16x8 hf[2][4];
            SB();
            acl[hd] = tb[hd * 256 + lrow]; cdv[hd] = tb[hd * 256 + 63];
#pragma unroll
            for (int j = 0; j < 2; ++j)
#pragma unroll
                for (int kk = 0; kk < 4; ++kk) hf[j][kk] = row_frag(hbc + hd * 16384, 16 * (2 * ph + j) + r16, 4 * kk + q);
            SB();
#pragma unroll
            for (int kk = 0; kk < 4; ++kk)
#pragma unroll
                for (int j = 0; j < 2; ++j) acc[hd][j] = __builtin_amdgcn_mfma_f32_16x16x32_bf16(hf[j][kk], cf[kk], acc[hd][j], 0, 0, 0);
            const float el = ex2(acl[hd]); acc[hd][0] = acc[hd][0] * el; acc[hd][1] = acc[hd][1] * el; }
#pragma unroll
        for (int k2 = 0; k2 < 2; ++k2) if (k2 <= (lt >> 1)) {
            const int sx = 32 * k2 + 8 * (r16 >> 2) + (r16 & 3), s0 = 32 * k2 + 8 * q;
            s16x8 bx[4], by[4], xf[2][2];
            SB();
#pragma unroll
            for (int kk = 0; kk < 4; ++kk) { bx[kk] = row_frag(lds + SSD_BS, sx, 4 * kk + q); by[kk] = row_frag(lds + SSD_BS, sx + 4, 4 * kk + q); }
            SB();
            f32x4 gx = (f32x4){0.f, 0.f, 0.f, 0.f}, gy = gx;
#pragma unroll
            for (int kk = 0; kk < 4; ++kk) { gx = __builtin_amdgcn_mfma_f32_16x16x32_bf16(bx[kk], cf[kk], gx, 0, 0, 0); gy = __builtin_amdgcn_mfma_f32_16x16x32_bf16(by[kk], cf[kk], gy, 0, 0, 0); }
#pragma unroll
            for (int hd = 0; hd < 2; ++hd)
#pragma unroll
                for (int j = 0; j < 2; ++j) xf[hd][j] = tr_frag(lds + SSD_XX + hd * 16384, lane, 2 * ph + j, k2);
#pragma unroll
            for (int hd = 0; hd < 2; ++hd) { f32x4 mx, my;
                if (k2 != (lt >> 1)) {
                    const float rowf = ex2(acl[hd] - tb[hd * 256 + 31]);
                    const f32x4 c0 = *(const LAS f32x4*)(tb + hd * 256 + 192 + s0), c1 = *(const LAS f32x4*)(tb + hd * 256 + 192 + s0 + 4);
                    mx = gx * (c0 * rowf); my = gy * (c1 * rowf);
                } else {
                const f32x4 as0 = *(const LAS f32x4*)(tb + hd * 256 + s0), as1 = *(const LAS f32x4*)(tb + hd * 256 + s0 + 4), d0 = *(const LAS f32x4*)(tb + hd * 256 + 64 + s0), d1 = *(const LAS f32x4*)(tb + hd * 256 + 64 + s0 + 4);
#pragma unroll
                for (int e = 0; e < 4; ++e) { mx[e] = (s0 + e <= lrow) ? gx[e] * ex2(acl[hd] - as0[e]) * d0[e] : 0.f; my[e] = (s0 + 4 + e <= lrow) ? gy[e] * ex2(acl[hd] - as1[e]) * d1[e] : 0.f; }
                }
                const s16x8 gms = __builtin_bit_cast(s16x8, (v4u){pk2(mx[0], mx[1]), pk2(mx[2], mx[3]), pk2(my[0], my[1]), pk2(my[2], my[3])});
#pragma unroll
                for (int j = 0; j < 2; ++j) acc[hd][j] = __builtin_amdgcn_mfma_f32_16x16x32_bf16(xf[hd][j], gms, acc[hd][j], 0, 0, 0); }
        }
        v2u xwv[2][2]; s16x8 bt[2], xs[2][2];
        SB();
#pragma unroll
        for (int hd = 0; hd < 2; ++hd)
#pragma unroll
            for (int j = 0; j < 2; ++j) { const int p0 = 16 * (2 * ph + j) + 4 * q; xwv[hd][j] = *(const LAS v2u*)(lds + SSD_XX + hd * 16384 + off_b(lrow, p0 >> 3) + 2 * (p0 & 7)); xs[hd][j] = tr_frag(lds + SSD_XX + hd * 16384, lane, 4 + 2 * ph + j, 0); }
#pragma unroll
        for (int i = 0; i < 2; ++i) bt[i] = tr_frag(lds + SSD_BS, lane, 2 * lt + i, 0);
        SB();
#pragma unroll
        for (int hd = 0; hd < 2; ++hd) { float ss = 0.f;
#pragma unroll
            for (int j = 0; j < 2; ++j) { const v2u xw = xwv[hd][j];
                f32x4 y = acc[hd][j] + Dk[hd] * (f32x4){bf2f((unsigned short)(xw.x & 0xffffu)), bf2f((unsigned short)(xw.x >> 16)), bf2f((unsigned short)(xw.y & 0xffffu)), bf2f((unsigned short)(xw.y >> 16))};
                y = y * (f32x4){bf2f((unsigned short)(zc[hd][j].x & 0xffffu)), bf2f((unsigned short)(zc[hd][j].x >> 16)), bf2f((unsigned short)(zc[hd][j].y & 0xffffu)), bf2f((unsigned short)(zc[hd][j].y >> 16))};
                ss += (y.x * y.x + y.y * y.y) + (y.z * y.z + y.w * y.w);
                ypk[hd][j] = (v2u){pk2(y.x, y.y), pk2(y.z, y.w)}; }
            ss += __shfl_xor(ss, 16); ss += __shfl_xor(ss, 32); ssk[hd] = ss; }
#pragma unroll
        for (int hd = 0; hd < 2; ++hd) { const float cd = ex2(cdv[hd]);
#pragma unroll
            for (int i = 0; i < 2; ++i)
#pragma unroll
                for (int j = 0; j < 2; ++j) Hacc[hd][i][j] = Hacc[hd][i][j] * cd; }
#pragma unroll
        for (int hd = 0; hd < 2; ++hd)
#pragma unroll
            for (int i = 0; i < 2; ++i)
#pragma unroll
                for (int j = 0; j < 2; ++j) Hacc[hd][i][j] = __builtin_amdgcn_mfma_f32_16x16x32_bf16(bt[i], xs[hd][j], Hacc[hd][i][j], 0, 0, 0);
        SB();
#pragma unroll
        for (int i = 0; i < 2; ++i) bt[i] = tr_frag(lds + SSD_BS, lane, 2 * lt + i, 1);
#pragma unroll
        for (int hd = 0; hd < 2; ++hd)
#pragma unroll
            for (int j = 0; j < 2; ++j) xs[hd][j] = tr_frag(lds + SSD_XX + hd * 16384, lane, 4 + 2 * ph + j, 1);
        SB();
#pragma unroll
        for (int hd = 0; hd < 2; ++hd)
#pragma unroll
            for (int i = 0; i < 2; ++i)
#pragma unroll
                for (int j = 0; j < 2; ++j) Hacc[hd][i][j] = __builtin_amdgcn_mfma_f32_16x16x32_bf16(bt[i], xs[hd][j], Hacc[hd][i][j], 0, 0, 0);
#undef SB
        if (more) { SSD_HWRITE((c + 1) & 1); SSD_SCAN((c + 1) & 1); }
        SSD_BAR();
        if (more) { SSD_STAGE_WRITE((c + 1) & 1);
#pragma unroll
            for (int hd = 0; hd < 2; ++hd) { zc[hd][0] = zr[hd][0]; zc[hd][1] = zr[hd][1]; }
            SSD_BAR(); }
    }
    if (lrow < vr) {
#pragma unroll
        for (int hd = 0; hd < 2; ++hd)
#pragma unroll
            for (int j = 0; j < 2; ++j) *(GAS v2u*)(yg + ((size_t)mbase + 64 * (nchunk - 1) + lrow) * DIN + (h0 + hd) * HD + 16 * (2 * ph + j) + 4 * q) = ypk[hd][j];
        if (q == 0) __hip_atomic_fetch_add(ssq + ((size_t)mbase + 64 * (nchunk - 1) + lrow) * 64, ssk[0] + ssk[1], __ATOMIC_RELAXED, __HIP_MEMORY_SCOPE_AGENT); }
#pragma unroll
    for (int hd = 0; hd < 2; ++hd) { float* so = a.out + (samp ? O_SS : O_SP) + (size_t)((l * (samp ? NBS : NBP) + b) * NH + h0 + hd) * HD * NS;
#pragma unroll
        for (int i = 0; i < 2; ++i)
#pragma unroll
            for (int j = 0; j < 2; ++j) *(GAS f32x4*)(so + (size_t)(16 * (2 * ph + j) + r16) * NS + 16 * (2 * lt + i) + 4 * q) = Hacc[hd][i][j]; }
#undef SSD_LOAD
#undef SSD_SCAN
#undef SSD_STAGE_WRITE
#undef SSD_HWRITE
#undef SSD_BAR
}
__device__ __forceinline__ void ktab_build(const float* ssq, LAS float* tab, int row0, int sbase, int gfirst, int tid) {
    const int r = tid >> 1, g0 = 4 * (tid & 1);
    const float* p = ssq + (size_t)(row0 + r) * 64;
    float sprev = 1.f;
#pragma unroll
    for (int gg = -1; gg < 4; ++gg) { const int g = g0 + gg; if (g < 0) continue;
        const f32x4* q4 = (const f32x4*)(p + 8 * g); const f32x4 t = q4[0] + q4[1];
        const float sg = 1.f / sqrtf(((t.x + t.y) + (t.z + t.w)) * (1.f / 768.f) + RMS_EPS);
        if (gg >= 0) { tab[g * 256 + r] = sprev / sg; if (g >= gfirst) tab[(sbase + g - gfirst) * 256 + r] = sg; }
        sprev = sg; }
}

constexpr int CW_SAMP = 8192;
__device__ __forceinline__ void sample_norm(const Args& a, int l, int G, int bid, int lane, int wave) {
    const float* ssq = (const float*)(a.ws + WS_YG); bf16* mx = (bf16*)(a.ws + WS_MIXED);
    for (int rr = bid; rr < MS / 2; rr += G) {
        const int m = MP + 2 * rr + (wave >> 2);
#pragma unroll
        for (int gg = 0; gg < 2; ++gg) { const int g = 2 * (wave & 3) + gg;
            const float part = lane < 8 ? ssq[(size_t)m * 64 + 8 * g + lane] : 0.f;
            const float rstd = 1.f / sqrtf(wave_sum(part) * (1.f / 768.f) + RMS_EPS);
            unsigned long long* p = (unsigned long long*)(mx + (size_t)m * DIN + WPOOL + g * 768) + lane;
#pragma unroll
            for (int j = 0; j < 3; ++j) { const unsigned long long q = p[64 * j]; const f32x4 v = pg8::bf4_to_f32((unsigned)q, (unsigned)(q >> 32)) * rstd;
                __hip_atomic_store(p + 64 * j, (unsigned long long)pk2(v.x, v.y) | ((unsigned long long)pk2(v.z, v.w) << 32), __ATOMIC_RELAXED, __HIP_MEMORY_SCOPE_AGENT); } }
    }
    VM_WAIT(); __syncthreads();
    if (wave == 0 && lane == 0) __hip_atomic_fetch_add((unsigned*)(a.ws + WS_CTL) + CW_SAMP, 1u, __ATOMIC_RELAXED, __HIP_MEMORY_SCOPE_AGENT);
}
__device__ __forceinline__ void sample_wait(const Args& a, unsigned target, int lane, int wave) {
    if (wave == 0) { unsigned* cnt = (unsigned*)(a.ws + WS_CTL) + CW_SAMP; unsigned sp = 0;
        while ((unsigned)__builtin_amdgcn_readfirstlane(__hip_atomic_load(cnt, __ATOMIC_RELAXED, __HIP_MEMORY_SCOPE_AGENT)) < target) { __builtin_amdgcn_s_sleep(2); if (++sp > (1u << 22)) break; }
        __builtin_amdgcn_fence(__ATOMIC_ACQUIRE, "agent"); VM_WAIT(); }
    __syncthreads();
}

constexpr int CW_PDONE = 8448, CW_ADONE = 8576, CW_CQ = 8704;
constexpr int PROJ_UNITS1 = (MP / 256) * 72, PROJ_UNITS2 = (MP / 256) + 2 * 73;
constexpr int CW_PQ = 8832, POOL_TILES = (M / 256) * 2 * 4;
struct OneTile {
    int t;
    __device__ bool next(int i, pg8::Unit& u) const { if (i != 0) return false; const int per = (M / 256) * 2, r = t % per; u.g = t / per; u.pm = r % (M / 256); u.pn = r / (M / 256); return true; }
    __device__ __forceinline__ void a_ready(const pg8::Unit&) const {}
    __device__ __forceinline__ void done(const pg8::Unit&) const {}
};
struct ProjOrder {
    pg8::StaticOrder so; int G, c, ilast; volatile LAS unsigned* lcnt; unsigned* pdone; unsigned ltarget;
    __device__ void init(int G_, int c_, volatile LAS unsigned* lcnt_, unsigned* pdone_, unsigned ltarget_) { so.init(MP, 72 * 256, G_, c_); G = G_; c = c_; ilast = (PROJ_UNITS1 - 1 - c_) / G_; lcnt = lcnt_; pdone = pdone_; ltarget = ltarget_; }
    __device__ bool next(int i, pg8::Unit& u) const {
        const long L = (long)i * G + c;
        if (L < PROJ_UNITS1) return so.next(i, u);
        const int t = (int)(L - PROJ_UNITS1); if (t >= PROJ_UNITS2) return false;
        if (t < MP / 256) { u.pm = t; u.pn = 72; } else { const int r = t - MP / 256; u.pm = MP / 256 + (r & 1); u.pn = r >> 1; }
        u.g = 0; return true;
    }
    __device__ __forceinline__ void a_ready(const pg8::Unit&) const {}
    __device__ __forceinline__ void done(const pg8::Unit& u) const {
        if (u.ui == ilast) {
            asm volatile("s_waitcnt vmcnt(0)" ::: "memory");
            if (fresh_lane() == 0) {
                const unsigned old = __hip_atomic_fetch_add((LAS unsigned*)lcnt, 1u, __ATOMIC_RELAXED, __HIP_MEMORY_SCOPE_WORKGROUP);
                if (old + 1u == ltarget) {
                    __builtin_amdgcn_fence(__ATOMIC_RELEASE, "agent"); asm volatile("s_waitcnt vmcnt(0)" ::: "memory");
                    __hip_atomic_fetch_add(pdone, 1u, __ATOMIC_RELAXED, __HIP_MEMORY_SCOPE_AGENT); } } }
    }
};
__device__ __forceinline__ void wait_count(unsigned* cnt, unsigned target, int wave) {
    if (wave == 0) { unsigned sp = 0;
        while ((unsigned)__builtin_amdgcn_readfirstlane(__hip_atomic_load(cnt, __ATOMIC_RELAXED, __HIP_MEMORY_SCOPE_AGENT)) < target) { __builtin_amdgcn_s_sleep(2); if (++sp > (1u << 22)) break; }
        __builtin_amdgcn_fence(__ATOMIC_ACQUIRE, "agent"); VM_WAIT(); }
    __syncthreads();
}

__global__ void __launch_bounds__(NWAVES * 64, 2) trunk_fwd(Args args) {
    extern __shared__ __attribute__((aligned(16))) unsigned char lds_raw[];
    LAS unsigned char* lds = (LAS unsigned char*)lds_raw;
    volatile LAS unsigned* MISC = (volatile LAS unsigned*)(lds + MISC_OFF);
    const int wave = __builtin_amdgcn_readfirstlane((int)threadIdx.x >> 6);
    const int tid = wave * 64 + fresh_lane();
    const int G = gridDim.x, bid = blockIdx.x;
    unsigned* ctl = (unsigned*)(args.ws + WS_CTL);
    for (int u = tid; u < (LDS_BYTES - LDSCTL_OFF) / 4; u += NWAVES * 64) ((LAS unsigned*)(lds + LDSCTL_OFF))[u] = 0u;
    __syncthreads();
    const int lo = args.ph_lo, hi = args.ph_hi;
    XcdBarrier bar; bar.bar = ctl + CW_BAR; bar.x = 0; bar.st = MISC + 8; bar.w0 = (wave == 0);
    if (hi - lo > 1) bar = xcd_barrier_post(ctl + CW_BAR, MISC + 8, wave == 0);
#ifndef PROBE_MASK
#define PROBE_MASK 0
#endif
#define REP(kind) for (int _r = 0; _r < (((PROBE_MASK) >> (kind)) & 1 ? 2 : 1); ++_r)
#define IN(k) (lo <= (k) && (k) < hi)
#define BOTH(k) (IN(k) && IN((k) + 1))
#define SEAM(k) do { if (BOTH(k)) xcd_barrier(bar); } while (0)
#ifndef PROBE_SEL
#define PROBE_SEL 0
#endif
#ifndef PROBE_MULT
#define PROBE_MULT 4
#endif
#if PROBE_SEL > 0
    volatile LAS unsigned long long* tsw = (volatile LAS unsigned long long*)(lds + MISC_OFF + 64);
    if (bid == 0 && wave == 0 && fresh_lane() == 0) { tsw[0] = __builtin_amdgcn_s_memrealtime(); tsw[1] = 0ull; }
#define STAMP(kind) do { if (bid == 0 && wave == 0 && fresh_lane() == 0) { const unsigned long long t_ = __builtin_amdgcn_s_memrealtime(); if ((PROBE_SEL >> (kind)) & 1) tsw[1] = tsw[1] + (t_ - tsw[0]); tsw[0] = t_; } } while (0)
#else
#define STAMP(kind) do { } while (0)
#endif

    if (IN(0)) { const int l0 = fresh_lane(); p0_prologue(args, lds, G, bid, wave * 64 + l0, l0, wave); STAMP(0);
                 wait_count(ctl + CW_MOD, (unsigned)G, wave);
                 phase_a(args, lds, G, bid, fresh_lane(), wave); SEAM(0); STAMP(1); }
    for (int l = 0; l < 2; ++l) {
        const int pb = 1 + 4 * l;
#define TL (wave * 64 + fresh_lane())
        if (IN(pb)) {
            pg8::Gemm g{(const pg8::bf16_t*)(args.ws + WS_H), (const pg8::bf16_t*)(args.ws + WS_WIN + (size_t)l * WIN_L), M, NPAD, DM, DM, DM, 0, 0};
            ProjOrder S; S.init(G, bid, MISC + 25, ctl + CW_PDONE + 64 * l, 8u * (unsigned)(l + 1));
            EpiProj E{args.ws, args.out, args.in[14] + (size_t)l * NH, l};
            pg8::gemm_phase<EpiProj, ProjOrder, true, true>(lds, g, S, E, TL);
            if (wave == 0 && fresh_lane() == 0) { __builtin_amdgcn_fence(__ATOMIC_RELEASE, "agent"); asm volatile("s_waitcnt vmcnt(0)" ::: "memory");
                __hip_atomic_fetch_add(ctl + CW_ADONE + 64 * l, 1u, __ATOMIC_RELAXED, __HIP_MEMORY_SCOPE_AGENT); }
            c_zero_ssq(args, G, bid, TL);
            wait_count(ctl + CW_PDONE + 64 * l, (unsigned)G, wave);
            for (;;) {
                if (wave == 0 && fresh_lane() == 0) MISC[24] = __hip_atomic_fetch_add(ctl + CW_CQ + 64 * l, 1u, __ATOMIC_RELAXED, __HIP_MEMORY_SCOPE_AGENT);
                __syncthreads();
                const int it = __builtin_amdgcn_readfirstlane((int)MISC[24]);
                __syncthreads();
                if (it >= C_QITEMS) break;
                c_prompt_item(args, l, it, TL); }
            wait_count(ctl + CW_ADONE + 64 * l, (unsigned)G, wave);
            c_sample_elems(args, l, G, bid, TL);
            SEAM(pb); STAMP(2);
        }
        if (IN(pb + 1)) {
            REP(5) for (int k = 0; ; ++k) {
                int u;
                if (G == 256) { if (k >= (bid < 192 ? 1 : 12)) break; u = bid < 192 ? bid : NBP * 48 + (bid - 192) * 12 + k; }
                else { u = bid + k * G; if (u >= (NBP + NBS) * 48) break; }
                ssd_unit(args, lds, l, u, TL); }
            __syncthreads();
            { pg8::Gemm g{(const pg8::bf16_t*)(args.ws + WS_POOLED), (const pg8::bf16_t*)(args.ws + WS_WP) + (size_t)l * 4 * 512 * 512, M, 512, 512, WPOOL, 512, 512, (size_t)512 * 512};
              pg8::EpiPool E{(pg8::bf16_t*)(args.ws + WS_MIXED), DIN, (const pg8::bf16_t*)(args.ws + WS_SG), WPOOL, args.in[11] + (size_t)l * WPOOL};
              for (;;) {
                  if (wave == 0 && fresh_lane() == 0) MISC[24] = __hip_atomic_fetch_add(ctl + CW_PQ + 64 * l, 1u, __ATOMIC_RELAXED, __HIP_MEMORY_SCOPE_AGENT);
                  __syncthreads();
                  const int tq = (int)MISC[24];
                  __syncthreads();
                  if (tq >= POOL_TILES) break;
                  OneTile S{tq};
                  pg8::gemm_phase<pg8::EpiPool, OneTile, true, true>(lds, g, S, E, TL);
                  __syncthreads(); } }
            SEAM(pb + 1); STAMP(4);
        }
        if (IN(pb + 2)) {   sample_norm(args, l, G, bid, fresh_lane(), wave);
            { pg8::Gemm g{(const pg8::bf16_t*)(args.ws + WS_MIXED), (const pg8::bf16_t*)(args.ws + WS_WOUT + (size_t)l * WOUT_L), MP, DM, DIN, DIN, DIN, 0, 0};
              pg8::StaticOrder S; S.init(MP, DM, G, bid);
              pg8::EpiResid E{(pg8::bf16_t*)(args.ws + WS_R), DM, l == 0 ? args.in[0] : (const float*)(args.ws + WS_X1), (const float*)(args.ws + WS_MODF) + (size_t)l * NBT * 3 * DM + 2 * DM, 3 * DM, ALPHA, lds};
              { const int tt = TL; pg8::Unit u0;
                for (int ui = 0; ui < 2; ++ui) if (S.next(ui, u0)) ktab_build((const float*)(args.ws + WS_YG), (LAS float*)(lds + pg8::KTAB_OFF) + ui * 9 * 256, u0.pm * 256, 8, 7, tt);
                __syncthreads(); }
              pg8::gemm_phase<pg8::EpiResid, pg8::StaticOrder, true, true>(lds, g, S, E, TL);
#if (PROBE_MASK >> 7) & 1
              __syncthreads(); pg8::gemm_phase<pg8::EpiResid, pg8::StaticOrder, true, true>(lds, g, S, E, TL);
#endif
            }
            __syncthreads();
            { pg8::Gemm g{(const pg8::bf16_t*)(args.ws + WS_MIXED) + (size_t)MP * DIN, (const pg8::bf16_t*)(args.ws + WS_WOUT + (size_t)l * WOUT_L), MS, DM, DIN / 8, DIN, DIN, (size_t)(DIN / 8), (size_t)(DIN / 8)};
              pg8::GroupOrder S; S.init(MS, DM, 8, G, bid);
              pg8::EpiSlab E{(float*)(args.ws + WS_SLAB), DM, (size_t)MS * DM};
              sample_wait(args, (unsigned)G * (unsigned)(l + 1), fresh_lane(), wave);
              pg8::gemm_phase<pg8::EpiSlab, pg8::GroupOrder, true, true>(lds, g, S, E, TL); }
            SEAM(pb + 2); STAMP(6);
        }
        if (IN(pb + 3)) { REP(8) phase_g(args, lds, l, G, bid, fresh_lane(), wave); if (pb + 3 < NPHASE - 1) SEAM(pb + 3); STAMP(7); }
    }
#if PROBE_SEL > 0
    if (bid == 0 && wave == 0 && fresh_lane() == 0) { const unsigned long long t_end = __builtin_amdgcn_s_memrealtime() + (unsigned long long)PROBE_MULT * tsw[1]; while (__builtin_amdgcn_s_memrealtime() < t_end) __builtin_amdgcn_s_sleep(8); }
#endif
#undef IN
#undef BOTH
#undef SEAM
}

#ifndef MK_SPLIT
#define MK_SPLIT 0
#endif
extern "C" void kernel_launch(void* const* d_in, const int* in_sizes, int n_in, void* d_out, int out_size, void* d_ws, size_t ws_size, hipStream_t stream) {
    static int grid = 0;
    if (grid == 0) {
        if (n_in != 21 || (size_t)out_size != O_END || ws_size < WS_END) { fprintf(stderr, "kernel_launch: unexpected shapes: n_in %d out %d ws %zu; nothing launched\n", n_in, out_size, ws_size); grid = -1; return; }
        int dev = 0, cus = 0, per_cu = 0;
        if (hipGetDevice(&dev) != hipSuccess || hipDeviceGetAttribute(&cus, hipDeviceAttributeMultiprocessorCount, dev) != hipSuccess) { grid = -1; return; }
        if (hipFuncSetAttribute((const void*)trunk_fwd, hipFuncAttributeMaxDynamicSharedMemorySize, LDS_BYTES) != hipSuccess) { fprintf(stderr, "kernel_launch: hipFuncSetAttribute failed\n"); grid = -1; return; }
        if (hipOccupancyMaxActiveBlocksPerMultiprocessor(&per_cu, (const void*)trunk_fwd, NWAVES * 64, LDS_BYTES) != hipSuccess || per_cu < 1) { fprintf(stderr, "kernel_launch: occupancy query says %d blocks per CU\n", per_cu); (void)hipGetLastError(); grid = -1; return; }
        grid = cus;
    }
    if (grid < 0) return;
    if (hipMemsetAsync((char*)d_ws + WS_CTL, 0, CTL_ZERO_BYTES, stream) != hipSuccess) return;
    Args a{};
    for (int i = 0; i < 21; ++i) a.in[i] = (const float*)d_in[i];
    a.out = (float*)d_out; a.ws = (unsigned char*)d_ws;
#if MK_SPLIT
    for (int ph = 0; ph < NPHASE; ++ph) { a.ph_lo = ph; a.ph_hi = ph + 1; hipLaunchKernelGGL(trunk_fwd, dim3(grid), dim3(NWAVES * 64), LDS_BYTES, stream, a); }
#else
    a.ph_lo = 0; a.ph_hi = NPHASE; hipLaunchKernelGGL(trunk_fwd, dim3(grid), dim3(NWAVES * 64), LDS_BYTES, stream, a);
#endif
}
```

```cpp
#ifndef PROBE_MASK
#define PROBE_MASK 0
#endif
#include <hip/hip_runtime.h>
#include <cstdio>
#include <cstdint>
namespace pg8 {
#define PG8_LAS __attribute__((address_space(3)))
typedef unsigned short bf16_t;
typedef short bf16x8 __attribute__((ext_vector_type(8)));
typedef float f32x4 __attribute__((ext_vector_type(4)));
typedef unsigned u32x4 __attribute__((ext_vector_type(4)));
constexpr int BM = 256, BK = 64, HALF = 128, HTB = HALF * BK * 2  , STAGE_BYTES = 8 * HTB, NXCD = 8, WGM = 8;

__host__ __device__ __forceinline__ int lds_byte(int r, int c) { const int st = (r >> 4) * 2 + (c >> 5), rr = r & 15, cc = c & 31, ob = rr * 64 + cc * 2; return st * 1024 + (ob ^ (((ob >> 9) & 1) << 5)); }
__host__ __device__ __forceinline__ void stage_rc(int b, int& R, int& C) { const int st = b / 1024, sb = b % 1024, swz = sb ^ (((sb >> 9) & 1) << 5); R = (st >> 1) * 16 + swz / 64; C = (st & 1) * 32 + (swz % 64) / 2; }
__host__ __device__ __forceinline__ int perm32(int rho) { const int n = rho >> 4, i = rho & 15; return 8 * (i >> 2) + 4 * n + (i & 3); }

struct Unit { int pm, pn, g, ui; };
struct Gemm { const bf16_t* A; const bf16_t* Bt; int M, N, K, lda, ldb; size_t a_goff, b_goff; };

struct StaticOrder {
    int nM, nN, nwg, G, c;
    __host__ __device__ void init(int M, int N, int G_, int c_) { nM = M / BM; nN = N / BM; nwg = nM * nN; G = G_; c = c_; }
    __host__ __device__ bool next(int i, Unit& u) const {
        const long L = (long)i * G + c; if (L >= nwg) return false;
        int wgid = (int)L; { const int q = nwg / NXCD, r = nwg % NXCD, xcd = wgid % NXCD, off = wgid / NXCD; wgid = (xcd < r ? xcd * (q + 1) : r * (q + 1) + (xcd - r) * q) + off; }
        const int nig = WGM * nN, gid = wgid / nig, fm = gid * WGM, gsz = (nM - fm) < WGM ? (nM - fm) : WGM;
        u.pm = fm + ((wgid % nig) % gsz); u.pn = (wgid % nig) / gsz; u.g = 0; return true;
    }
    __device__ __forceinline__ void a_ready(const Unit&) const {}
    __device__ __forceinline__ void done(const Unit&) const {}
};
struct GroupOrder {
    int nM, nN, ng, G, c;
    __host__ __device__ void init(int M, int N, int ng_, int G_, int c_) { nM = M / BM; nN = N / BM; ng = ng_; G = G_; c = c_; }
    __host__ __device__ bool next(int i, Unit& u) const {
        const long L = (long)i * G + c; if (L >= (long)nM * nN * ng) return false;
        const int per = nM * nN, l = (int)L; u.g = l / per; const int r = l % per; u.pm = r % nM; u.pn = r / nM; return true;
    }
    __device__ __forceinline__ void a_ready(const Unit&) const {}
    __device__ __forceinline__ void done(const Unit&) const {}
};

typedef __bf16 hwbf16x2 __attribute__((ext_vector_type(2))); typedef float f32x2c __attribute__((ext_vector_type(2)));
__device__ __forceinline__ unsigned cvt_pk_bf16(float lo, float hi) { return __builtin_bit_cast(unsigned, __builtin_convertvector((f32x2c){lo, hi}, hwbf16x2)); }
__device__ __forceinline__ float silu_f(float x) { return x * __builtin_amdgcn_rcpf(1.0f + __expf(-x)); }

__device__ __forceinline__ f32x4 bf4_to_f32(unsigned lo, unsigned hi) { return (f32x4){__builtin_bit_cast(float, lo << 16), __builtin_bit_cast(float, lo & 0xffff0000u), __builtin_bit_cast(float, hi << 16), __builtin_bit_cast(float, hi & 0xffff0000u)}; }
constexpr int KTAB_OFF = 135168;
__device__ __forceinline__ void kscale_acc(f32x4 (&acc)[2][2][4][2], const PG8_LAS float* col, int wr, int fr) {
#pragma unroll
    for (int ai = 0; ai < 2; ++ai)
#pragma unroll
        for (int m = 0; m < 4; ++m) { const float f = col[ai * HALF + wr * 64 + m * 16 + fr];
#pragma unroll
            for (int bj = 0; bj < 2; ++bj)
#pragma unroll
                for (int n = 0; n < 2; ++n) acc[ai][bj][m][n] = acc[ai][bj][m][n] * f; }
}
struct EpiSlab {
    static constexpr bool PERM = false, AFTER_DRAIN = false, KHOOK = false;
    float* C; int ldc; size_t gstride;
    __device__ __forceinline__ void operator()(const f32x4 (&acc)[2][2][4][2], const Unit& u, int wr, int wc, int fr, int fq) const {
        asm volatile("" : "+v"(fr), "+v"(fq));
        const int row0 = u.pm * BM + wr * 64 + fr, col0 = u.pn * BM + wc * 32 + 4 * fq; float* Cg = C + (size_t)u.g * gstride;
#pragma unroll
        for (int ai = 0; ai < 2; ++ai)
#pragma unroll
            for (int m = 0; m < 4; ++m) { float* rowp = Cg + (size_t)(row0 + ai * HALF + m * 16) * ldc + col0;
#pragma unroll
                for (int bj = 0; bj < 2; ++bj)
#pragma unroll
                    for (int n = 0; n < 2; ++n) *(f32x4*)(rowp + bj * HALF + n * 16) = acc[ai][bj][m][n]; }
    }
};
struct EpiPool {
    static constexpr bool PERM = true, AFTER_DRAIN = false, KHOOK = false;
    bf16_t* O; int ldo; const bf16_t* sg; int ldp; const float* pscale;
    __device__ __forceinline__ void operator()(const f32x4 (&acc)[2][2][4][2], const Unit& u, int wr, int wc, int fr, int fq) const {
        asm volatile("" : "+v"(fr), "+v"(fq));
        const int row0 = u.pm * BM + wr * 64 + fr, col0 = u.g * 512 + u.pn * BM + wc * 32 + 8 * fq;
        f32x4 ps[2][2];
#pragma unroll
        for (int bj = 0; bj < 2; ++bj)
#pragma unroll
            for (int n = 0; n < 2; ++n) ps[bj][n] = *(const f32x4*)(pscale + col0 + bj * HALF + 4 * n);
#pragma unroll
        for (int ai = 0; ai < 2; ++ai)
#pragma unroll
            for (int m = 0; m < 4; ++m) { const size_t row = (size_t)(row0 + ai * HALF + m * 16);
#pragma unroll
                for (int bj = 0; bj < 2; ++bj) { const int c = col0 + bj * HALF;
                    const u32x4 gq = *(const u32x4*)(sg + row * ldp + c);
                    const f32x4 v0 = acc[ai][bj][m][0] * ps[bj][0] * bf4_to_f32(gq.x, gq.y), v1 = acc[ai][bj][m][1] * ps[bj][1] * bf4_to_f32(gq.z, gq.w);
                    u32x4 w; w.x = cvt_pk_bf16(v0[0], v0[1]); w.y = cvt_pk_bf16(v0[2], v0[3]); w.z = cvt_pk_bf16(v1[0], v1[1]); w.w = cvt_pk_bf16(v1[2], v1[3]);
                    *(u32x4*)(O + row * ldo + c) = w; } }
    }
};
struct EpiResid {
    static constexpr bool PERM = true, AFTER_DRAIN = false, KHOOK = true;
    bf16_t* R; int ldr; const float* xp; const float* gate; int ldg; float alpha; PG8_LAS unsigned char* lds;
    __device__ __forceinline__ void khook(f32x4 (&acc)[2][2][4][2], const Unit& u, int t, int wr, int fr) const {
        if (t >= 32 && (t - 32) % 12 == 0) kscale_acc(acc, (const PG8_LAS float*)(lds + KTAB_OFF) + (u.ui * 9 + (t - 32) / 12) * 256, wr, fr);
    }
    __device__ __forceinline__ void operator()(const f32x4 (&acc)[2][2][4][2], const Unit& u, int wr, int wc, int fr, int fq) const {
        asm volatile("" : "+v"(fr), "+v"(fq));
        const int row0 = u.pm * BM + wr * 64 + fr, col0 = u.pn * BM + wc * 32 + 8 * fq;
        const float* gr = gate + (size_t)(u.pm >> 3) * ldg + col0;
        f32x4 gv[2][2];
#pragma unroll
        for (int bj = 0; bj < 2; ++bj)
#pragma unroll
            for (int n = 0; n < 2; ++n) gv[bj][n] = *(const f32x4*)(gr + bj * HALF + 4 * n);
        u32x4 pk[2][4][2];
#pragma unroll
        for (int ai = 0; ai < 2; ++ai)
#pragma unroll
            for (int m = 0; m < 4; ++m) { const float s7 = ((const PG8_LAS float*)(lds + KTAB_OFF))[(u.ui * 9 + 8) * 256 + ai * HALF + wr * 64 + m * 16 + fr];
#pragma unroll
                for (int bj = 0; bj < 2; ++bj) { const f32x4 v0 = acc[ai][bj][m][0] * gv[bj][0] * s7, v1 = acc[ai][bj][m][1] * gv[bj][1] * s7;
                    pk[ai][m][bj] = (u32x4){cvt_pk_bf16(v0[0], v0[1]), cvt_pk_bf16(v0[2], v0[3]), cvt_pk_bf16(v1[0], v1[1]), cvt_pk_bf16(v1[2], v1[3])}; } }
#pragma unroll
        for (int ai = 0; ai < 2; ++ai) { f32x4 xv[4][2][2];
            __builtin_amdgcn_sched_barrier(0);
#pragma unroll
            for (int m = 0; m < 4; ++m) { const float* xr = xp + (size_t)(row0 + ai * HALF + m * 16) * 4096 + col0;
#pragma unroll
                for (int bj = 0; bj < 2; ++bj)
#pragma unroll
                    for (int n = 0; n < 2; ++n) xv[m][bj][n] = *(const f32x4*)(xr + bj * HALF + 4 * n); }
            __builtin_amdgcn_sched_barrier(0);
#pragma unroll
            for (int m = 0; m < 4; ++m) { bf16_t* rr = R + (size_t)(row0 + ai * HALF + m * 16) * ldr + col0;
#pragma unroll
                for (int bj = 0; bj < 2; ++bj) { const u32x4 t = pk[ai][m][bj];
                    const f32x4 o0 = xv[m][bj][0] * alpha + bf4_to_f32(t.x, t.y), o1 = xv[m][bj][1] * alpha + bf4_to_f32(t.z, t.w);
                    u32x4 w; w.x = cvt_pk_bf16(o0[0], o0[1]); w.y = cvt_pk_bf16(o0[2], o0[3]); w.z = cvt_pk_bf16(o1[0], o1[1]); w.w = cvt_pk_bf16(o1[2], o1[3]);
                    *(u32x4*)(rr + bj * HALF) = w; } } }
    }
};

template <class Epi, class Sched, bool ALIGN_EPI = false, bool SP2 = false>
__device__ __forceinline__ void gemm_phase(PG8_LAS unsigned char* lds, const Gemm g, const Sched& S, const Epi& E, const int tid) {
    const int wid = __builtin_amdgcn_readfirstlane(tid >> 6), lane = tid & 63, wr = wid >> 2, wc = wid & 3, fr = lane & 15, fq = lane >> 4;
    const int K = g.K, nt = K / BK;
    unsigned voffA[2], voffB[2];
#pragma unroll
    for (int i = 0; i < 2; ++i) { int R, C; stage_rc(tid * 16 + i * 8192, R, C); const int Rb = Epi::PERM ? ((R & ~31) + perm32(R & 31)) : R;
        voffA[i] = (unsigned)(R * g.lda + C) * 2u; voffB[i] = (unsigned)(Rb * g.ldb + C) * 2u; }
    const size_t kstep = (size_t)(BK * 2);
    const size_t hstepA = (size_t)HALF * g.lda * 2, hstepB = (size_t)HALF * g.ldb * 2;
    const size_t tstepA = 2 * hstepA, tstepB = 2 * hstepB;
    const unsigned ldsw = (unsigned)wid * 1024u;
    const int aoff = lds_byte(wr * 64 + fr, fq * 8), boff = lds_byte(wc * 32 + fr, fq * 8);
#define PG8_SA(b, h) (((b) * 2 + (h)) * HTB)
#define PG8_SB(b, h) ((4 + (b) * 2 + (h)) * HTB)
#define PG8_STAGE(bufoff, gbase, voff) do { _Pragma("unroll") for (int _i = 0; _i < 2; ++_i) \
        __builtin_amdgcn_global_load_lds((const unsigned*)((const char*)(gbase) + (voff)[_i]), (PG8_LAS unsigned*)(lds + (bufoff) + ldsw + _i * 8192), 16, 0, 0); } while (0)
#define PG8_LDA(dst, b, h) do { _Pragma("unroll") for (int m = 0; m < 4; ++m) _Pragma("unroll") for (int k = 0; k < 2; ++k) dst[m][k] = *(const PG8_LAS bf16x8*)(lds + PG8_SA(b, h) + aoff + m * 2048 + k * 1024); } while (0)
#define PG8_LDB(dst, b, h) do { _Pragma("unroll") for (int n = 0; n < 2; ++n) _Pragma("unroll") for (int k = 0; k < 2; ++k) dst[n][k] = *(const PG8_LAS bf16x8*)(lds + PG8_SB(b, h) + boff + n * 2048 + k * 1024); } while (0)
#define PG8_MMA(ai, bj, At, Bt) do { __builtin_amdgcn_s_setprio(1); _Pragma("unroll") for (int m = 0; m < 4; ++m) _Pragma("unroll") for (int n = 0; n < 2; ++n) _Pragma("unroll") for (int k = 0; k < 2; ++k) \
        acc[ai][bj][m][n] = __builtin_amdgcn_mfma_f32_16x16x32_bf16(Bt[n][k], At[m][k], acc[ai][bj][m][n], 0, 0, 0); __builtin_amdgcn_s_setprio(0); } while (0)
#define PG8_WAIT_V(n) asm volatile("s_waitcnt vmcnt(" #n ")" ::: "memory")
#define PG8_WAIT_L(n) asm volatile("s_waitcnt lgkmcnt(" #n ")" ::: "memory")
#define PG8_BAR __builtin_amdgcn_s_barrier()
#define PG8_SCHED __builtin_amdgcn_sched_barrier(0)
    Unit cur, nxt; int ui = 0;
    if (!S.next(0, cur)) return;
    cur.ui = 0;
    f32x4 acc[2][2][4][2];
#pragma unroll
    for (int a = 0; a < 2; ++a)
#pragma unroll
        for (int b = 0; b < 2; ++b)
#pragma unroll
            for (int m = 0; m < 4; ++m)
#pragma unroll
                for (int n = 0; n < 2; ++n) acc[a][b][m][n] = (f32x4){0.f, 0.f, 0.f, 0.f};
    bf16x8 At[4][2], B0[2][2], B1[2][2];
    const char* cA = (const char*)g.A + (size_t)cur.g * g.a_goff * 2 + (size_t)cur.pm * tstepA; const char* cB = (const char*)g.Bt + (size_t)cur.g * g.b_goff * 2 + (size_t)cur.pn * tstepB;
    S.a_ready(cur);
    if constexpr (SP2) {
        PG8_STAGE(PG8_SB(0, 0), cB, voffB); PG8_STAGE(PG8_SB(0, 1), cB + hstepB, voffB); PG8_STAGE(PG8_SA(0, 0), cA, voffA); PG8_STAGE(PG8_SA(0, 1), cA + hstepA, voffA);
        if (wr == 1) PG8_BAR;
        PG8_WAIT_V(2); PG8_BAR;
        PG8_STAGE(PG8_SB(1, 0), cB + kstep, voffB); PG8_STAGE(PG8_SA(1, 0), cA + kstep, voffA); PG8_STAGE(PG8_SB(1, 1), cB + hstepB + kstep, voffB);
        PG8_WAIT_V(6); PG8_BAR;
    } else {
        PG8_STAGE(PG8_SB(0, 0), cB, voffB); PG8_STAGE(PG8_SA(0, 0), cA, voffA); PG8_STAGE(PG8_SB(0, 1), cB + hstepB, voffB); PG8_STAGE(PG8_SA(0, 1), cA + hstepA, voffA);
        if (wr == 1) PG8_BAR;
        PG8_WAIT_V(4); PG8_BAR;
        PG8_STAGE(PG8_SB(1, 0), cB + kstep, voffB); PG8_STAGE(PG8_SA(1, 0), cA + kstep, voffA); PG8_STAGE(PG8_SB(1, 1), cB + hstepB + kstep, voffB);
        PG8_WAIT_V(6); PG8_BAR;
    }
    for (;;) {
        const bool has_next = S.next(ui + 1, nxt); nxt.ui = ui + 1;
        const char* nA = has_next ? (const char*)g.A + (size_t)nxt.g * g.a_goff * 2 + (size_t)nxt.pm * tstepA : cA; const char* nB = has_next ? (const char*)g.Bt + (size_t)nxt.g * g.b_goff * 2 + (size_t)nxt.pn * tstepB : cB;
        for (int t = 0; t < nt; t += 2) {
            const bool last = (t == nt - 2);
            const char* a1 = cA + (size_t)(t + 1) * kstep;
            const char* a2 = last ? nA : cA + (size_t)(t + 2) * kstep; const char* b2 = last ? nB : cB + (size_t)(t + 2) * kstep;
            const char* a3 = a2 + kstep; const char* b3 = b2 + kstep;
            if (last && has_next) S.a_ready(nxt);
            if constexpr (Epi::KHOOK) E.khook(acc, cur, t, wr, fr);
            if constexpr (SP2) {
            PG8_LDB(B0, 0, 0); PG8_LDB(B1, 0, 1); PG8_SCHED; PG8_LDA(At, 0, 0); PG8_STAGE(PG8_SA(1, 1), a1 + hstepA, voffA);
            PG8_WAIT_V(8); PG8_WAIT_L(0); PG8_BAR; PG8_MMA(0, 0, At, B0); PG8_MMA(0, 1, At, B1); PG8_BAR; PG8_SCHED;
            PG8_LDA(At, 0, 1); PG8_STAGE(PG8_SB(0, 0), b2, voffB); PG8_STAGE(PG8_SB(0, 1), b2 + hstepB, voffB); PG8_STAGE(PG8_SA(0, 0), a2, voffA);
            PG8_WAIT_V(8); PG8_WAIT_L(0); PG8_BAR; PG8_MMA(1, 0, At, B0); PG8_MMA(1, 1, At, B1); PG8_BAR; PG8_SCHED;
            PG8_LDB(B0, 1, 0); PG8_LDB(B1, 1, 1); PG8_SCHED; PG8_LDA(At, 1, 0); PG8_STAGE(PG8_SA(0, 1), a2 + hstepA, voffA);
            PG8_WAIT_V(8); PG8_WAIT_L(0); PG8_BAR; PG8_MMA(0, 0, At, B0); PG8_MMA(0, 1, At, B1); PG8_BAR; PG8_SCHED;
            PG8_LDA(At, 1, 1); PG8_STAGE(PG8_SB(1, 0), b3, voffB); PG8_STAGE(PG8_SB(1, 1), b3 + hstepB, voffB); PG8_STAGE(PG8_SA(1, 0), a3, voffA);
            PG8_WAIT_V(8); PG8_WAIT_L(0); PG8_BAR; PG8_MMA(1, 0, At, B0); PG8_MMA(1, 1, At, B1); PG8_BAR; PG8_SCHED;
            } else {
            PG8_LDB(B0, 0, 0); PG8_SCHED; PG8_LDA(At, 0, 0); PG8_STAGE(PG8_SA(1, 1), a1 + hstepA, voffA);
            PG8_WAIT_L(8); PG8_BAR; PG8_WAIT_L(0); PG8_MMA(0, 0, At, B0); PG8_BAR; PG8_SCHED;
            PG8_LDB(B1, 0, 1); PG8_STAGE(PG8_SB(0, 0), b2, voffB);
            PG8_BAR; PG8_WAIT_L(0); PG8_MMA(0, 1, At, B1); PG8_BAR;
            PG8_LDA(At, 0, 1); PG8_STAGE(PG8_SA(0, 0), a2, voffA);
            PG8_BAR; PG8_WAIT_L(0); PG8_MMA(1, 0, At, B0); PG8_BAR; PG8_SCHED;
            PG8_STAGE(PG8_SB(0, 1), b2 + hstepB, voffB);
            PG8_WAIT_V(6); PG8_BAR; PG8_MMA(1, 1, At, B1); PG8_BAR;
            PG8_LDB(B0, 1, 0); PG8_SCHED; PG8_LDA(At, 1, 0); PG8_STAGE(PG8_SA(0, 1), a2 + hstepA, voffA);
            PG8_WAIT_L(8); PG8_BAR; PG8_WAIT_L(0); PG8_MMA(0, 0, At, B0); PG8_BAR; PG8_SCHED;
            PG8_LDB(B1, 1, 1); PG8_STAGE(PG8_SB(1, 0), b3, voffB);
            PG8_BAR; PG8_WAIT_L(0); PG8_MMA(0, 1, At, B1); PG8_BAR;
            PG8_LDA(At, 1, 1); PG8_STAGE(PG8_SA(1, 0), a3, voffA);
            PG8_BAR; PG8_WAIT_L(0); PG8_MMA(1, 0, At, B0); PG8_BAR; PG8_SCHED;
            PG8_STAGE(PG8_SB(1, 1), b3 + hstepB, voffB);
            PG8_WAIT_V(6); PG8_BAR; PG8_MMA(1, 1, At, B1); PG8_BAR;
            }
        }
        if constexpr (ALIGN_EPI) { if (wr == 0) PG8_BAR; }
        if constexpr (!Epi::AFTER_DRAIN) { E(acc, cur, wr, wc, fr, fq); S.done(cur); }
        if (!has_next) break;
#pragma unroll
        for (int a = 0; a < 2; ++a)
#pragma unroll
            for (int b = 0; b < 2; ++b)
#pragma unroll
                for (int m = 0; m < 4; ++m)
#pragma unroll
                    for (int n = 0; n < 2; ++n) acc[a][b][m][n] = (f32x4){0.f, 0.f, 0.f, 0.f};
        cur = nxt; cA = nA; cB = nB; ++ui;
        if constexpr (ALIGN_EPI) { if (wr == 1) PG8_BAR; }
    }
    PG8_WAIT_V(0);
    if constexpr (!ALIGN_EPI) { if (wr == 0) PG8_BAR; }
    PG8_BAR;
    if constexpr (Epi::AFTER_DRAIN) { E.fused(acc, cur, wr, wc, fr, fq, lds, wid, lane); S.done(cur); }
#undef PG8_SA
#undef PG8_SB
#undef PG8_STAGE
#undef PG8_LDA
#undef PG8_LDB
#undef PG8_MMA
#undef PG8_WAIT_V
#undef PG8_WAIT_L
#undef PG8_BAR
#undef PG8_SCHED
}
}

constexpr int DM = 4096, NBP = 4, SEQ = 2048, NBS = 16, DSEQ = 32, PAST = 1024;
constexpr int MP = NBP * SEQ, MS = NBS * DSEQ, M = MP + MS, NBT = NBP + NBS;
constexpr int WPOOL = 2048, WSSD = 6144, HD = 64, NH = 96, NS = 128, CONVD = 8192, IN_DIM = 18528, NPAD = 18688, DIN = 8192;
constexpr int C_U = 0, C_G = 2048, C_Z = 4096, C_X = 10240, C_B = C_X + 6144, C_C = C_B + 1024, C_DT = 18432;
constexpr float LN_EPS = 1e-5f, RMS_EPS = 1e-5f, ALPHA = 1.41421356237f;
constexpr size_t O_Y = 0, O_PP = 35651584, O_CP = 35897344, O_SP = 36093952, O_PS = 42385408, O_CS = 43368448, O_SS = 44154880, O_END = 69320704;
constexpr size_t MiB = 1u << 20;
constexpr size_t WS_CTL = 0, CTL_ZERO_BYTES = 1 * MiB, WS_MODF = 1 * MiB, WS_WIN = 4 * MiB, WIN_L = 146 * MiB, WS_WOUT = 296 * MiB, WOUT_L = 64 * MiB, WS_WP = 424 * MiB,
                 WS_H = 428 * MiB, WS_UP = 496 * MiB, WS_SG = 530 * MiB, WS_SZ = 564 * MiB, WS_XP = 666 * MiB, WS_XBC = 802 * MiB, WS_POOLED = 938 * MiB, WS_DTV = 972 * MiB,
                 WS_YG = 976 * MiB, WS_MIXED = 1078 * MiB, WS_R = 1214 * MiB, WS_X1 = 1350 * MiB, WS_SLAB = 1486 * MiB, WS_END = 1550 * MiB;
static_assert((size_t)NPAD * DM * 2 == WIN_L && (size_t)DM * DIN * 2 == WOUT_L && WS_SZ + (size_t)M * WSSD * 2 <= WS_XP && WS_XP + (size_t)M * CONVD * 2 <= WS_XBC && WS_SLAB + (size_t)8 * MS * DM * 4 <= WS_END, "ws map");
constexpr int CW_MOD = 8128;
constexpr int CW_BAR = 4096;
constexpr int RING_BYTES = 131072, LDSCTL_OFF = RING_BYTES, MISC_OFF = LDSCTL_OFF + 320, LDS_BYTES = 155648;
constexpr int NWAVES = 8;
constexpr int NPHASE = 9;

struct EpiProj {
    typedef pg8::bf16_t bf16_t; typedef pg8::f32x4 f32x4; typedef pg8::u32x4 u32x4; typedef pg8::Unit Unit; static constexpr int BM = pg8::BM, HALF = pg8::HALF;
    static constexpr bool PERM = true, AFTER_DRAIN = false, KHOOK = false;
    unsigned char* ws; float* out; const float* dtb; int l;
    __device__ __forceinline__ void operator()(const f32x4 (&acc)[2][2][4][2], const Unit& u, int wr, int wc, int fr, int fq) const {
        asm volatile("" : "+v"(fr), "+v"(fq));
        const int pn = u.pn, row0 = u.pm * BM + wr * 64 + fr, cl = wc * 32 + 8 * fq;
        if (pn < 8 || (pn >= 40 && pn < 72)) {
            const bool pool = pn < 8; bf16_t* O = (bf16_t*)(ws + (pool ? WS_UP : WS_XP)); const int ldo = pool ? 2048 : 8192, c0 = (pool ? pn : pn - 40) * BM + cl, hist = pool ? 15 : 3;
#pragma unroll
            for (int ai = 0; ai < 2; ++ai)
#pragma unroll
                for (int m = 0; m < 4; ++m) { const int row = row0 + ai * HALF + m * 16;
#pragma unroll
                    for (int bj = 0; bj < 2; ++bj) { const f32x4 v0 = acc[ai][bj][m][0], v1 = acc[ai][bj][m][1];
                        u32x4 w; w.x = pg8::cvt_pk_bf16(v0[0], v0[1]); w.y = pg8::cvt_pk_bf16(v0[2], v0[3]); w.z = pg8::cvt_pk_bf16(v1[0], v1[1]); w.w = pg8::cvt_pk_bf16(v1[2], v1[3]);
                        *(u32x4*)(O + (size_t)row * ldo + c0 + bj * HALF) = w; }
                    asm volatile("" ::: "memory"); }
            if (u.pm >= 32 || (u.pm & 7) == 7) {
#pragma unroll
                for (int ai = 0; ai < 2; ++ai)
#pragma unroll
                    for (int m = 0; m < 4; ++m) { const int row = row0 + ai * HALF + m * 16;
                        const bool samp = row >= 8192; const int t = samp ? ((row - 8192) & 31) : (row & 2047), L = samp ? 32 : 2048, b = samp ? ((row - 8192) >> 5) : (row >> 11);
                        if (t >= L - hist) { float* nb = out + (samp ? (pool ? O_PS : O_CS) : (pool ? O_PP : O_CP)) + ((size_t)(l * (samp ? NBS : NBP) + b) * hist + (t - (L - hist))) * ldo + c0;
#pragma unroll
                            for (int bj = 0; bj < 2; ++bj) { *(f32x4*)(nb + bj * HALF) = acc[ai][bj][m][0]; *(f32x4*)(nb + bj * HALF + 4) = acc[ai][bj][m][1]; } }
                        asm volatile("" ::: "memory"); }
            }
        } else if (pn < 40) {
            const bool gp = pn < 16; bf16_t* O = (bf16_t*)(ws + (gp ? WS_SG : WS_SZ)); const int ldo = gp ? 2048 : 6144, c0 = (gp ? pn - 8 : pn - 16) * BM + cl;
#pragma unroll
            for (int ai = 0; ai < 2; ++ai)
#pragma unroll
                for (int m = 0; m < 4; ++m) { const int row = row0 + ai * HALF + m * 16;
#pragma unroll
                    for (int bj = 0; bj < 2; ++bj) { f32x4 v0 = acc[ai][bj][m][0], v1 = acc[ai][bj][m][1];
#pragma unroll
                        for (int j = 0; j < 4; ++j) { v0[j] = pg8::silu_f(v0[j]); v1[j] = pg8::silu_f(v1[j]); }
                        u32x4 w; w.x = pg8::cvt_pk_bf16(v0[0], v0[1]); w.y = pg8::cvt_pk_bf16(v0[2], v0[3]); w.z = pg8::cvt_pk_bf16(v1[0], v1[1]); w.w = pg8::cvt_pk_bf16(v1[2], v1[3]);
                        *(u32x4*)(O + (size_t)row * ldo + c0 + bj * HALF) = w; }
                    asm volatile("" ::: "memory"); }
        } else {
            if (cl < 96) {
#pragma unroll
                for (int n = 0; n < 2; ++n)
#pragma unroll
                    for (int j = 0; j < 4; ++j) { const int c = cl + 4 * n + j; const float bias = dtb[c];
#pragma unroll
                        for (int ai = 0; ai < 2; ++ai)
#pragma unroll
                            for (int m = 0; m < 4; ++m) { const float x = acc[ai][0][m][n][j] + bias;
                                ((float*)(ws + WS_DTV))[(size_t)c * 8704 + row0 + ai * HALF + m * 16] = fmaxf(x, 0.f) + log1pf(expf(-fabsf(x))); } }
            }
        }
    }
};

#define GAS __attribute__((address_space(1)))
#define LAS __attribute__((address_space(3)))
typedef unsigned short bf16;
typedef unsigned v4u __attribute__((ext_vector_type(4)));
typedef unsigned v2u __attribute__((ext_vector_type(2)));
typedef float f32x4 __attribute__((ext_vector_type(4)));
typedef float f32x2 __attribute__((ext_vector_type(2)));
#define LDS_WAIT() asm volatile("s_waitcnt lgkmcnt(0)" ::: "memory")
#define VM_WAIT() asm volatile("s_waitcnt vmcnt(0)" ::: "memory")
__device__ __forceinline__ unsigned f2bf(float f) { unsigned u = __builtin_bit_cast(unsigned, f); return (u + 0x7fffu + ((u >> 16) & 1u)) >> 16; }
typedef __bf16 hwbf16x2 __attribute__((ext_vector_type(2)));
__device__ __forceinline__ unsigned pk2(float lo, float hi) { return __builtin_bit_cast(unsigned, __builtin_convertvector((f32x2){lo, hi}, hwbf16x2)); }
__device__ __forceinline__ float bf2f(unsigned short b) { return __builtin_bit_cast(float, ((unsigned)b) << 16); }
__device__ __forceinline__ float silu(float x) { return x / (1.0f + __expf(-x)); }
__device__ __forceinline__ int fresh_lane() { int l; asm volatile("v_mbcnt_lo_u32_b32 %0, -1, 0\n\tv_mbcnt_hi_u32_b32 %0, -1, %0" : "=v"(l)); return l; }
__device__ __forceinline__ float wave_sum(float v) {
#pragma unroll
    for (int o = 1; o < 64; o <<= 1) v += __shfl_xor(v, o);
    return v;
}

#define XB_TMO      128
#define XB_XCNT(j)  (256  + 64 * (j))
#define XB_XSUB(j)  (1280 + 64 * (j))
#define XB_XGEN(j)  (2304 + 64 * (j))
#define XB_TOP      3328
#define XB_TOPGEN   3392
#define XCD_BAR_WORDS 3456
#define XB_SPIN_CAP (1u << 18)
__device__ __forceinline__ unsigned xb_ld(unsigned* p)              { return __hip_atomic_load(p, __ATOMIC_RELAXED, __HIP_MEMORY_SCOPE_AGENT); }
__device__ __forceinline__ unsigned xb_add(unsigned* p, unsigned v) { return __hip_atomic_fetch_add(p, v, __ATOMIC_RELAXED, __HIP_MEMORY_SCOPE_AGENT); }
__device__ __forceinline__ unsigned xb_xcc_id() { return (unsigned)__builtin_amdgcn_s_getreg((3 << 11) | 20) & 0xFu; }
#define XB_SPIN(cond, bar) do { unsigned _sp = 0; while (cond) { __builtin_amdgcn_s_sleep(1); \
    if ((++_sp & 255u) == 0u) { if (xb_ld(&(bar)[XB_TMO])) break; if (_sp > XB_SPIN_CAP) { atomicAdd(&(bar)[XB_TMO], 1u); break; } } } } while (0)
struct XcdBarrier { unsigned* bar; unsigned x; volatile LAS unsigned* st; unsigned w0; };
__device__ __forceinline__ XcdBarrier xcd_barrier_post(unsigned* bar, volatile LAS unsigned* st, unsigned w0) {
    XcdBarrier b; b.bar = bar; b.x = xb_xcc_id(); b.st = st; b.w0 = w0;
    if (w0 && fresh_lane() == 0) (void)xb_add(&bar[XB_XCNT(b.x)], 1u);
    return b;
}
__device__ __forceinline__ void xcd_barrier_complete(unsigned* bar, unsigned x, unsigned& nloc, unsigned& nx) {
    const unsigned G = gridDim.x * gridDim.y * gridDim.z;
    unsigned sum, cnt, mine, sp = 0u;
    for (;;) {
        sum = 0u; cnt = 0u; mine = 0u;
#pragma unroll
        for (unsigned j = 0; j < 16; ++j) { const unsigned c = xb_ld(&bar[XB_XCNT(j)]); sum += c; cnt += (c > 0u) ? 1u : 0u; mine = (j == x) ? c : mine; }
        if (sum == G) break;
        __builtin_amdgcn_s_sleep(1);
        if ((++sp & 255u) == 0u) { if (xb_ld(&bar[XB_TMO])) break; if (sp > XB_SPIN_CAP) { atomicAdd(&bar[XB_TMO], 1u); break; } }
    }
    nloc = mine > 0u ? mine : 1u; nx = cnt > 0u ? cnt : 1u;
}
__device__ __forceinline__ void xcd_barrier(const XcdBarrier& b) {
    asm volatile("s_waitcnt vmcnt(0)" ::: "memory");
    __syncthreads();
    if (b.w0 && fresh_lane() == 0) {
        unsigned* bar = b.bar;
        __builtin_amdgcn_s_waitcnt(0);
        unsigned nloc = b.st[0], nx = b.st[1];
        if (nloc == 0u) { xcd_barrier_complete(bar, b.x, nloc, nx); b.st[0] = nloc; b.st[1] = nx; }
        const unsigned old = xb_add(&bar[XB_XSUB(b.x)], 1u);
        const unsigned gen = old / nloc;
        if (old + 1u == (gen + 1u) * nloc) {
            __builtin_amdgcn_fence(__ATOMIC_RELEASE, "agent");
            asm volatile("s_waitcnt vmcnt(0)" ::: "memory");
            const unsigned og = xb_add(&bar[XB_TOP], 1u);
            const unsigned tg = og / nx;
            if (og + 1u == (tg + 1u) * nx) xb_add(&bar[XB_TOPGEN], 1u);
            else XB_SPIN(xb_ld(&bar[XB_TOPGEN]) == tg, bar);
            __builtin_amdgcn_fence(__ATOMIC_ACQUIRE, "agent");
            xb_add(&bar[XB_XGEN(b.x)], 1u);
            asm volatile("s_waitcnt vmcnt(0)" ::: "memory");
        } else {
            XB_SPIN(xb_ld(&bar[XB_XGEN(b.x)]) == gen, bar);
            __builtin_amdgcn_fence(__ATOMIC_ACQUIRE, "agent");
            asm volatile("s_waitcnt vmcnt(0)" ::: "memory");
        }
    }
    __syncthreads();
}

struct Args { const float* in[21]; float* out; unsigned char* ws; int ph_lo, ph_hi; };

struct TItem { const float* W; bf16* WT; const float* ksc; int N, ldt, k0, n0, nvalid; };
__device__ __forceinline__ void p0_titem_load(const TItem& d, float (&v)[64], int lane) {
    const int col = lane < d.nvalid ? lane : d.nvalid - 1;
#pragma unroll
    for (int i = 0; i < 64; ++i) v[i] = d.W[(size_t)(d.k0 + i) * d.N + d.n0 + col];
}
__device__ __forceinline__ void p0_titem_finish(const TItem& d, const float (&v)[64], LAS float* scr, int lane) {
#pragma unroll
    for (int i = 0; i < 64; ++i) scr[i * 65 + lane] = v[i];
    LDS_WAIT(); asm volatile("" ::: "memory");
    const int c = lane & 7;
    f32x4 ka = (f32x4){1.f, 1.f, 1.f, 1.f}, kb4 = ka;
    if (d.ksc && d.k0 >= WPOOL) { ka = *(const f32x4*)(d.ksc + d.k0 + 8 * c - WPOOL); kb4 = *(const f32x4*)(d.ksc + d.k0 + 8 * c - WPOOL + 4); }
#pragma unroll
    for (int j = 0; j < 8; ++j) { const int n = (lane >> 3) + 8 * j; const LAS float* s = scr + (8 * c) * 65 + n;
        v4u o; o.x = pk2(s[0 * 65] * ka.x, s[1 * 65] * ka.y); o.y = pk2(s[2 * 65] * ka.z, s[3 * 65] * ka.w); o.z = pk2(s[4 * 65] * kb4.x, s[5 * 65] * kb4.y); o.w = pk2(s[6 * 65] * kb4.z, s[7 * 65] * kb4.w);
        if (n < d.nvalid) *(GAS v4u*)(d.WT + (size_t)(d.n0 + n) * d.ldt + d.k0 + 8 * c) = o; }
    LDS_WAIT(); asm volatile("" ::: "memory");
}
__device__ __forceinline__ void p0_mod_item(const Args& a, LAS unsigned char* lds, int item, int tid, int lane, int wave) {
    const int l = item >> 7, cb = item & 127, e0 = cb * 96;
    const float* W = a.in[7] + (size_t)l * DM * 3 * DM;
    const float* cp = a.in[5]; const float* cs = a.in[6];
    LAS float* sl = (LAS float*)(lds + wave * 8192);
    f32x4 acc[20];
#pragma unroll
    for (int b = 0; b < 20; ++b) acc[b] = (f32x4){0.f, 0.f, 0.f, 0.f};
    const bool act = lane < 48; const int rs = lane >= 24 ? 1 : 0, c4 = lane - 24 * rs;
    const float* wl = W + (size_t)(wave * 512 + rs) * (3 * DM) + e0 + 4 * (act ? c4 : 0);
    f32x4 nxt[8];
#define MOD_LOAD(t_) do { _Pragma("unroll") for (int j_ = 0; j_ < 8; ++j_) nxt[j_] = act ? *(const f32x4*)(wl + (size_t)(16 * (t_) + 2 * j_) * (3 * DM)) : (f32x4){0.f, 0.f, 0.f, 0.f}; } while (0)
    MOD_LOAD(0);
    for (int ch = 0; ch < 8; ++ch) {
        const int d0 = wave * 512 + ch * 64;
#pragma unroll
        for (int b = 0; b < 20; ++b) { const float c = b < 4 ? cp[b * DM + d0 + lane] : cs[(b - 4) * DM + d0 + lane]; sl[lane * 20 + b] = c / (1.0f + expf(-c)); }
        LDS_WAIT(); asm volatile("" ::: "memory");
        for (int rb = 0; rb < 4; ++rb) {
            f32x4 wv[8];
#pragma unroll
            for (int j = 0; j < 8; ++j) wv[j] = nxt[j];
            const int tn = ch * 4 + rb + 1;
            if (tn < 32) MOD_LOAD(tn);
#pragma unroll
            for (int j = 0; j < 8; ++j) { const LAS f32x4* sp = (const LAS f32x4*)(sl + (16 * rb + 2 * j + rs) * 20);
#pragma unroll
                for (int q = 0; q < 5; ++q) { const f32x4 s4 = sp[q];
#pragma unroll
                    for (int c = 0; c < 4; ++c) acc[q * 4 + c] += wv[j] * s4[c]; } }
        }
        LDS_WAIT(); asm volatile("" ::: "memory");
    }
#undef MOD_LOAD
#pragma unroll
    for (int b = 0; b < 20; ++b)
#pragma unroll
        for (int c = 0; c < 4; ++c) acc[b][c] += __shfl_down(acc[b][c], 24);
    LAS float* red = (LAS float*)(lds + 65536 + wave * 7680);
    if (lane < 24) {
#pragma unroll
        for (int b = 0; b < 20; ++b) *(LAS f32x4*)(red + b * 96 + 4 * lane) = acc[b]; }
    __syncthreads();
    float* modf = (float*)(a.ws + WS_MODF);
    for (int idx = tid; idx < 20 * 96; idx += NWAVES * 64) { float s = 0.f;
#pragma unroll
        for (int w = 0; w < 8; ++w) s += ((LAS float*)(lds + 65536 + w * 7680))[idx];
        const int b = idx / 96, e = idx % 96; modf[(size_t)(l * 20 + b) * (3 * DM) + e0 + e] = s + a.in[8][(size_t)l * 3 * DM + e0 + e]; }
    __syncthreads();
}
__device__ __forceinline__ void p0_prologue(const Args& a, LAS unsigned char* lds, int G, int bid, int tid, int lane, int wave) {
    for (int it = bid; it < 256; it += G) p0_mod_item(a, lds, it, tid, lane, wave);
    VM_WAIT(); __syncthreads();
    if (wave == 0 && lane == 0) { __builtin_amdgcn_fence(__ATOMIC_RELEASE, "agent"); VM_WAIT(); __hip_atomic_fetch_add((unsigned*)(a.ws + WS_CTL) + CW_MOD, 1u, __ATOMIC_RELAXED, __HIP_MEMORY_SCOPE_AGENT); }
    LAS float* scr = (LAS float*)(lds + (wave < 7 ? wave * 16640 : 135168));
    const int gw = bid * NWAVES + wave, NGW = G * NWAVES;
    constexpr int NB_IN = (IN_DIM + 63) / 64, I_IN = 64 * NB_IN, I_OUT = 128 * 64, I_P = 8 * 8;
    constexpr int NITEMS = 2 * I_IN + 2 * I_OUT + 8 * I_P;
#define P0_DECODE(d, it_) do { int r = (it_); \
        if (r < 2 * I_IN) { const int l = r / I_IN; r -= l * I_IN; const int nb = 2 * (r / 128) + (r & 1), kb = 4 * ((r >> 3) & 15) + ((r >> 1) & 3); d = TItem{a.in[9] + (size_t)l * DM * IN_DIM, (bf16*)(a.ws + WS_WIN + l * WIN_L), nullptr, IN_DIM, DM, 64 * kb, 64 * nb, IN_DIM - 64 * nb < 64 ? IN_DIM - 64 * nb : 64}; } \
        else { r -= 2 * I_IN; if (r < 2 * I_OUT) { const int l = r / I_OUT; r -= l * I_OUT; const int nb = 2 * (r / 256) + (r & 1), kb = 4 * ((r >> 3) & 31) + ((r >> 1) & 3); d = TItem{a.in[18] + (size_t)l * DIN * DM, (bf16*)(a.ws + WS_WOUT + l * WOUT_L), a.in[17] + (size_t)l * WSSD, DM, DIN, 64 * kb, 64 * nb, 64}; } \
               else { r -= 2 * I_OUT; const int lg = r / I_P; r -= lg * I_P; d = TItem{a.in[10] + (size_t)lg * 512 * 512, (bf16*)(a.ws + WS_WP) + (size_t)lg * 512 * 512, nullptr, 512, 512, 64 * (r / 8), 64 * (r % 8), 64}; } } } while (0)
    { int it = gw; TItem d{}; float nx[64];
      if (it < NITEMS) { P0_DECODE(d, it); p0_titem_load(d, nx, lane); }
      while (it < NITEMS) {
          float cur[64];
#pragma unroll
          for (int i = 0; i < 64; ++i) cur[i] = nx[i];
          const TItem dc = d; const int itn = it + NGW;
          if (itn < NITEMS) { P0_DECODE(d, itn); p0_titem_load(d, nx, lane); }
          p0_titem_finish(dc, cur, scr, lane);
          it = itn; } }
#undef P0_DECODE
    for (int i = bid * NWAVES * 64 + tid; i < 2 * (NPAD - IN_DIM) * (DM / 8); i += G * NWAVES * 64) { const int l = i / ((NPAD - IN_DIM) * (DM / 8)), r = i % ((NPAD - IN_DIM) * (DM / 8));
        *(GAS v4u*)((bf16*)(a.ws + WS_WIN + l * WIN_L) + (size_t)IN_DIM * DM + (size_t)r * 8) = (v4u){0u, 0u, 0u, 0u}; }
}

__device__ __forceinline__ void row_stats(const f32x4 (&v)[16], float& mean, float& rstd) {
    float s = 0.f;
#pragma unroll
    for (int j = 0; j < 16; ++j) s += (v[j].x + v[j].y) + (v[j].z + v[j].w);
    mean = wave_sum(s) * (1.f / DM); float q = 0.f;
#pragma unroll
    for (int j = 0; j < 16; ++j) { const f32x4 d = v[j] - mean; q += (d.x * d.x + d.y * d.y) + (d.z * d.z + d.w * d.w); }
    rstd = 1.f / sqrtf(wave_sum(q) * (1.f / DM) + LN_EPS);
}
__device__ __forceinline__ int batch_of(int m) { return m < MP ? (m >> 11) : NBP + ((m - MP) >> 5); }
template <typename VP>
__device__ __forceinline__ void mod_row_to_bf16(const f32x4 (&v)[16], VP sh4, VP sc4, bf16* hrow, int lane) {
    float mean, rstd; row_stats(v, mean, rstd);
#pragma unroll
    for (int j = 0; j < 16; ++j) { const f32x4 sh = sh4[lane + 64 * j], sc = sc4[lane + 64 * j];
        const f32x4 o = (v[j] - mean) * rstd * (sc + 1.0f) + sh;
        ((GAS v2u*)hrow)[lane + 64 * j] = (v2u){pk2(o.x, o.y), pk2(o.z, o.w)};
        if ((j & 3) == 3) asm volatile("" ::: "memory"); }
}
__device__ __forceinline__ void lds_fill_vec(LAS unsigned char* lds, int slot, const float* src, int tid) {
#pragma unroll
    for (int i = 0; i < DM / 4 / (NWAVES * 64); ++i) ((LAS f32x4*)(lds + slot * 16384))[tid + i * NWAVES * 64] = ((const f32x4*)src)[tid + i * NWAVES * 64];
}
__device__ __forceinline__ void phase_a(const Args& a, LAS unsigned char* lds, int G, int bid, int lane, int wave) {
    const int gw = bid * NWAVES + wave, NGW = G * NWAVES;
    const float* modf = (const float*)(a.ws + WS_MODF); bf16* H = (bf16*)(a.ws + WS_H);
    if (G == 256) {
        { const float* md = modf + (size_t)(bid >> 6) * 3 * DM; const int tid = wave * 64 + lane;
          lds_fill_vec(lds, 0, md, tid); lds_fill_vec(lds, 1, md + DM, tid); }
        LDS_WAIT(); __syncthreads();
        const LAS f32x4* shl = (const LAS f32x4*)lds; const LAS f32x4* scl = (const LAS f32x4*)(lds + 16384);
        const int nrow = wave < 2 ? 5 : 4;
#define A_ROW(k) ((k) < 4 ? 32 * bid + wave + 8 * (k) : MP + 2 * bid + wave)
#define A_SRC(m) ((m) < MP ? a.in[0] + (size_t)(m) * DM : a.in[1] + (size_t)((m) - MP) * DM)
        f32x4 nx[16];
        { const float* xr = A_SRC(A_ROW(0));
#pragma unroll
          for (int j = 0; j < 16; ++j) nx[j] = ((const f32x4*)xr)[lane + 64 * j]; }
        for (int k = 0; k < 4; ++k) {
            const int m = A_ROW(k);
            f32x4 v[16];
#pragma unroll
            for (int j = 0; j < 16; ++j) v[j] = nx[j];
            if (k + 1 < nrow) { const int mn = A_ROW(k + 1); const float* xr = A_SRC(mn);
#pragma unroll
                for (int j = 0; j < 16; ++j) nx[j] = ((const f32x4*)xr)[lane + 64 * j]; }
            mod_row_to_bf16(v, shl, scl, H + (size_t)m * DM, lane);
        }
        if (wave < 2) { const int m = A_ROW(4); const float* md = modf + (size_t)batch_of(m) * 3 * DM;
            mod_row_to_bf16(nx, (const f32x4*)md, (const f32x4*)(md + DM), H + (size_t)m * DM, lane); }
#undef A_ROW
#undef A_SRC
        return;
    }
    f32x4 nx[16]; int m = gw;
    if (m < M) { const float* xr = m < MP ? a.in[0] + (size_t)m * DM : a.in[1] + (size_t)(m - MP) * DM;
#pragma unroll
        for (int j = 0; j < 16; ++j) nx[j] = ((const f32x4*)xr)[lane + 64 * j]; }
    while (m < M) {
        f32x4 v[16];
#pragma unroll
        for (int j = 0; j < 16; ++j) v[j] = nx[j];
        const int mn = m + NGW;
        if (mn < M) { const float* xr = mn < MP ? a.in[0] + (size_t)mn * DM : a.in[1] + (size_t)(mn - MP) * DM;
#pragma unroll
            for (int j = 0; j < 16; ++j) nx[j] = ((const f32x4*)xr)[lane + 64 * j]; }
        const float* md = modf + (size_t)batch_of(m) * 3 * DM;
        mod_row_to_bf16(v, (const f32x4*)md, (const f32x4*)(md + DM), H + (size_t)m * DM, lane);
        m = mn;
    }
}
template <typename LP, typename VP>
__device__ __forceinline__ void g_process(f32x4 (&v)[16], LP lg4, LP lb4, float* xrow, bool do_h, VP sh4, VP sc4, bf16* hrow, int lane) {
    float mean, rstd; row_stats(v, mean, rstd);
#pragma unroll
    for (int j = 0; j < 16; ++j) { v[j] = (v[j] - mean) * rstd * lg4[lane + 64 * j] + lb4[lane + 64 * j];
        ((GAS f32x4*)xrow)[lane + 64 * j] = v[j];
        if ((j & 3) == 3) asm volatile("" ::: "memory"); }
    if (do_h) mod_row_to_bf16(v, sh4, sc4, hrow, lane);
}
template <bool EVEN>
__device__ __forceinline__ void g_prompt_rows(const Args& a, LAS unsigned char* lds, int l, int G, int bid, int lane, int wave) {
    const int gw = bid * NWAVES + wave, NGW = G * NWAVES;
    const float* modf = (const float*)(a.ws + WS_MODF); bf16* H = (bf16*)(a.ws + WS_H);
    const bf16* R = (const bf16*)(a.ws + WS_R); float* xo = l == 0 ? (float*)(a.ws + WS_X1) : a.out + O_Y;
    const LAS f32x4* lgl = (const LAS f32x4*)lds; const LAS f32x4* lbl = (const LAS f32x4*)(lds + 16384); const LAS f32x4* shl = (const LAS f32x4*)(lds + 32768); const LAS f32x4* scl = (const LAS f32x4*)(lds + 49152);
    v2u nx[16];
    const int nrow = EVEN ? (wave < 2 ? 3 : (wave < 4 ? 5 : 4)) : (MP - gw + NGW - 1) / NGW;
#define G_ROW(k) (EVEN ? 32 * bid + ((k) == 4 ? 24 + (wave - 2) : wave + 8 * (k)) : gw + (k) * NGW)
    int k = 0;
    if (k < nrow) { const int m = G_ROW(0);
#pragma unroll
        for (int j = 0; j < 16; ++j) nx[j] = *(const v2u*)(R + (size_t)m * DM + 4 * (lane + 64 * j)); }
    for (; k < nrow; ++k) {
        const int m = G_ROW(k);
        f32x4 v[16];
#pragma unroll
        for (int j = 0; j < 16; ++j) v[j] = pg8::bf4_to_f32(nx[j].x, nx[j].y);
        if (k + 1 < nrow) { const int mn = G_ROW(k + 1);
#pragma unroll
            for (int j = 0; j < 16; ++j) nx[j] = *(const v2u*)(R + (size_t)mn * DM + 4 * (lane + 64 * j)); }
        if (EVEN) g_process(v, lgl, lbl, xo + (size_t)m * DM, l == 0, shl, scl, H + (size_t)m * DM, lane);
        else { const float* lg = a.in[19] + (size_t)l * DM; const float* lb = a.in[20] + (size_t)l * DM; const float* md = modf + (size_t)(NBT + batch_of(m)) * 3 * DM;
            g_process(v, (const f32x4*)lg, (const f32x4*)lb, xo + (size_t)m * DM, l == 0, (const f32x4*)md, (const f32x4*)(md + DM), H + (size_t)m * DM, lane); } }
#undef G_ROW
}
__device__ __forceinline__ void phase_g(const Args& a, LAS unsigned char* lds, int l, int G, int bid, int lane, int wave) {
    const int gw = bid * NWAVES + wave, NGW = G * NWAVES;
    const float* modf = (const float*)(a.ws + WS_MODF); bf16* H = (bf16*)(a.ws + WS_H);
    const bf16* R = (const bf16*)(a.ws + WS_R); float* xo = l == 0 ? (float*)(a.ws + WS_X1) : a.out + O_Y;
    const float* lg = a.in[19] + (size_t)l * DM; const float* lb = a.in[20] + (size_t)l * DM;
    const bool even = (G == 256);
    const LAS f32x4* lgl = (const LAS f32x4*)lds; const LAS f32x4* lbl = (const LAS f32x4*)(lds + 16384); const LAS f32x4* shl = (const LAS f32x4*)(lds + 32768); const LAS f32x4* scl = (const LAS f32x4*)(lds + 49152);
    if (even) {
        const int tid = wave * 64 + lane;
        lds_fill_vec(lds, 0, lg, tid); lds_fill_vec(lds, 1, lb, tid);
        if (l == 0) { const float* md = modf + (size_t)(NBT + (bid >> 6)) * 3 * DM; lds_fill_vec(lds, 2, md, tid); lds_fill_vec(lds, 3, md + DM, tid); }
        LDS_WAIT(); __syncthreads();
    }
    if (even ? wave < 2 : gw < MS) {
        const int m = even ? MP + 2 * bid + wave : MP + gw; f32x4 v[16];
        const float* xr = (l == 0 ? a.in[1] : (const float*)(a.ws + WS_X1) + (size_t)MP * DM) + (size_t)(m - MP) * DM;
        const float* gr = modf + (size_t)(l * NBT + batch_of(m)) * 3 * DM + 2 * DM; const float* sl = (const float*)(a.ws + WS_SLAB) + (size_t)(m - MP) * DM;
#pragma unroll
        for (int j2 = 0; j2 < 16; j2 += 2) { f32x4 t[2][8], xv[2], gv[2];
#pragma unroll
            for (int jj = 0; jj < 2; ++jj) { xv[jj] = ((const f32x4*)xr)[lane + 64 * (j2 + jj)]; gv[jj] = ((const f32x4*)gr)[lane + 64 * (j2 + jj)];
#pragma unroll
                for (int k2 = 0; k2 < 8; ++k2) t[jj][k2] = ((const f32x4*)(sl + (size_t)k2 * MS * DM))[lane + 64 * (j2 + jj)]; }
#pragma unroll
            for (int jj = 0; jj < 2; ++jj) { const f32x4 o = ((t[jj][0] + t[jj][1]) + (t[jj][2] + t[jj][3])) + ((t[jj][4] + t[jj][5]) + (t[jj][6] + t[jj][7]));
                v[j2 + jj] = xv[jj] * ALPHA + gv[jj] * o; }
            asm volatile("" ::: "memory"); }
        const float* md = modf + (size_t)(NBT + batch_of(m)) * 3 * DM;
        if (even) g_process(v, lgl, lbl, xo + (size_t)m * DM, l == 0, (const f32x4*)md, (const f32x4*)(md + DM), H + (size_t)m * DM, lane);
        else g_process(v, (const f32x4*)lg, (const f32x4*)lb, xo + (size_t)m * DM, l == 0, (const f32x4*)md, (const f32x4*)(md + DM), H + (size_t)m * DM, lane);
    }
    if (even) g_prompt_rows<true>(a, lds, l, G, bid, lane, wave); else g_prompt_rows<false>(a, lds, l, G, bid, lane, wave);
}
__device__ __forceinline__ f32x4 ld_bf4(const bf16* p) { const v2u q = *(const v2u*)p; return (f32x4){bf2f((unsigned short)(q.x & 0xffffu)), bf2f((unsigned short)(q.x >> 16)), bf2f((unsigned short)(q.y & 0xffffu)), bf2f((unsigned short)(q.y >> 16))}; }
__device__ __forceinline__ f32x4 pool_hist(const bf16* pc, const float* st, bool samp, int t) {
    if (t >= 0) return ld_bf4(pc + (size_t)t * WPOOL);
    if (samp) return *(const f32x4*)(st + (size_t)(15 + t) * WPOOL);
    return (f32x4){0.f, 0.f, 0.f, 0.f};
}
__device__ __forceinline__ void c1_elem(const Args& a, int l, int e, v2u& out, bf16*& dst) {
    const int c4 = e % 2560, r = (e / 2560) & 31, ss = e / (2560 * 32);
    const bool samp = ss >= 4; const int b = samp ? ss - 4 : ss, m0 = samp ? MP + b * DSEQ : b * SEQ;
    if (c4 < 512) { const int j0 = 4 * c4, w = 2 << (j0 >> 9);
        const bf16* pc = (const bf16*)(a.ws + WS_UP) + (size_t)m0 * WPOOL + j0; const float* st = a.in[2] + (size_t)(l * NBS + b) * 15 * WPOOL + j0;
        const f32x4 u = ld_bf4(pc + (size_t)r * WPOOL); f32x4 S = u;
        for (int i = 1; i < w; ++i) S += pool_hist(pc, st, samp, r - i);
        const int pos = (samp ? PAST : 0) + r; const float cnt = (float)(pos + 1 < w ? pos + 1 : w);
        const f32x4 p = S / cnt - u;
        out = (v2u){pk2(p.x, p.y), pk2(p.z, p.w)}; dst = (bf16*)(a.ws + WS_POOLED) + (size_t)(m0 + r) * WPOOL + j0;
    } else { const int j0 = 4 * (c4 - 512);
        const float* cw = a.in[12] + (size_t)l * 4 * CONVD + j0; const bf16* pc = (const bf16*)(a.ws + WS_XP) + (size_t)m0 * CONVD + j0; const float* st = a.in[3] + (size_t)(l * NBS + b) * 3 * CONVD + j0;
        f32x4 o = *(const f32x4*)(a.in[13] + (size_t)l * CONVD + j0);
#pragma unroll
        for (int k = 0; k < 4; ++k) { const int t = r - 3 + k;
            const f32x4 x = t >= 0 ? ld_bf4(pc + (size_t)t * CONVD) : (samp ? *(const f32x4*)(st + (size_t)(3 + t) * CONVD) : (f32x4){0.f, 0.f, 0.f, 0.f});
            o += *(const f32x4*)(cw + (size_t)k * CONVD) * x; }
        o.x = silu(o.x); o.y = silu(o.y); o.z = silu(o.z); o.w = silu(o.w);
        out = (v2u){pk2(o.x, o.y), pk2(o.z, o.w)}; dst = (bf16*)(a.ws + WS_XBC) + (size_t)(m0 + r) * CONVD + j0;
    }
}
__device__ __forceinline__ void c_zero_ssq(const Args& a, int G, int bid, int tid) {
    for (int i = bid * NWAVES * 64 + tid; i < M * 16; i += G * NWAVES * 64) ((GAS f32x4*)(a.ws + WS_YG))[i] = (f32x4){0.f, 0.f, 0.f, 0.f};
}
__device__ __forceinline__ void c1_range(const Args& a, int l, int e_lo, int e_hi, int first, int stride) {
    for (int e0 = e_lo + first; e0 < e_hi; e0 += 4 * stride) { v2u res[4]; bf16* dst[4];
#pragma unroll
        for (int u4 = 0; u4 < 4; ++u4) { const int e = e0 + u4 * stride; dst[u4] = nullptr; res[u4] = (v2u){0u, 0u};
            if (e < e_hi) c1_elem(a, l, e, res[u4], dst[u4]); }
#pragma unroll
        for (int u4 = 0; u4 < 4; ++u4) if (dst[u4]) *(GAS v2u*)dst[u4] = res[u4]; }
}
constexpr int C1_PROMPT_ELEMS = 4 * 32 * 2560, C1_ALL_ELEMS = 20 * 32 * 2560, C_ITEMS2 = 252 * 3, C_ITEMS1 = C1_PROMPT_ELEMS / 2048, C_QITEMS = C_ITEMS2 + C_ITEMS1;
__device__ __forceinline__ void c_sample_elems(const Args& a, int l, int G, int bid, int tid) { c1_range(a, l, C1_PROMPT_ELEMS, C1_ALL_ELEMS, bid * NWAVES * 64 + tid, G * NWAVES * 64); }
__device__ __forceinline__ void c_prompt_item(const Args& a, int l, int it, int tid) {
    if (it >= C_ITEMS2) { c1_range(a, l, (it - C_ITEMS2) * 2048, (it - C_ITEMS2 + 1) * 2048, tid, NWAVES * 64); return; }
    {
        const int sq = it / 3, cblk = it % 3, b = sq / 63, t0 = 32 * (1 + sq % 63), m0 = b * SEQ + t0;
        if (cblk == 0) {
            const int j0 = 4 * tid, w = 2 << (j0 >> 9);
            const bf16* p0 = (const bf16*)(a.ws + WS_UP) + (size_t)m0 * WPOOL + j0;
            bf16* po = (bf16*)(a.ws + WS_POOLED) + (size_t)m0 * WPOOL + j0;
            f32x4 S = (f32x4){0.f, 0.f, 0.f, 0.f};
            for (int i = 1; i < w; ++i) S += ld_bf4(p0 - (size_t)i * WPOOL);
            const float inv = 1.0f / (float)w;
            f32x4 nu[8], no[8];
#pragma unroll
            for (int k = 0; k < 8; ++k) { nu[k] = ld_bf4(p0 + (size_t)k * WPOOL); no[k] = ld_bf4(p0 + (ptrdiff_t)(k - w + 1) * WPOOL); }
#pragma unroll
            for (int r0 = 0; r0 < 32; r0 += 8) { f32x4 u[8], o[8];
#pragma unroll
                for (int k = 0; k < 8; ++k) { u[k] = nu[k]; o[k] = no[k]; }
                if (r0 + 8 < 32) {
#pragma unroll
                    for (int k = 0; k < 8; ++k) { nu[k] = ld_bf4(p0 + (size_t)(r0 + 8 + k) * WPOOL); no[k] = ld_bf4(p0 + (ptrdiff_t)(r0 + 8 + k - w + 1) * WPOOL); } }
#pragma unroll
                for (int k = 0; k < 8; ++k) { S += u[k]; const f32x4 p = S * inv - u[k];
                    *(GAS v2u*)(po + (size_t)(r0 + k) * WPOOL) = (v2u){pk2(p.x, p.y), pk2(p.z, p.w)}; S -= o[k]; } }
        } else {
            const int j0 = (cblk - 1) * 4096 + 8 * tid;
            const float* cw = a.in[12] + (size_t)l * 4 * CONVD + j0; const float* cb = a.in[13] + (size_t)l * CONVD + j0;
            f32x4 wt[4][2], bs[2];
#pragma unroll
            for (int hh = 0; hh < 2; ++hh) { bs[hh] = *(const f32x4*)(cb + 4 * hh);
#pragma unroll
                for (int k = 0; k < 4; ++k) wt[k][hh] = *(const f32x4*)(cw + (size_t)k * CONVD + 4 * hh); }
            const bf16* pc = (const bf16*)(a.ws + WS_XP) + (size_t)m0 * CONVD + j0;
            bf16* xo = (bf16*)(a.ws + WS_XBC) + (size_t)m0 * CONVD + j0;
            v4u h3 = *(const v4u*)(pc - 3 * (size_t)CONVD), h2 = *(const v4u*)(pc - 2 * (size_t)CONVD), h1 = *(const v4u*)(pc - (size_t)CONVD);
            f32x4 p3[2] = {pg8::bf4_to_f32(h3.x, h3.y), pg8::bf4_to_f32(h3.z, h3.w)}, p2[2] = {pg8::bf4_to_f32(h2.x, h2.y), pg8::bf4_to_f32(h2.z, h2.w)}, p1[2] = {pg8::bf4_to_f32(h1.x, h1.y), pg8::bf4_to_f32(h1.z, h1.w)};
            v4u nc[4];
#pragma unroll
            for (int k = 0; k < 4; ++k) nc[k] = *(const v4u*)(pc + (size_t)k * CONVD);
#pragma unroll
            for (int r0 = 0; r0 < 32; r0 += 4) { v4u cq[4];
#pragma unroll
                for (int k = 0; k < 4; ++k) cq[k] = nc[k];
                if (r0 + 4 < 32) {
#pragma unroll
                    for (int k = 0; k < 4; ++k) nc[k] = *(const v4u*)(pc + (size_t)(r0 + 4 + k) * CONVD); }
#pragma unroll
                for (int k = 0; k < 4; ++k) { const f32x4 cur[2] = {pg8::bf4_to_f32(cq[k].x, cq[k].y), pg8::bf4_to_f32(cq[k].z, cq[k].w)}; unsigned ow[4];
#pragma unroll
                    for (int hh = 0; hh < 2; ++hh) { f32x4 o = wt[0][hh] * p3[hh] + wt[1][hh] * p2[hh] + wt[2][hh] * p1[hh] + wt[3][hh] * cur[hh] + bs[hh];
                        o.x = silu(o.x); o.y = silu(o.y); o.z = silu(o.z); o.w = silu(o.w);
                        ow[2 * hh] = pk2(o.x, o.y); ow[2 * hh + 1] = pk2(o.z, o.w);
                        p3[hh] = p2[hh]; p2[hh] = p1[hh]; p1[hh] = cur[hh]; }
                    *(GAS v4u*)(xo + (size_t)(r0 + k) * CONVD) = (v4u){ow[0], ow[1], ow[2], ow[3]}; } }
        }
    }
}
typedef short s16x4 __attribute__((ext_vector_type(4)));
typedef short s16x8 __attribute__((ext_vector_type(8)));
constexpr int SSD_XX = 0, SSD_BS = 32768, SSD_CS = 49152, SSD_HB = 65536, SSD_TAB = 135168;
__device__ __forceinline__ unsigned off_b(unsigned row, unsigned ch) { return 256u * row + 16u * (ch ^ (((row & 3u) << 2) | ((row >> 2) & 3u))); }
__device__ __forceinline__ s16x8 tr_frag(LAS unsigned char* img, int lane, int c, int ks) {
    const unsigned g = (unsigned)lane >> 4, qq = ((unsigned)lane & 15u) >> 2, pp = (unsigned)lane & 3u;
    const unsigned a0 = off_b(32u * ks + 8u * g + qq, 2u * c + (pp >> 1)) + 8u * (pp & 1u), a1 = off_b(32u * ks + 8u * g + 4u + qq, 2u * c + (pp >> 1)) + 8u * (pp & 1u);
    const s16x4 lo = __builtin_amdgcn_ds_read_tr16_b64_v4i16((LAS s16x4*)(img + a0)), hi = __builtin_amdgcn_ds_read_tr16_b64_v4i16((LAS s16x4*)(img + a1));
    return __builtin_shufflevector(lo, hi, 0, 1, 2, 3, 4, 5, 6, 7);
}
__device__ __forceinline__ s16x8 row_frag(LAS unsigned char* img, int row, int ch) { return *(const LAS s16x8*)(img + off_b((unsigned)row, (unsigned)ch)); }
__device__ __forceinline__ float ex2(float x) { return __builtin_amdgcn_exp2f(x); }
template <int CTRL, int RM, int BMK> __device__ __forceinline__ float dpp0(float v) { return __builtin_bit_cast(float, __builtin_amdgcn_update_dpp(0, __builtin_bit_cast(int, v), CTRL, RM, BMK, true)); }
__device__ __forceinline__ float wave_scan(float x) {
    float v = x + dpp0<0x111, 0xf, 0xf>(x); v += dpp0<0x112, 0xf, 0xf>(x); v += dpp0<0x113, 0xf, 0xf>(x);
    v += dpp0<0x114, 0xf, 0xe>(v); v += dpp0<0x118, 0xf, 0xc>(v); v += dpp0<0x142, 0xa, 0xf>(v); v += dpp0<0x143, 0xc, 0xf>(v);
    return v;
}
__device__ __forceinline__ unsigned scale_pk(unsigned v, float w) { return pk2(bf2f((unsigned short)(v & 0xffffu)) * w, bf2f((unsigned short)(v >> 16)) * w); }

__device__ __forceinline__ void ssd_unit(const Args& a, LAS unsigned char* lds, int l, int unit0, int nunits, int tid) {
    int lane = tid & 63, r16 = lane & 15, q = lane >> 4; const int wave = __builtin_amdgcn_readfirstlane(tid >> 6);
    const int lt = wave & 3, ph = wave >> 2;
    const bool samp = unit0 >= NBP * 48;
    const int nchunk = samp ? 1 : SEQ / 64, vr = samp ? DSEQ : 64;
#define SSD_DECODE(u_, b_, hp_, mb_) do { const int u2_ = samp ? (u_) - NBP * 48 : (u_); b_ = u2_ / 48; hp_ = u2_ % 48; mb_ = samp ? MP + b_ * DSEQ : b_ * SEQ; } while (0)
    int b, hp, mbase; SSD_DECODE(unit0, b, hp, mbase);
    const bf16* xbc = (const bf16*)(a.ws + WS_XBC); const bf16* sz = (const bf16*)(a.ws + WS_SZ); bf16* yg = (bf16*)(a.ws + WS_MIXED) + WPOOL;
    int xrow = tid >> 3, xch = tid & 7, brow = tid >> 4, bch = tid & 15;
    int lrow = 16 * lt + r16;
    v4u xr[2], br[2], cr[2]; v2u zr[2][2]; float dtl = 0.f;
    const v4u zero4 = (v4u){0u, 0u, 0u, 0u};
#define SSD_LOAD(c, MB_, HP_) do { const size_t m0_ = (size_t)(MB_) + 64 * (size_t)(c); const int h0_ = 2 * (HP_), g_ = (HP_) / 6; \
        { const bf16* xp_ = xbc + (m0_ + (xrow < vr ? xrow : 0)) * CONVD + h0_ * HD + 8 * xch; xr[0] = *(const v4u*)xp_; xr[1] = *(const v4u*)(xp_ + HD); } \
        _Pragma("unroll") for (int i_ = 0; i_ < 2; ++i_) { const int row_ = brow + 32 * i_; const bf16* rp_ = xbc + (m0_ + (row_ < vr ? row_ : 0)) * CONVD + WSSD + g_ * NS + 8 * bch; \
            br[i_] = *(const v4u*)rp_; cr[i_] = *(const v4u*)(rp_ + 1024); } \
        _Pragma("unroll") for (int hd_ = 0; hd_ < 2; ++hd_) _Pragma("unroll") for (int j_ = 0; j_ < 2; ++j_) \
            zr[hd_][j_] = *(const v2u*)(sz + (m0_ + (lrow < vr ? lrow : 0)) * WSSD + (h0_ + hd_) * HD + 16 * (2 * ph + j_) + 4 * q); \
        if (wave < 2) dtl = ((const float*)(a.ws + WS_DTV) + (size_t)(h0_ + (wave & 1)) * M)[m0_ + (lane < vr ? lane : 0)]; } while (0)     \

#define SSD_LOADH(B_, HP_) do { _Pragma("unroll") for (int hd_ = 0; hd_ < 2; ++hd_) _Pragma("unroll") for (int i_ = 0; i_ < 2; ++i_) _Pragma("unroll") for (int j_ = 0; j_ < 2; ++j_) \
        Hin[hd_][i_][j_] = samp ? *(const f32x4*)(a.in[4] + ((size_t)((l * NBS + (B_)) * NH + 2 * (HP_) + hd_) * HD + 16 * (2 * ph + j_) + r16) * NS + 16 * (2 * lt + i_) + 4 * q) : (f32x4){0.f, 0.f, 0.f, 0.f}; } while (0)
#define SSD_SCAN(i_) do { if (wave < 2) { LAS float* tb_ = (LAS float*)(lds + SSD_TAB + (2 * (i_) + wave) * 1024); const float d_ = lane < vr ? dtl : 0.f; \
            const float cs_ = wave_scan(d_ * (wave == 0 ? A2[0] : A2[1])); const float tot_ = __builtin_bit_cast(float, __builtin_amdgcn_readlane(__builtin_bit_cast(int, cs_), 63)); \
            const float c31_ = __builtin_bit_cast(float, __builtin_amdgcn_readlane(__builtin_bit_cast(int, cs_), 31)); \
            tb_[lane] = cs_; tb_[64 + lane] = d_; tb_[128 + lane] = d_ * ex2(tot_ - cs_); tb_[192 + lane] = lane < 32 ? d_ * ex2(c31_ - cs_) : 0.f; } } while (0)
#define SSD_STAGE_WRITE(i_) do { \
        _Pragma("unroll") for (int hd_ = 0; hd_ < 2; ++hd_) { const float w_ = ((const LAS float*)(lds + SSD_TAB + (2 * (i_) + hd_) * 1024))[128 + xrow]; const v4u x_ = xrow < vr ? xr[hd_] : zero4; \
            *(LAS v4u*)(lds + SSD_XX + hd_ * 16384 + off_b(xrow, xch)) = x_; \
            *(LAS v4u*)(lds + SSD_XX + hd_ * 16384 + off_b(xrow, 8 + xch)) = (v4u){scale_pk(x_.x, w_), scale_pk(x_.y, w_), scale_pk(x_.z, w_), scale_pk(x_.w, w_)}; } \
        _Pragma("unroll") for (int i2_ = 0; i2_ < 2; ++i2_) { const bool ok_ = brow + 32 * i2_ < vr; \
            *(LAS v4u*)(lds + SSD_BS + off_b(brow + 32 * i2_, bch)) = ok_ ? br[i2_] : zero4; *(LAS v4u*)(lds + SSD_CS + off_b(brow + 32 * i2_, bch)) = ok_ ? cr[i2_] : zero4; } } while (0)
#define SSD_BAR() do { asm volatile("s_waitcnt lgkmcnt(0)" ::: "memory"); __builtin_amdgcn_s_barrier(); asm volatile("" ::: "memory"); } while (0)
    f32x4 Hacc[2][2][2], Hin[2][2][2];
#define SSD_HWRITE(i_) do { _Pragma("unroll") for (int hd_ = 0; hd_ < 2; ++hd_) { LAS unsigned char* hb_ = lds + SSD_HB + (2 * (i_) + hd_) * 16384; \
        _Pragma("unroll") for (int i2_ = 0; i2_ < 2; ++i2_) _Pragma("unroll") for (int j2_ = 0; j2_ < 2; ++j2_) { const f32x4 v_ = Hacc[hd_][i2_][j2_]; \
            *(LAS v2u*)(hb_ + off_b(16 * (2 * ph + j2_) + r16, 2 * (2 * lt + i2_) + (q >> 1)) + 8 * (q & 1)) = (v2u){pk2(v_.x, v_.y), pk2(v_.z, v_.w)}; } } } while (0)
    SSD_LOAD(0, mbase, hp); SSD_LOADH(b, hp);
    for (int ui = 0; ui < nunits; ++ui) {
    asm volatile("" : "+v"(lane), "+v"(r16), "+v"(q), "+v"(xrow), "+v"(xch), "+v"(brow), "+v"(bch), "+v"(lrow));
    const int h0 = 2 * hp, g = hp / 6;
    float A2[2], Dk[2];
#pragma unroll
    for (int hd = 0; hd < 2; ++hd) { A2[hd] = -expf(a.in[15][l * NH + h0 + hd]) * 1.44269504089f; Dk[hd] = a.in[16][l * NH + h0 + hd]; }
    float* ssq = (float*)(a.ws + WS_YG) + g * 8 + hp % 6;
#pragma unroll
    for (int hd = 0; hd < 2; ++hd)
#pragma unroll
        for (int i = 0; i < 2; ++i)
#pragma unroll
            for (int j = 0; j < 2; ++j) Hacc[hd][i][j] = Hin[hd][i][j];
    v2u zc[2][2] = {{zr[0][0], zr[0][1]}, {zr[1][0], zr[1][1]}};
    SSD_SCAN(0); SSD_HWRITE(0);
    SSD_BAR();
    SSD_STAGE_WRITE(0);
    SSD_BAR();
    v2u ypk[2][2] = {{(v2u){0u, 0u}, (v2u){0u, 0u}}, {(v2u){0u, 0u}, (v2u){0u, 0u}}}; float ssk[2] = {0.f, 0.f};
    for (int c = 0; c < nchunk; ++c) {
        const bool more = c + 1 < nchunk;
        if (c > 0 && lrow < vr) {
#pragma unroll
            for (int hd = 0; hd < 2; ++hd)
#pragma unroll
                for (int j = 0; j < 2; ++j) *(GAS v2u*)(yg + ((size_t)mbase + 64 * (c - 1) + lrow) * DIN + (h0 + hd) * HD + 16 * (2 * ph + j) + 4 * q) = ypk[hd][j];
            if (q == 0) __hip_atomic_fetch_add(ssq + ((size_t)mbase + 64 * (c - 1) + lrow) * 64, ssk[0] + ssk[1], __ATOMIC_RELAXED, __HIP_MEMORY_SCOPE_AGENT); }
        if (more) SSD_LOAD(c + 1, mbase, hp);
        LAS unsigned char* hbc = lds + SSD_HB + 2 * (c & 1) * 16384; const LAS float* tb = (const LAS float*)(lds + SSD_TAB + 2 * (c & 1) * 1024);
#define SB() __builtin_amdgcn_sched_barrier(0)
        s16x8 cf[4]; float acl[2], cdv[2];
#pragma unroll
        for (int kk = 0; kk < 4; ++kk) cf[kk] = row_frag(lds + SSD_CS, lrow, 4 * kk + q);
        f32x4 acc[2][2] = {{(f32x4){0.f, 0.f, 0.f, 0.f}, (f32x4){0.f, 0.f, 0.f, 0.f}}, {(f32x4){0.f, 0.f, 0.f, 0.f}, (f32x4){0.f, 0.f, 0.f, 0.f}}};
#pragma unroll
        for (int hd = 0; hd < 2; ++hd) { s16x8 hf[2][4];
            SB();
            acl[hd] = tb[hd * 256 + lrow]; cdv[hd] = tb[hd * 256 + 63];
#pragma unroll
            for (int j = 0; j < 2; ++j)
#pragma unroll
                for (int kk = 0; kk < 4; ++kk) hf[j][kk] = row_frag(hbc + hd * 16384, 16 * (2 * ph + j) + r16, 4 * kk + q);
            SB();
#pragma unroll
            for (int kk = 0; kk < 4; ++kk)
#pragma unroll
                for (int j = 0; j < 2; ++j) acc[hd][j] = __builtin_amdgcn_mfma_f32_16x16x32_bf16(hf[j][kk], cf[kk], acc[hd][j], 0, 0, 0);
            const float el = ex2(acl[hd]); acc[hd][0] = acc[hd][0] * el; acc[hd][1] = acc[hd][1] * el; }
#pragma unroll
        for (int k2 = 0; k2 < 2; ++k2) if (k2 <= (lt >> 1)) {
            const int sx = 32 * k2 + 8 * (r16 >> 2) + (r16 & 3), s0 = 32 * k2 + 8 * q;
            s16x8 bx[4], by[4], xf[2][2];
            SB();
#pragma unroll
            for (int kk = 0; kk < 4; ++kk) { bx[kk] = row_frag(lds + SSD_BS, sx, 4 * kk + q); by[kk] = row_frag(lds + SSD_BS, sx + 4, 4 * kk + q); }
            SB();
            f32x4 gx = (f32x4){0.f, 0.f, 0.f, 0.f}, gy = gx;
#pragma unroll
            for (int kk = 0; kk < 4; ++kk) { gx = __builtin_amdgcn_mfma_f32_16x16x32_bf16(bx[kk], cf[kk], gx, 0, 0, 0); gy = __builtin_amdgcn_mfma_f32_16x16x32_bf16(by[kk], cf[kk], gy, 0, 0, 0); }
#pragma unroll
            for (int hd = 0; hd < 2; ++hd)
#pragma unroll
                for (int j = 0; j < 2; ++j) xf[hd][j] = tr_frag(lds + SSD_XX + hd * 16384, lane, 2 * ph + j, k2);
#pragma unroll
            for (int hd = 0; hd < 2; ++hd) { f32x4 mx, my;
                if (k2 != (lt >> 1)) {
                    const float rowf = ex2(acl[hd] - tb[hd * 256 + 31]);
                    const f32x4 c0 = *(const LAS f32x4*)(tb + hd * 256 + 192 + s0), c1 = *(const LAS f32x4*)(tb + hd * 256 + 192 + s0 + 4);
                    mx = gx * (c0 * rowf); my = gy * (c1 * rowf);
                } else {
                const f32x4 as0 = *(const LAS f32x4*)(tb + hd * 256 + s0), as1 = *(const LAS f32x4*)(tb + hd * 256 + s0 + 4), d0 = *(const LAS f32x4*)(tb + hd * 256 + 64 + s0), d1 = *(const LAS f32x4*)(tb + hd * 256 + 64 + s0 + 4);
#pragma unroll
                for (int e = 0; e < 4; ++e) { mx[e] = (s0 + e <= lrow) ? gx[e] * ex2(acl[hd] - as0[e]) * d0[e] : 0.f; my[e] = (s0 + 4 + e <= lrow) ? gy[e] * ex2(acl[hd] - as1[e]) * d1[e] : 0.f; }
                }
                const s16x8 gms = __builtin_bit_cast(s16x8, (v4u){pk2(mx[0], mx[1]), pk2(mx[2], mx[3]), pk2(my[0], my[1]), pk2(my[2], my[3])});
#pragma unroll
                for (int j = 0; j < 2; ++j) acc[hd][j] = __builtin_amdgcn_mfma_f32_16x16x32_bf16(xf[hd][j], gms, acc[hd][j], 0, 0, 0); }
        }
        v2u xwv[2][2]; s16x8 bt[2], xs[2][2];
        SB();
#pragma unroll
        for (int hd = 0; hd < 2; ++hd)
#pragma unroll
            for (int j = 0; j < 2; ++j) { const int p0 = 16 * (2 * ph + j) + 4 * q; xwv[hd][j] = *(const LAS v2u*)(lds + SSD_XX + hd * 16384 + off_b(lrow, p0 >> 3) + 2 * (p0 & 7)); xs[hd][j] = tr_frag(lds + SSD_XX + hd * 16384, lane, 4 + 2 * ph + j, 0); }
#pragma unroll
        for (int i = 0; i < 2; ++i) bt[i] = tr_frag(lds + SSD_BS, lane, 2 * lt + i, 0);
        SB();
#pragma unroll
        for (int hd = 0; hd < 2; ++hd) { float ss = 0.f;
#pragma unroll
            for (int j = 0; j < 2; ++j) { const v2u xw = xwv[hd][j];
                f32x4 y = acc[hd][j] + Dk[hd] * (f32x4){bf2f((unsigned short)(xw.x & 0xffffu)), bf2f((unsigned short)(xw.x >> 16)), bf2f((unsigned short)(xw.y & 0xffffu)), bf2f((unsigned short)(xw.y >> 16))};
                y = y * (f32x4){bf2f((unsigned short)(zc[hd][j].x & 0xffffu)), bf2f((unsigned short)(zc[hd][j].x >> 16)), bf2f((unsigned short)(zc[hd][j].y & 0xffffu)), bf2f((unsigned short)(zc[hd][j].y >> 16))};
                ss += (y.x * y.x + y.y * y.y) + (y.z * y.z + y.w * y.w);
                ypk[hd][j] = (v2u){pk2(y.x, y.y), pk2(y.z, y.w)}; }
            ss += __shfl_xor(ss, 16); ss += __shfl_xor(ss, 32); ssk[hd] = ss; }
#pragma unroll
        for (int hd = 0; hd < 2; ++hd) { const float cd = ex2(cdv[hd]);
#pragma unroll
            for (int i = 0; i < 2; ++i)
#pragma unroll
                for (int j = 0; j < 2; ++j) Hacc[hd][i][j] = Hacc[hd][i][j] * cd; }
#pragma unroll
        for (int hd = 0; hd < 2; ++hd)
#pragma unroll
            for (int i = 0; i < 2; ++i)
#pragma unroll
                for (int j = 0; j < 2; ++j) Hacc[hd][i][j] = __builtin_amdgcn_mfma_f32_16x16x32_bf16(bt[i], xs[hd][j], Hacc[hd][i][j], 0, 0, 0);
        SB();
#pragma unroll
        for (int i = 0; i < 2; ++i) bt[i] = tr_frag(lds + SSD_BS, lane, 2 * lt + i, 1);
#pragma unroll
        for (int hd = 0; hd < 2; ++hd)
#pragma unroll
            for (int j = 0; j < 2; ++j) xs[hd][j] = tr_frag(lds + SSD_XX + hd * 16384, lane, 4 + 2 * ph + j, 1);
        SB();
#pragma unroll
        for (int hd = 0; hd < 2; ++hd)
#pragma unroll
            for (int i = 0; i < 2; ++i)
#pragma unroll
                for (int j = 0; j < 2; ++j) Hacc[hd][i][j] = __builtin_amdgcn_mfma_f32_16x16x32_bf16(bt[i], xs[hd][j], Hacc[hd][i][j], 0, 0, 0);
#undef SB
        if (more) { SSD_HWRITE((c + 1) & 1); SSD_SCAN((c + 1) & 1); }
        SSD_BAR();
        if (more) { SSD_STAGE_WRITE((c + 1) & 1);
#pragma unroll
            for (int hd = 0; hd < 2; ++hd) { zc[hd][0] = zr[hd][0]; zc[hd][1] = zr[hd][1]; }
            SSD_BAR(); }
    }
    int nb = b, nhp = hp, nmb = mbase;
    asm volatile("" : "+v"(lane), "+v"(r16), "+v"(q), "+v"(xrow), "+v"(xch), "+v"(brow), "+v"(bch), "+v"(lrow));
    if (ui + 1 < nunits) { SSD_DECODE(unit0 + ui + 1, nb, nhp, nmb); SSD_LOAD(0, nmb, nhp); SSD_LOADH(nb, nhp); }
    else {
        asm volatile("" : "=v"(xr[0]), "=v"(xr[1]), "=v"(br[0]), "=v"(br[1]), "=v"(cr[0]), "=v"(cr[1]));
        asm volatile("" : "=v"(zr[0][0]), "=v"(zr[0][1]), "=v"(zr[1][0]), "=v"(zr[1][1]), "=v"(dtl));
#pragma unroll
        for (int hd = 0; hd < 2; ++hd)
#pragma unroll
            for (int i = 0; i < 2; ++i) asm volatile("" : "=v"(Hin[hd][i][0]), "=v"(Hin[hd][i][1])); }
    if (lrow < vr) {
#pragma unroll
        for (int hd = 0; hd < 2; ++hd)
#pragma unroll
            for (int j = 0; j < 2; ++j) *(GAS v2u*)(yg + ((size_t)mbase + 64 * (nchunk - 1) + lrow) * DIN + (h0 + hd) * HD + 16 * (2 * ph + j) + 4 * q) = ypk[hd][j];
        if (q == 0) __hip_atomic_fetch_add(ssq + ((size_t)mbase + 64 * (nchunk - 1) + lrow) * 64, ssk[0] + ssk[1], __ATOMIC_RELAXED, __HIP_MEMORY_SCOPE_AGENT); }
#pragma unroll
    for (int hd = 0; hd < 2; ++hd) { float* so = a.out + (samp ? O_SS : O_SP) + (size_t)((l * (samp ? NBS : NBP) + b) * NH + h0 + hd) * HD * NS;
#pragma unroll
        for (int i = 0; i < 2; ++i)
#pragma unroll
            for (int j = 0; j < 2; ++j) *(GAS f32x4*)(so + (size_t)(16 * (2 * ph + j) + r16) * NS + 16 * (2 * lt + i) + 4 * q) = Hacc[hd][i][j]; }
    b = nb; hp = nhp; mbase = nmb;
    }
#undef SSD_DECODE
#undef SSD_LOADH
#undef SSD_LOAD
#undef SSD_SCAN
#undef SSD_STAGE_WRITE
#undef SSD_HWRITE
#undef SSD_BAR
}
__device__ __forceinline__ void ktab_build(const float* ssq, LAS float* tab, int row0, int sbase, int gfirst, int tid) {
    const int r = tid >> 1, g0 = 4 * (tid & 1);
    const float* p = ssq + (size_t)(row0 + r) * 64;
    float sprev = 1.f;
#pragma unroll
    for (int gg = -1; gg < 4; ++gg) { const int g = g0 + gg; if (g < 0) continue;
        const f32x4* q4 = (const f32x4*)(p + 8 * g); const f32x4 t = q4[0] + q4[1];
        const float sg = 1.f / sqrtf(((t.x + t.y) + (t.z + t.w)) * (1.f / 768.f) + RMS_EPS);
        if (gg >= 0) { tab[g * 256 + r] = sprev / sg; if (g >= gfirst) tab[(sbase + g - gfirst) * 256 + r] = sg; }
        sprev = sg; }
}

constexpr int CW_SAMP = 8192;
__device__ __forceinline__ void sample_norm(const Args& a, int l, int G, int bid, int lane, int wave) {
    const float* ssq = (const float*)(a.ws + WS_YG); bf16* mx = (bf16*)(a.ws + WS_MIXED);
    for (int rr = bid; rr < MS / 2; rr += G) {
        const int m = MP + 2 * rr + (wave >> 2);
#pragma unroll
        for (int gg = 0; gg < 2; ++gg) { const int g = 2 * (wave & 3) + gg;
            const float part = lane < 8 ? ssq[(size_t)m * 64 + 8 * g + lane] : 0.f;
            const float rstd = 1.f / sqrtf(wave_sum(part) * (1.f / 768.f) + RMS_EPS);
            unsigned long long* p = (unsigned long long*)(mx + (size_t)m * DIN + WPOOL + g * 768) + lane;
#pragma unroll
            for (int j = 0; j < 3; ++j) { const unsigned long long q = p[64 * j]; const f32x4 v = pg8::bf4_to_f32((unsigned)q, (unsigned)(q >> 32)) * rstd;
                __hip_atomic_store(p + 64 * j, (unsigned long long)pk2(v.x, v.y) | ((unsigned long long)pk2(v.z, v.w) << 32), __ATOMIC_RELAXED, __HIP_MEMORY_SCOPE_AGENT); } }
    }
    VM_WAIT(); __syncthreads();
    if (wave == 0 && lane == 0) __hip_atomic_fetch_add((unsigned*)(a.ws + WS_CTL) + CW_SAMP, 1u, __ATOMIC_RELAXED, __HIP_MEMORY_SCOPE_AGENT);
}
__device__ __forceinline__ void sample_wait(const Args& a, unsigned target, int lane, int wave) {
    if (wave == 0) { unsigned* cnt = (unsigned*)(a.ws + WS_CTL) + CW_SAMP; unsigned sp = 0;
        while ((unsigned)__builtin_amdgcn_readfirstlane(__hip_atomic_load(cnt, __ATOMIC_RELAXED, __HIP_MEMORY_SCOPE_AGENT)) < target) { __builtin_amdgcn_s_sleep(2); if (++sp > (1u << 22)) break; }
        __builtin_amdgcn_fence(__ATOMIC_ACQUIRE, "agent"); VM_WAIT(); }
    __syncthreads();
}

constexpr int CW_PDONE = 8448, CW_ADONE = 8576, CW_CQ = 8704;
constexpr int PROJ_UNITS1 = (MP / 256) * 72, PROJ_UNITS2 = (MP / 256) + 2 * 73;
constexpr int CW_PQ = 8832, POOL_TILES = (M / 256) * 2 * 4;
struct OneTile {
    int t;
    __device__ bool next(int i, pg8::Unit& u) const { if (i != 0) return false; const int per = (M / 256) * 2, r = t % per; u.g = t / per; u.pm = r % (M / 256); u.pn = r / (M / 256); return true; }
    __device__ __forceinline__ void a_ready(const pg8::Unit&) const {}
    __device__ __forceinline__ void done(const pg8::Unit&) const {}
};
struct ProjOrder {
    pg8::StaticOrder so; int G, c, ilast; volatile LAS unsigned* lcnt; unsigned* pdone; unsigned ltarget;
    __device__ void init(int G_, int c_, volatile LAS unsigned* lcnt_, unsigned* pdone_, unsigned ltarget_) { so.init(MP, 72 * 256, G_, c_); G = G_; c = c_; ilast = (PROJ_UNITS1 - 1 - c_) / G_; lcnt = lcnt_; pdone = pdone_; ltarget = ltarget_; }
    __device__ bool next(int i, pg8::Unit& u) const {
        const long L = (long)i * G + c;
        if (L < PROJ_UNITS1) return so.next(i, u);
        const int t = (int)(L - PROJ_UNITS1); if (t >= PROJ_UNITS2) return false;
        if (t < MP / 256) { u.pm = t; u.pn = 72; } else { const int r = t - MP / 256; u.pm = MP / 256 + (r & 1); u.pn = r >> 1; }
        u.g = 0; return true;
    }
    __device__ __forceinline__ void a_ready(const pg8::Unit&) const {}
    __device__ __forceinline__ void done(const pg8::Unit& u) const {
        if (u.ui == ilast) {
            asm volatile("s_waitcnt vmcnt(0)" ::: "memory");
            if (fresh_lane() == 0) {
                const unsigned old = __hip_atomic_fetch_add((LAS unsigned*)lcnt, 1u, __ATOMIC_RELAXED, __HIP_MEMORY_SCOPE_WORKGROUP);
                if (old + 1u == ltarget) {
                    __builtin_amdgcn_fence(__ATOMIC_RELEASE, "agent"); asm volatile("s_waitcnt vmcnt(0)" ::: "memory");
                    __hip_atomic_fetch_add(pdone, 1u, __ATOMIC_RELAXED, __HIP_MEMORY_SCOPE_AGENT); } } }
    }
};
__device__ __forceinline__ void wait_count(unsigned* cnt, unsigned target, int wave) {
    if (wave == 0) { unsigned sp = 0;
        while ((unsigned)__builtin_amdgcn_readfirstlane(__hip_atomic_load(cnt, __ATOMIC_RELAXED, __HIP_MEMORY_SCOPE_AGENT)) < target) { __builtin_amdgcn_s_sleep(2); if (++sp > (1u << 22)) break; }
        __builtin_amdgcn_fence(__ATOMIC_ACQUIRE, "agent"); VM_WAIT(); }
    __syncthreads();
}

__global__ void __launch_bounds__(NWAVES * 64, 2) trunk_fwd(Args args) {
    extern __shared__ __attribute__((aligned(16))) unsigned char lds_raw[];
    LAS unsigned char* lds = (LAS unsigned char*)lds_raw;
    volatile LAS unsigned* MISC = (volatile LAS unsigned*)(lds + MISC_OFF);
    const int wave = __builtin_amdgcn_readfirstlane((int)threadIdx.x >> 6);
    const int tid = wave * 64 + fresh_lane();
    const int G = gridDim.x, bid = blockIdx.x;
    unsigned* ctl = (unsigned*)(args.ws + WS_CTL);
    for (int u = tid; u < (LDS_BYTES - LDSCTL_OFF) / 4; u += NWAVES * 64) ((LAS unsigned*)(lds + LDSCTL_OFF))[u] = 0u;
    __syncthreads();
    const int lo = args.ph_lo, hi = args.ph_hi;
    XcdBarrier bar; bar.bar = ctl + CW_BAR; bar.x = 0; bar.st = MISC + 8; bar.w0 = (wave == 0);
    if (hi - lo > 1) bar = xcd_barrier_post(ctl + CW_BAR, MISC + 8, wave == 0);
#ifndef PROBE_MASK
#define PROBE_MASK 0
#endif
#define REP(kind) for (int _r = 0; _r < (((PROBE_MASK) >> (kind)) & 1 ? 2 : 1); ++_r)
#define IN(k) (lo <= (k) && (k) < hi)
#define BOTH(k) (IN(k) && IN((k) + 1))
#define SEAM(k) do { if (BOTH(k)) xcd_barrier(bar); } while (0)
#ifndef PROBE_SEL
#define PROBE_SEL 0
#endif
#ifndef PROBE_MULT
#define PROBE_MULT 4
#endif
#if PROBE_SEL > 0
    volatile LAS unsigned long long* tsw = (volatile LAS unsigned long long*)(lds + MISC_OFF + 64);
    if (bid == 0 && wave == 0 && fresh_lane() == 0) { tsw[0] = __builtin_amdgcn_s_memrealtime(); tsw[1] = 0ull; }
#define STAMP(kind) do { if (bid == 0 && wave == 0 && fresh_lane() == 0) { const unsigned long long t_ = __builtin_amdgcn_s_memrealtime(); if ((PROBE_SEL >> (kind)) & 1) tsw[1] = tsw[1] + (t_ - tsw[0]); tsw[0] = t_; } } while (0)
#else
#define STAMP(kind) do { } while (0)
#endif

    if (IN(0)) { const int l0 = fresh_lane(); p0_prologue(args, lds, G, bid, wave * 64 + l0, l0, wave); STAMP(0);
                 wait_count(ctl + CW_MOD, (unsigned)G, wave);
                 phase_a(args, lds, G, bid, fresh_lane(), wave); SEAM(0); STAMP(1); }
    for (int l = 0; l < 2; ++l) {
        const int pb = 1 + 4 * l;
#define TL (wave * 64 + fresh_lane())
        if (IN(pb)) {
            pg8::Gemm g{(const pg8::bf16_t*)(args.ws + WS_H), (const pg8::bf16_t*)(args.ws + WS_WIN + (size_t)l * WIN_L), M, NPAD, DM, DM, DM, 0, 0};
            ProjOrder S; S.init(G, bid, MISC + 25, ctl + CW_PDONE + 64 * l, 8u * (unsigned)(l + 1));
            EpiProj E{args.ws, args.out, args.in[14] + (size_t)l * NH, l};
            pg8::gemm_phase<EpiProj, ProjOrder, true, true>(lds, g, S, E, TL);
            if (wave == 0 && fresh_lane() == 0) { __builtin_amdgcn_fence(__ATOMIC_RELEASE, "agent"); asm volatile("s_waitcnt vmcnt(0)" ::: "memory");
                __hip_atomic_fetch_add(ctl + CW_ADONE + 64 * l, 1u, __ATOMIC_RELAXED, __HIP_MEMORY_SCOPE_AGENT); }
            c_zero_ssq(args, G, bid, TL);
            wait_count(ctl + CW_PDONE + 64 * l, (unsigned)G, wave);
            for (;;) {
                if (wave == 0 && fresh_lane() == 0) MISC[24] = __hip_atomic_fetch_add(ctl + CW_CQ + 64 * l, 1u, __ATOMIC_RELAXED, __HIP_MEMORY_SCOPE_AGENT);
                __syncthreads();
                const int it = __builtin_amdgcn_readfirstlane((int)MISC[24]);
                __syncthreads();
                if (it >= C_QITEMS) break;
                c_prompt_item(args, l, it, TL); }
            wait_count(ctl + CW_ADONE + 64 * l, (unsigned)G, wave);
            c_sample_elems(args, l, G, bid, TL);
            SEAM(pb); STAMP(2);
        }
        if (IN(pb + 1)) {
            REP(5) for (int k = 0; ; ++k) {
                int u, nu = 1;
                if (G == 256) { if (k >= 1) break; u = bid < 192 ? bid : NBP * 48 + (bid - 192) * 12; nu = bid < 192 ? 1 : 12; }
                else { u = bid + k * G; if (u >= (NBP + NBS) * 48) break; }
                ssd_unit(args, lds, l, u, nu, TL); }
            __syncthreads();
            { pg8::Gemm g{(const pg8::bf16_t*)(args.ws + WS_POOLED), (const pg8::bf16_t*)(args.ws + WS_WP) + (size_t)l * 4 * 512 * 512, M, 512, 512, WPOOL, 512, 512, (size_t)512 * 512};
              pg8::EpiPool E{(pg8::bf16_t*)(args.ws + WS_MIXED), DIN, (const pg8::bf16_t*)(args.ws + WS_SG), WPOOL, args.in[11] + (size_t)l * WPOOL};
              for (;;) {
                  if (wave == 0 && fresh_lane() == 0) MISC[24] = __hip_atomic_fetch_add(ctl + CW_PQ + 64 * l, 1u, __ATOMIC_RELAXED, __HIP_MEMORY_SCOPE_AGENT);
                  __syncthreads();
                  const int tq = (int)MISC[24];
                  __syncthreads();
                  if (tq >= POOL_TILES) break;
                  OneTile S{tq};
                  pg8::gemm_phase<pg8::EpiPool, OneTile, true, true>(lds, g, S, E, TL);
                  __syncthreads(); } }
            SEAM(pb + 1); STAMP(4);
        }
        if (IN(pb + 2)) {   sample_norm(args, l, G, bid, fresh_lane(), wave);
            { pg8::Gemm g{(const pg8::bf16_t*)(args.ws + WS_MIXED), (const pg8::bf16_t*)(args.ws + WS_WOUT + (size_t)l * WOUT_L), MP, DM, DIN, DIN, DIN, 0, 0};
              pg8::StaticOrder S; S.init(MP, DM, G, bid);
              pg8::EpiResid E{(pg8::bf16_t*)(args.ws + WS_R), DM, l == 0 ? args.in[0] : (const float*)(args.ws + WS_X1), (const float*)(args.ws + WS_MODF) + (size_t)l * NBT * 3 * DM + 2 * DM, 3 * DM, ALPHA, lds};
              { const int tt = TL; pg8::Unit u0;
                for (int ui = 0; ui < 2; ++ui) if (S.next(ui, u0)) ktab_build((const float*)(args.ws + WS_YG), (LAS float*)(lds + pg8::KTAB_OFF) + ui * 9 * 256, u0.pm * 256, 8, 7, tt);
                __syncthreads(); }
              pg8::gemm_phase<pg8::EpiResid, pg8::StaticOrder, true, true>(lds, g, S, E, TL);
#if (PROBE_MASK >> 7) & 1
              __syncthreads(); pg8::gemm_phase<pg8::EpiResid, pg8::StaticOrder, true, true>(lds, g, S, E, TL);
#endif
            }
            __syncthreads();
            { pg8::Gemm g{(const pg8::bf16_t*)(args.ws + WS_MIXED) + (size_t)MP * DIN, (const pg8::bf16_t*)(args.ws + WS_WOUT + (size_t)l * WOUT_L), MS, DM, DIN / 8, DIN, DIN, (size_t)(DIN / 8), (size_t)(DIN / 8)};
              pg8::GroupOrder S; S.init(MS, DM, 8, G, bid);
              pg8::EpiSlab E{(float*)(args.ws + WS_SLAB), DM, (size_t)MS * DM};
              sample_wait(args, (unsigned)G * (unsigned)(l + 1), fresh_lane(), wave);
              pg8::gemm_phase<pg8::EpiSlab, pg8::GroupOrder, true, true>(lds, g, S, E, TL); }
            SEAM(pb + 2); STAMP(6);
        }
        if (IN(pb + 3)) { REP(8) phase_g(args, lds, l, G, bid, fresh_lane(), wave); if (pb + 3 < NPHASE - 1) SEAM(pb + 3); STAMP(7); }
    }
#if PROBE_SEL > 0
    if (bid == 0 && wave == 0 && fresh_lane() == 0) { const unsigned long long t_end = __builtin_amdgcn_s_memrealtime() + (unsigned long long)PROBE_MULT * tsw[1]; while (__builtin_amdgcn_s_memrealtime() < t_end) __builtin_amdgcn_s_sleep(8); }
#endif
#undef IN
#undef BOTH
#undef SEAM
}

#ifndef MK_SPLIT
#define MK_SPLIT 0
#endif
extern "C" void kernel_launch(void* const* d_in, const int* in_sizes, int n_in, void* d_out, int out_size, void* d_ws, size_t ws_size, hipStream_t stream) {
    static int grid = 0;
    if (grid == 0) {
        if (n_in != 21 || (size_t)out_size != O_END || ws_size < WS_END) { fprintf(stderr, "kernel_launch: unexpected shapes: n_in %d out %d ws %zu; nothing launched\n", n_in, out_size, ws_size); grid = -1; return; }
        int dev = 0, cus = 0, per_cu = 0;
        if (hipGetDevice(&dev) != hipSuccess || hipDeviceGetAttribute(&cus, hipDeviceAttributeMultiprocessorCount, dev) != hipSuccess) { grid = -1; return; }
        if (hipFuncSetAttribute((const void*)trunk_fwd, hipFuncAttributeMaxDynamicSharedMemorySize, LDS_BYTES) != hipSuccess) { fprintf(stderr, "kernel_launch: hipFuncSetAttribute failed\n"); grid = -1; return; }
        if (hipOccupancyMaxActiveBlocksPerMultiprocessor(&per_cu, (const void*)trunk_fwd, NWAVES * 64, LDS_BYTES) != hipSuccess || per_cu < 1) { fprintf(stderr, "kernel_launch: occupancy query says %d blocks per CU\n", per_cu); (void)hipGetLastError(); grid = -1; return; }
        grid = cus;
    }
    if (grid < 0) return;
    if (hipMemsetAsync((char*)d_ws + WS_CTL, 0, CTL_ZERO_BYTES, stream) != hipSuccess) return;
    Args a{};
    for (int i = 0; i < 21; ++i) a.in[i] = (const float*)d_in[i];
    a.out = (float*)d_out; a.ws = (unsigned char*)d_ws;
#if MK_SPLIT
    for (int ph = 0; ph < NPHASE; ++ph) { a.ph_lo = ph; a.ph_hi = ph + 1; hipLaunchKernelGGL(trunk_fwd, dim3(grid), dim3(NWAVES * 64), LDS_BYTES, stream, a); }
#else
    a.ph_lo = 0; a.ph_hi = NPHASE; hipLaunchKernelGGL(trunk_fwd, dim3(grid), dim3(NWAVES * 64), LDS_BYTES, stream, a);
#endif
}
```

```cpp
#ifndef PROBE_MASK
#define PROBE_MASK 0
#endif
#include <hip/hip_runtime.h>
#include <cstdio>
#include <cstdint>
namespace pg8 {
#define PG8_LAS __attribute__((address_space(3)))
typedef unsigned short bf16_t;
typedef short bf16x8 __attribute__((ext_vector_type(8)));
typedef float f32x4 __attribute__((ext_vector_type(4)));
typedef unsigned u32x4 __attribute__((ext_vector_type(4)));
constexpr int BM = 256, BK = 64, HALF = 128, HTB = HALF * BK * 2  , STAGE_BYTES = 8 * HTB, NXCD = 8, WGM = 8;

__host__ __device__ __forceinline__ int lds_byte(int r, int c) { const int st = (r >> 4) * 2 + (c >> 5), rr = r & 15, cc = c & 31, ob = rr * 64 + cc * 2; return st * 1024 + (ob ^ (((ob >> 9) & 1) << 5)); }
__host__ __device__ __forceinline__ void stage_rc(int b, int& R, int& C) { const int st = b / 1024, sb = b % 1024, swz = sb ^ (((sb >> 9) & 1) << 5); R = (st >> 1) * 16 + swz / 64; C = (st & 1) * 32 + (swz % 64) / 2; }
__host__ __device__ __forceinline__ int perm32(int rho) { const int n = rho >> 4, i = rho & 15; return 8 * (i >> 2) + 4 * n + (i & 3); }

struct Unit { int pm, pn, g, ui; };
struct Gemm { const bf16_t* A; const bf16_t* Bt; int M, N, K, lda, ldb; size_t a_goff, b_goff; };

struct StaticOrder {
    int nM, nN, nwg, G, c;
    __host__ __device__ void init(int M, int N, int G_, int c_) { nM = M / BM; nN = N / BM; nwg = nM * nN; G = G_; c = c_; }
    __host__ __device__ bool next(int i, Unit& u) const {
        const long L = (long)i * G + c; if (L >= nwg) return false;
        int wgid = (int)L; { const int q = nwg / NXCD, r = nwg % NXCD, xcd = wgid % NXCD, off = wgid / NXCD; wgid = (xcd < r ? xcd * (q + 1) : r * (q + 1) + (xcd - r) * q) + off; }
        const int nig = WGM * nN, gid = wgid / nig, fm = gid * WGM, gsz = (nM - fm) < WGM ? (nM - fm) : WGM;
        u.pm = fm + ((wgid % nig) % gsz); u.pn = (wgid % nig) / gsz; u.g = 0; return true;
    }
    __device__ __forceinline__ void a_ready(const Unit&) const {}
    __device__ __forceinline__ void done(const Unit&) const {}
};
struct GroupOrder {
    int nM, nN, ng, G, c;
    __host__ __device__ void init(int M, int N, int ng_, int G_, int c_) { nM = M / BM; nN = N / BM; ng = ng_; G = G_; c = c_; }
    __host__ __device__ bool next(int i, Unit& u) const {
        const long L = (long)i * G + c; if (L >= (long)nM * nN * ng) return false;
        const int per = nM * nN, l = (int)L; u.g = l / per; const int r = l % per; u.pm = r % nM; u.pn = r / nM; return true;
    }
    __device__ __forceinline__ void a_ready(const Unit&) const {}
    __device__ __forceinline__ void done(const Unit&) const {}
};

typedef __bf16 hwbf16x2 __attribute__((ext_vector_type(2))); typedef float f32x2c __attribute__((ext_vector_type(2)));
__device__ __forceinline__ unsigned cvt_pk_bf16(float lo, float hi) { return __builtin_bit_cast(unsigned, __builtin_convertvector((f32x2c){lo, hi}, hwbf16x2)); }
__device__ __forceinline__ float silu_f(float x) { return x * __builtin_amdgcn_rcpf(1.0f + __expf(-x)); }

__device__ __forceinline__ f32x4 bf4_to_f32(unsigned lo, unsigned hi) { return (f32x4){__builtin_bit_cast(float, lo << 16), __builtin_bit_cast(float, lo & 0xffff0000u), __builtin_bit_cast(float, hi << 16), __builtin_bit_cast(float, hi & 0xffff0000u)}; }
constexpr int KTAB_OFF = 135168;
__device__ __forceinline__ void kscale_acc(f32x4 (&acc)[2][2][4][2], const PG8_LAS float* col, int wr, int fr) {
#pragma unroll
    for (int ai = 0; ai < 2; ++ai)
#pragma unroll
        for (int m = 0; m < 4; ++m) { const float f = col[ai * HALF + wr * 64 + m * 16 + fr];
#pragma unroll
            for (int bj = 0; bj < 2; ++bj)
#pragma unroll
                for (int n = 0; n < 2; ++n) acc[ai][bj][m][n] = acc[ai][bj][m][n] * f; }
}
struct EpiSlab {
    static constexpr bool PERM = false, AFTER_DRAIN = false, KHOOK = false;
    float* C; int ldc; size_t gstride;
    __device__ __forceinline__ void operator()(const f32x4 (&acc)[2][2][4][2], const Unit& u, int wr, int wc, int fr, int fq) const {
        asm volatile("" : "+v"(fr), "+v"(fq));
        const int row0 = u.pm * BM + wr * 64 + fr, col0 = u.pn * BM + wc * 32 + 4 * fq; float* Cg = C + (size_t)u.g * gstride;
#pragma unroll
        for (int ai = 0; ai < 2; ++ai)
#pragma unroll
            for (int m = 0; m < 4; ++m) { float* rowp = Cg + (size_t)(row0 + ai * HALF + m * 16) * ldc + col0;
#pragma unroll
                for (int bj = 0; bj < 2; ++bj)
#pragma unroll
                    for (int n = 0; n < 2; ++n) *(f32x4*)(rowp + bj * HALF + n * 16) = acc[ai][bj][m][n]; }
    }
};
struct EpiPool {
    static constexpr bool PERM = true, AFTER_DRAIN = false, KHOOK = false;
    bf16_t* O; int ldo; const bf16_t* sg; int ldp; const float* pscale;
    __device__ __forceinline__ void operator()(const f32x4 (&acc)[2][2][4][2], const Unit& u, int wr, int wc, int fr, int fq) const {
        asm volatile("" : "+v"(fr), "+v"(fq));
        const int row0 = u.pm * BM + wr * 64 + fr, col0 = u.g * 512 + u.pn * BM + wc * 32 + 8 * fq;
        f32x4 ps[2][2];
#pragma unroll
        for (int bj = 0; bj < 2; ++bj)
#pragma unroll
            for (int n = 0; n < 2; ++n) ps[bj][n] = *(const f32x4*)(pscale + col0 + bj * HALF + 4 * n);
#pragma unroll
        for (int ai = 0; ai < 2; ++ai)
#pragma unroll
            for (int m = 0; m < 4; ++m) { const size_t row = (size_t)(row0 + ai * HALF + m * 16);
#pragma unroll
                for (int bj = 0; bj < 2; ++bj) { const int c = col0 + bj * HALF;
                    const u32x4 gq = *(const u32x4*)(sg + row * ldp + c);
                    const f32x4 v0 = acc[ai][bj][m][0] * ps[bj][0] * bf4_to_f32(gq.x, gq.y), v1 = acc[ai][bj][m][1] * ps[bj][1] * bf4_to_f32(gq.z, gq.w);
                    u32x4 w; w.x = cvt_pk_bf16(v0[0], v0[1]); w.y = cvt_pk_bf16(v0[2], v0[3]); w.z = cvt_pk_bf16(v1[0], v1[1]); w.w = cvt_pk_bf16(v1[2], v1[3]);
                    *(u32x4*)(O + row * ldo + c) = w; } }
    }
};
struct EpiResid {
    static constexpr bool PERM = true, AFTER_DRAIN = false, KHOOK = true;
    bf16_t* R; int ldr; const float* xp; const float* gate; int ldg; float alpha; PG8_LAS unsigned char* lds;
    __device__ __forceinline__ void khook(f32x4 (&acc)[2][2][4][2], const Unit& u, int t, int wr, int fr) const {
        if (t >= 32 && (t - 32) % 12 == 0) kscale_acc(acc, (const PG8_LAS float*)(lds + KTAB_OFF) + (u.ui * 9 + (t - 32) / 12) * 256, wr, fr);
    }
    __device__ __forceinline__ void operator()(const f32x4 (&acc)[2][2][4][2], const Unit& u, int wr, int wc, int fr, int fq) const {
        asm volatile("" : "+v"(fr), "+v"(fq));
        const int row0 = u.pm * BM + wr * 64 + fr, col0 = u.pn * BM + wc * 32 + 8 * fq;
        const float* gr = gate + (size_t)(u.pm >> 3) * ldg + col0;
        f32x4 gv[2][2];
#pragma unroll
        for (int bj = 0; bj < 2; ++bj)
#pragma unroll
            for (int n = 0; n < 2; ++n) gv[bj][n] = *(const f32x4*)(gr + bj * HALF + 4 * n);
        u32x4 pk[2][4][2];
#pragma unroll
        for (int ai = 0; ai < 2; ++ai)
#pragma unroll
            for (int m = 0; m < 4; ++m) { const float s7 = ((const PG8_LAS float*)(lds + KTAB_OFF))[(u.ui * 9 + 8) * 256 + ai * HALF + wr * 64 + m * 16 + fr];
#pragma unroll
                for (int bj = 0; bj < 2; ++bj) { const f32x4 v0 = acc[ai][bj][m][0] * gv[bj][0] * s7, v1 = acc[ai][bj][m][1] * gv[bj][1] * s7;
                    pk[ai][m][bj] = (u32x4){cvt_pk_bf16(v0[0], v0[1]), cvt_pk_bf16(v0[2], v0[3]), cvt_pk_bf16(v1[0], v1[1]), cvt_pk_bf16(v1[2], v1[3])}; } }
#pragma unroll
        for (int ai = 0; ai < 2; ++ai) { f32x4 xv[4][2][2];
            __builtin_amdgcn_sched_barrier(0);
#pragma unroll
            for (int m = 0; m < 4; ++m) { const float* xr = xp + (size_t)(row0 + ai * HALF + m * 16) * 4096 + col0;
#pragma unroll
                for (int bj = 0; bj < 2; ++bj)
#pragma unroll
                    for (int n = 0; n < 2; ++n) xv[m][bj][n] = *(const f32x4*)(xr + bj * HALF + 4 * n); }
            __builtin_amdgcn_sched_barrier(0);
#pragma unroll
            for (int m = 0; m < 4; ++m) { bf16_t* rr = R + (size_t)(row0 + ai * HALF + m * 16) * ldr + col0;
#pragma unroll
                for (int bj = 0; bj < 2; ++bj) { const u32x4 t = pk[ai][m][bj];
                    const f32x4 o0 = xv[m][bj][0] * alpha + bf4_to_f32(t.x, t.y), o1 = xv[m][bj][1] * alpha + bf4_to_f32(t.z, t.w);
                    u32x4 w; w.x = cvt_pk_bf16(o0[0], o0[1]); w.y = cvt_pk_bf16(o0[2], o0[3]); w.z = cvt_pk_bf16(o1[0], o1[1]); w.w = cvt_pk_bf16(o1[2], o1[3]);
                    *(u32x4*)(rr + bj * HALF) = w; } } }
    }
};

template <class Epi, class Sched, bool ALIGN_EPI = false, bool SP2 = false>
__device__ __forceinline__ void gemm_phase(PG8_LAS unsigned char* lds, const Gemm g, const Sched& S, const Epi& E, const int tid) {
    const int wid = __builtin_amdgcn_readfirstlane(tid >> 6), lane = tid & 63, wr = wid >> 2, wc = wid & 3, fr = lane & 15, fq = lane >> 4;
    const int K = g.K, nt = K / BK;
    unsigned voffA[2], voffB[2];
#pragma unroll
    for (int i = 0; i < 2; ++i) { int R, C; stage_rc(tid * 16 + i * 8192, R, C); const int Rb = Epi::PERM ? ((R & ~31) + perm32(R & 31)) : R;
        voffA[i] = (unsigned)(R * g.lda + C) * 2u; voffB[i] = (unsigned)(Rb * g.ldb + C) * 2u; }
    const size_t kstep = (size_t)(BK * 2);
    const size_t hstepA = (size_t)HALF * g.lda * 2, hstepB = (size_t)HALF * g.ldb * 2;
    const size_t tstepA = 2 * hstepA, tstepB = 2 * hstepB;
    const unsigned ldsw = (unsigned)wid * 1024u;
    const int aoff = lds_byte(wr * 64 + fr, fq * 8), boff = lds_byte(wc * 32 + fr, fq * 8);
#define PG8_SA(b, h) (((b) * 2 + (h)) * HTB)
#define PG8_SB(b, h) ((4 + (b) * 2 + (h)) * HTB)
#define PG8_STAGE(bufoff, gbase, voff) do { _Pragma("unroll") for (int _i = 0; _i < 2; ++_i) \
        __builtin_amdgcn_global_load_lds((const unsigned*)((const char*)(gbase) + (voff)[_i]), (PG8_LAS unsigned*)(lds + (bufoff) + ldsw + _i * 8192), 16, 0, 0); } while (0)
#define PG8_LDA(dst, b, h) do { _Pragma("unroll") for (int m = 0; m < 4; ++m) _Pragma("unroll") for (int k = 0; k < 2; ++k) dst[m][k] = *(const PG8_LAS bf16x8*)(lds + PG8_SA(b, h) + aoff + m * 2048 + k * 1024); } while (0)
#define PG8_LDB(dst, b, h) do { _Pragma("unroll") for (int n = 0; n < 2; ++n) _Pragma("unroll") for (int k = 0; k < 2; ++k) dst[n][k] = *(const PG8_LAS bf16x8*)(lds + PG8_SB(b, h) + boff + n * 2048 + k * 1024); } while (0)
#define PG8_MMA(ai, bj, At, Bt) do { __builtin_amdgcn_s_setprio(1); _Pragma("unroll") for (int m = 0; m < 4; ++m) _Pragma("unroll") for (int n = 0; n < 2; ++n) _Pragma("unroll") for (int k = 0; k < 2; ++k) \
        acc[ai][bj][m][n] = __builtin_amdgcn_mfma_f32_16x16x32_bf16(Bt[n][k], At[m][k], acc[ai][bj][m][n], 0, 0, 0); __builtin_amdgcn_s_setprio(0); } while (0)
#define PG8_WAIT_V(n) asm volatile("s_waitcnt vmcnt(" #n ")" ::: "memory")
#define PG8_WAIT_L(n) asm volatile("s_waitcnt lgkmcnt(" #n ")" ::: "memory")
#define PG8_BAR __builtin_amdgcn_s_barrier()
#define PG8_SCHED __builtin_amdgcn_sched_barrier(0)
    Unit cur, nxt; int ui = 0;
    if (!S.next(0, cur)) return;
    cur.ui = 0;
    f32x4 acc[2][2][4][2];
#pragma unroll
    for (int a = 0; a < 2; ++a)
#pragma unroll
        for (int b = 0; b < 2; ++b)
#pragma unroll
            for (int m = 0; m < 4; ++m)
#pragma unroll
                for (int n = 0; n < 2; ++n) acc[a][b][m][n] = (f32x4){0.f, 0.f, 0.f, 0.f};
    bf16x8 At[4][2], B0[2][2], B1[2][2];
    const char* cA = (const char*)g.A + (size_t)cur.g * g.a_goff * 2 + (size_t)cur.pm * tstepA; const char* cB = (const char*)g.Bt + (size_t)cur.g * g.b_goff * 2 + (size_t)cur.pn * tstepB;
    S.a_ready(cur);
    if constexpr (SP2) {
        PG8_STAGE(PG8_SB(0, 0), cB, voffB); PG8_STAGE(PG8_SB(0, 1), cB + hstepB, voffB); PG8_STAGE(PG8_SA(0, 0), cA, voffA); PG8_STAGE(PG8_SA(0, 1), cA + hstepA, voffA);
        if (wr == 1) PG8_BAR;
        PG8_WAIT_V(2); PG8_BAR;
        PG8_STAGE(PG8_SB(1, 0), cB + kstep, voffB); PG8_STAGE(PG8_SA(1, 0), cA + kstep, voffA); PG8_STAGE(PG8_SB(1, 1), cB + hstepB + kstep, voffB);
        PG8_WAIT_V(6); PG8_BAR;
    } else {
        PG8_STAGE(PG8_SB(0, 0), cB, voffB); PG8_STAGE(PG8_SA(0, 0), cA, voffA); PG8_STAGE(PG8_SB(0, 1), cB + hstepB, voffB); PG8_STAGE(PG8_SA(0, 1), cA + hstepA, voffA);
        if (wr == 1) PG8_BAR;
        PG8_WAIT_V(4); PG8_BAR;
        PG8_STAGE(PG8_SB(1, 0), cB + kstep, voffB); PG8_STAGE(PG8_SA(1, 0), cA + kstep, voffA); PG8_STAGE(PG8_SB(1, 1), cB + hstepB + kstep, voffB);
        PG8_WAIT_V(6); PG8_BAR;
    }
    for (;;) {
        const bool has_next = S.next(ui + 1, nxt); nxt.ui = ui + 1;
        const char* nA = has_next ? (const char*)g.A + (size_t)nxt.g * g.a_goff * 2 + (size_t)nxt.pm * tstepA : cA; const char* nB = has_next ? (const char*)g.Bt + (size_t)nxt.g * g.b_goff * 2 + (size_t)nxt.pn * tstepB : cB;
        for (int t = 0; t < nt; t += 2) {
            const bool last = (t == nt - 2);
            const char* a1 = cA + (size_t)(t + 1) * kstep;
            const char* a2 = last ? nA : cA + (size_t)(t + 2) * kstep; const char* b2 = last ? nB : cB + (size_t)(t + 2) * kstep;
            const char* a3 = a2 + kstep; const char* b3 = b2 + kstep;
            if (last && has_next) S.a_ready(nxt);
            if constexpr (Epi::KHOOK) E.khook(acc, cur, t, wr, fr);
            if constexpr (SP2) {
            PG8_LDB(B0, 0, 0); PG8_LDB(B1, 0, 1); PG8_SCHED; PG8_LDA(At, 0, 0); PG8_STAGE(PG8_SA(1, 1), a1 + hstepA, voffA);
            PG8_WAIT_V(8); PG8_WAIT_L(0); PG8_BAR; PG8_MMA(0, 0, At, B0); PG8_MMA(0, 1, At, B1); PG8_BAR; PG8_SCHED;
            PG8_LDA(At, 0, 1); PG8_STAGE(PG8_SB(0, 0), b2, voffB); PG8_STAGE(PG8_SB(0, 1), b2 + hstepB, voffB); PG8_STAGE(PG8_SA(0, 0), a2, voffA);
            PG8_WAIT_V(8); PG8_WAIT_L(0); PG8_BAR; PG8_MMA(1, 0, At, B0); PG8_MMA(1, 1, At, B1); PG8_BAR; PG8_SCHED;
            PG8_LDB(B0, 1, 0); PG8_LDB(B1, 1, 1); PG8_SCHED; PG8_LDA(At, 1, 0); PG8_STAGE(PG8_SA(0, 1), a2 + hstepA, voffA);
            PG8_WAIT_V(8); PG8_WAIT_L(0); PG8_BAR; PG8_MMA(0, 0, At, B0); PG8_MMA(0, 1, At, B1); PG8_BAR; PG8_SCHED;
            PG8_LDA(At, 1, 1); PG8_STAGE(PG8_SB(1, 0), b3, voffB); PG8_STAGE(PG8_SB(1, 1), b3 + hstepB, voffB); PG8_STAGE(PG8_SA(1, 0), a3, voffA);
            PG8_WAIT_V(8); PG8_WAIT_L(0); PG8_BAR; PG8_MMA(1, 0, At, B0); PG8_MMA(1, 1, At, B1); PG8_BAR; PG8_SCHED;
            } else {
            PG8_LDB(B0, 0, 0); PG8_SCHED; PG8_LDA(At, 0, 0); PG8_STAGE(PG8_SA(1, 1), a1 + hstepA, voffA);
            PG8_WAIT_L(8); PG8_BAR; PG8_WAIT_L(0); PG8_MMA(0, 0, At, B0); PG8_BAR; PG8_SCHED;
            PG8_LDB(B1, 0, 1); PG8_STAGE(PG8_SB(0, 0), b2, voffB);
            PG8_BAR; PG8_WAIT_L(0); PG8_MMA(0, 1, At, B1); PG8_BAR;
            PG8_LDA(At, 0, 1); PG8_STAGE(PG8_SA(0, 0), a2, voffA);
            PG8_BAR; PG8_WAIT_L(0); PG8_MMA(1, 0, At, B0); PG8_BAR; PG8_SCHED;
            PG8_STAGE(PG8_SB(0, 1), b2 + hstepB, voffB);
            PG8_WAIT_V(6); PG8_BAR; PG8_MMA(1, 1, At, B1); PG8_BAR;
            PG8_LDB(B0, 1, 0); PG8_SCHED; PG8_LDA(At, 1, 0); PG8_STAGE(PG8_SA(0, 1), a2 + hstepA, voffA);
            PG8_WAIT_L(8); PG8_BAR; PG8_WAIT_L(0); PG8_MMA(0, 0, At, B0); PG8_BAR; PG8_SCHED;
            PG8_LDB(B1, 1, 1); PG8_STAGE(PG8_SB(1, 0), b3, voffB);
            PG8_BAR; PG8_WAIT_L(0); PG8_MMA(0, 1, At, B1); PG8_BAR;
            PG8_LDA(At, 1, 1); PG8_STAGE(PG8_SA(1, 0), a3, voffA);
            PG8_BAR; PG8_WAIT_L(0); PG8_MMA(1, 0, At, B0); PG8_BAR; PG8_SCHED;
            PG8_STAGE(PG8_SB(1, 1), b3 + hstepB, voffB);
            PG8_WAIT_V(6); PG8_BAR; PG8_MMA(1, 1, At, B1); PG8_BAR;
            }
        }
        if constexpr (ALIGN_EPI) { if (wr == 0) PG8_BAR; }
        if constexpr (!Epi::AFTER_DRAIN) { E(acc, cur, wr, wc, fr, fq); S.done(cur); }
        if (!has_next) break;
#pragma unroll
        for (int a = 0; a < 2; ++a)
#pragma unroll
            for (int b = 0; b < 2; ++b)
#pragma unroll
                for (int m = 0; m < 4; ++m)
#pragma unroll
                    for (int n = 0; n < 2; ++n) acc[a][b][m][n] = (f32x4){0.f, 0.f, 0.f, 0.f};
        cur = nxt; cA = nA; cB = nB; ++ui;
        if constexpr (ALIGN_EPI) { if (wr == 1) PG8_BAR; }
    }
    PG8_WAIT_V(0);
    if constexpr (!ALIGN_EPI) { if (wr == 0) PG8_BAR; }
    PG8_BAR;
    if constexpr (Epi::AFTER_DRAIN) { E.fused(acc, cur, wr, wc, fr, fq, lds, wid, lane); S.done(cur); }
#undef PG8_SA
#undef PG8_SB
#undef PG8_STAGE
#undef PG8_LDA
#undef PG8_LDB
#undef PG8_MMA
#undef PG8_WAIT_V
#undef PG8_WAIT_L
#undef PG8_BAR
#undef PG8_SCHED
}
}

constexpr int DM = 4096, NBP = 4, SEQ = 2048, NBS = 16, DSEQ = 32, PAST = 1024;
constexpr int MP = NBP * SEQ, MS = NBS * DSEQ, M = MP + MS, NBT = NBP + NBS;
constexpr int WPOOL = 2048, WSSD = 6144, HD = 64, NH = 96, NS = 128, CONVD = 8192, IN_DIM = 18528, NPAD = 18688, DIN = 8192;
constexpr int C_U = 0, C_G = 2048, C_Z = 4096, C_X = 10240, C_B = C_X + 6144, C_C = C_B + 1024, C_DT = 18432;
constexpr float LN_EPS = 1e-5f, RMS_EPS = 1e-5f, ALPHA = 1.41421356237f;
constexpr size_t O_Y = 0, O_PP = 35651584, O_CP = 35897344, O_SP = 36093952, O_PS = 42385408, O_CS = 43368448, O_SS = 44154880, O_END = 69320704;
constexpr size_t MiB = 1u << 20;
constexpr size_t WS_CTL = 0, CTL_ZERO_BYTES = 1 * MiB, WS_MODF = 1 * MiB, WS_WIN = 4 * MiB, WIN_L = 146 * MiB, WS_WOUT = 296 * MiB, WOUT_L = 64 * MiB, WS_WP = 424 * MiB,
                 WS_H = 428 * MiB, WS_UP = 496 * MiB, WS_SG = 530 * MiB, WS_SZ = 564 * MiB, WS_XP = 666 * MiB, WS_XBC = 802 * MiB, WS_POOLED = 938 * MiB, WS_DTV = 972 * MiB,
                 WS_YG = 976 * MiB, WS_MIXED = 1078 * MiB, WS_R = 1214 * MiB, WS_X1 = 1350 * MiB, WS_SLAB = 1486 * MiB, WS_END = 1550 * MiB;
static_assert((size_t)NPAD * DM * 2 == WIN_L && (size_t)DM * DIN * 2 == WOUT_L && WS_SZ + (size_t)M * WSSD * 2 <= WS_XP && WS_XP + (size_t)M * CONVD * 2 <= WS_XBC && WS_SLAB + (size_t)8 * MS * DM * 4 <= WS_END, "ws map");
constexpr int CW_MOD = 8128;
constexpr int CW_BAR = 4096;
constexpr int RING_BYTES = 131072, LDSCTL_OFF = RING_BYTES, MISC_OFF = LDSCTL_OFF + 320, LDS_BYTES = 155648;
constexpr int NWAVES = 8;
constexpr int NPHASE = 9;

struct EpiProj {
    typedef pg8::bf16_t bf16_t; typedef pg8::f32x4 f32x4; typedef pg8::u32x4 u32x4; typedef pg8::Unit Unit; static constexpr int BM = pg8::BM, HALF = pg8::HALF;
    static constexpr bool PERM = true, AFTER_DRAIN = false, KHOOK = false;
    unsigned char* ws; float* out; const float* dtb; int l;
    __device__ __forceinline__ void operator()(const f32x4 (&acc)[2][2][4][2], const Unit& u, int wr, int wc, int fr, int fq) const {
        asm volatile("" : "+v"(fr), "+v"(fq));
        const int pn = u.pn, row0 = u.pm * BM + wr * 64 + fr, cl = wc * 32 + 8 * fq;
        if (pn < 8 || (pn >= 40 && pn < 72)) {
            const bool pool = pn < 8; bf16_t* O = (bf16_t*)(ws + (pool ? WS_UP : WS_XP)); const int ldo = pool ? 2048 : 8192, c0 = (pool ? pn : pn - 40) * BM + cl, hist = pool ? 15 : 3;
#pragma unroll
            for (int ai = 0; ai < 2; ++ai)
#pragma unroll
                for (int m = 0; m < 4; ++m) { const int row = row0 + ai * HALF + m * 16;
#pragma unroll
                    for (int bj = 0; bj < 2; ++bj) { const f32x4 v0 = acc[ai][bj][m][0], v1 = acc[ai][bj][m][1];
                        u32x4 w; w.x = pg8::cvt_pk_bf16(v0[0], v0[1]); w.y = pg8::cvt_pk_bf16(v0[2], v0[3]); w.z = pg8::cvt_pk_bf16(v1[0], v1[1]); w.w = pg8::cvt_pk_bf16(v1[2], v1[3]);
                        *(u32x4*)(O + (size_t)row * ldo + c0 + bj * HALF) = w; }
                    asm volatile("" ::: "memory"); }
            if (u.pm >= 32 || (u.pm & 7) == 7) {
#pragma unroll
                for (int ai = 0; ai < 2; ++ai)
#pragma unroll
                    for (int m = 0; m < 4; ++m) { const int row = row0 + ai * HALF + m * 16;
                        const bool samp = row >= 8192; const int t = samp ? ((row - 8192) & 31) : (row & 2047), L = samp ? 32 : 2048, b = samp ? ((row - 8192) >> 5) : (row >> 11);
                        if (t >= L - hist) { float* nb = out + (samp ? (pool ? O_PS : O_CS) : (pool ? O_PP : O_CP)) + ((size_t)(l * (samp ? NBS : NBP) + b) * hist + (t - (L - hist))) * ldo + c0;
#pragma unroll
                            for (int bj = 0; bj < 2; ++bj) { *(f32x4*)(nb + bj * HALF) = acc[ai][bj][m][0]; *(f32x4*)(nb + bj * HALF + 4) = acc[ai][bj][m][1]; } }
                        asm volatile("" ::: "memory"); }
            }
        } else if (pn < 40) {
            const bool gp = pn < 16; bf16_t* O = (bf16_t*)(ws + (gp ? WS_SG : WS_SZ)); const int ldo = gp ? 2048 : 6144, c0 = (gp ? pn - 8 : pn - 16) * BM + cl;
#pragma unroll
            for (int ai = 0; ai < 2; ++ai)
#pragma unroll
                for (int m = 0; m < 4; ++m) { const int row = row0 + ai * HALF + m * 16;
#pragma unroll
                    for (int bj = 0; bj < 2; ++bj) { f32x4 v0 = acc[ai][bj][m][0], v1 = acc[ai][bj][m][1];
#pragma unroll
                        for (int j = 0; j < 4; ++j) { v0[j] = pg8::silu_f(v0[j]); v1[j] = pg8::silu_f(v1[j]); }
                        u32x4 w; w.x = pg8::cvt_pk_bf16(v0[0], v0[1]); w.y = pg8::cvt_pk_bf16(v0[2], v0[3]); w.z = pg8::cvt_pk_bf16(v1[0], v1[1]); w.w = pg8::cvt_pk_bf16(v1[2], v1[3]);
                        *(u32x4*)(O + (size_t)row * ldo + c0 + bj * HALF) = w; }
                    asm volatile("" ::: "memory"); }
        } else {
            if (cl < 96) {
#pragma unroll
                for (int n = 0; n < 2; ++n)
#pragma unroll
                    for (int j = 0; j < 4; ++j) { const int c = cl + 4 * n + j; const float bias = dtb[c];
#pragma unroll
                        for (int ai = 0; ai < 2; ++ai)
#pragma unroll
                            for (int m = 0; m < 4; ++m) { const float x = acc[ai][0][m][n][j] + bias;
                                ((float*)(ws + WS_DTV))[(size_t)c * 8704 + row0 + ai * HALF + m * 16] = fmaxf(x, 0.f) + log1pf(expf(-fabsf(x))); } }
            }
        }
    }
};

#define GAS __attribute__((address_space(1)))
#define LAS __attribute__((address_space(3)))
typedef unsigned short bf16;
typedef unsigned v4u __attribute__((ext_vector_type(4)));
typedef unsigned v2u __attribute__((ext_vector_type(2)));
typedef float f32x4 __attribute__((ext_vector_type(4)));
typedef float f32x2 __attribute__((ext_vector_type(2)));
#define LDS_WAIT() asm volatile("s_waitcnt lgkmcnt(0)" ::: "memory")
#define VM_WAIT() asm volatile("s_waitcnt vmcnt(0)" ::: "memory")
__device__ __forceinline__ unsigned f2bf(float f) { unsigned u = __builtin_bit_cast(unsigned, f); return (u + 0x7fffu + ((u >> 16) & 1u)) >> 16; }
typedef __bf16 hwbf16x2 __attribute__((ext_vector_type(2)));
__device__ __forceinline__ unsigned pk2(float lo, float hi) { return __builtin_bit_cast(unsigned, __builtin_convertvector((f32x2){lo, hi}, hwbf16x2)); }
__device__ __forceinline__ float bf2f(unsigned short b) { return __builtin_bit_cast(float, ((unsigned)b) << 16); }
__device__ __forceinline__ float silu(float x) { return x / (1.0f + __expf(-x)); }
__device__ __forceinline__ int fresh_lane() { int l; asm volatile("v_mbcnt_lo_u32_b32 %0, -1, 0\n\tv_mbcnt_hi_u32_b32 %0, -1, %0" : "=v"(l)); return l; }
__device__ __forceinline__ float wave_sum(float v) {
#pragma unroll
    for (int o = 1; o < 64; o <<= 1) v += __shfl_xor(v, o);
    return v;
}

#define XB_TMO      128
#define XB_XCNT(j)  (256  + 64 * (j))
#define XB_XSUB(j)  (1280 + 64 * (j))
#define XB_XGEN(j)  (2304 + 64 * (j))
#define XB_TOP      3328
#define XB_TOPGEN   3392
#define XCD_BAR_WORDS 3456
#define XB_SPIN_CAP (1u << 18)
__device__ __forceinline__ unsigned xb_ld(unsigned* p)              { return __hip_atomic_load(p, __ATOMIC_RELAXED, __HIP_MEMORY_SCOPE_AGENT); }
__device__ __forceinline__ unsigned xb_add(unsigned* p, unsigned v) { return __hip_atomic_fetch_add(p, v, __ATOMIC_RELAXED, __HIP_MEMORY_SCOPE_AGENT); }
__device__ __forceinline__ unsigned xb_xcc_id() { return (unsigned)__builtin_amdgcn_s_getreg((3 << 11) | 20) & 0xFu; }
#define XB_SPIN(cond, bar) do { unsigned _sp = 0; while (cond) { __builtin_amdgcn_s_sleep(1); \
    if ((++_sp & 255u) == 0u) { if (xb_ld(&(bar)[XB_TMO])) break; if (_sp > XB_SPIN_CAP) { atomicAdd(&(bar)[XB_TMO], 1u); break; } } } } while (0)
struct XcdBarrier { unsigned* bar; unsigned x; volatile LAS unsigned* st; unsigned w0; };
__device__ __forceinline__ XcdBarrier xcd_barrier_post(unsigned* bar, volatile LAS unsigned* st, unsigned w0) {
    XcdBarrier b; b.bar = bar; b.x = xb_xcc_id(); b.st = st; b.w0 = w0;
    if (w0 && fresh_lane() == 0) (void)xb_add(&bar[XB_XCNT(b.x)], 1u);
    return b;
}
__device__ __forceinline__ void xcd_barrier_complete(unsigned* bar, unsigned x, unsigned& nloc, unsigned& nx) {
    const unsigned G = gridDim.x * gridDim.y * gridDim.z;
    unsigned sum, cnt, mine, sp = 0u;
    for (;;) {
        sum = 0u; cnt = 0u; mine = 0u;
#pragma unroll
        for (unsigned j = 0; j < 16; ++j) { const unsigned c = xb_ld(&bar[XB_XCNT(j)]); sum += c; cnt += (c > 0u) ? 1u : 0u; mine = (j == x) ? c : mine; }
        if (sum == G) break;
        __builtin_amdgcn_s_sleep(1);
        if ((++sp & 255u) == 0u) { if (xb_ld(&bar[XB_TMO])) break; if (sp > XB_SPIN_CAP) { atomicAdd(&bar[XB_TMO], 1u); break; } }
    }
    nloc = mine > 0u ? mine : 1u; nx = cnt > 0u ? cnt : 1u;
}
__device__ __forceinline__ void xcd_barrier(const XcdBarrier& b) {
    asm volatile("s_waitcnt vmcnt(0)" ::: "memory");
    __syncthreads();
    if (b.w0 && fresh_lane() == 0) {
        unsigned* bar = b.bar;
        __builtin_amdgcn_s_waitcnt(0);
        unsigned nloc = b.st[0], nx = b.st[1];
        if (nloc == 0u) { xcd_barrier_complete(bar, b.x, nloc, nx); b.st[0] = nloc; b.st[1] = nx; }
        const unsigned old = xb_add(&bar[XB_XSUB(b.x)], 1u);
        const unsigned gen = old / nloc;
        if (old + 1u == (gen + 1u) * nloc) {
            __builtin_amdgcn_fence(__ATOMIC_RELEASE, "agent");
            asm volatile("s_waitcnt vmcnt(0)" ::: "memory");
            const unsigned og = xb_add(&bar[XB_TOP], 1u);
            const unsigned tg = og / nx;
            if (og + 1u == (tg + 1u) * nx) xb_add(&bar[XB_TOPGEN], 1u);
            else XB_SPIN(xb_ld(&bar[XB_TOPGEN]) == tg, bar);
            __builtin_amdgcn_fence(__ATOMIC_ACQUIRE, "agent");
            xb_add(&bar[XB_XGEN(b.x)], 1u);
            asm volatile("s_waitcnt vmcnt(0)" ::: "memory");
        } else {
            XB_SPIN(xb_ld(&bar[XB_XGEN(b.x)]) == gen, bar);
            __builtin_amdgcn_fence(__ATOMIC_ACQUIRE, "agent");
            asm volatile("s_waitcnt vmcnt(0)" ::: "memory");
        }
    }
    __syncthreads();
}

struct Args { const float* in[21]; float* out; unsigned char* ws; int ph_lo, ph_hi; };

struct TItem { const float* W; bf16* WT; const float* ksc; int N, ldt, k0, n0, nvalid; };
__device__ __forceinline__ void p0_titem_load(const TItem& d, float (&v)[64], int lane) {
    const int col = lane < d.nvalid ? lane : d.nvalid - 1;
#pragma unroll
    for (int i = 0; i < 64; ++i) v[i] = d.W[(size_t)(d.k0 + i) * d.N + d.n0 + col];
}
__device__ __forceinline__ void p0_titem_finish(const TItem& d, const float (&v)[64], LAS float* scr, int lane) {
#pragma unroll
    for (int i = 0; i < 64; ++i) scr[i * 65 + lane] = v[i];
    LDS_WAIT(); asm volatile("" ::: "memory");
    const int c = lane & 7;
    f32x4 ka = (f32x4){1.f, 1.f, 1.f, 1.f}, kb4 = ka;
    if (d.ksc && d.k0 >= WPOOL) { ka = *(const f32x4*)(d.ksc + d.k0 + 8 * c - WPOOL); kb4 = *(const f32x4*)(d.ksc + d.k0 + 8 * c - WPOOL + 4); }
#pragma unroll
    for (int j = 0; j < 8; ++j) { const int n = (lane >> 3) + 8 * j; const LAS float* s = scr + (8 * c) * 65 + n;
        v4u o; o.x = pk2(s[0 * 65] * ka.x, s[1 * 65] * ka.y); o.y = pk2(s[2 * 65] * ka.z, s[3 * 65] * ka.w); o.z = pk2(s[4 * 65] * kb4.x, s[5 * 65] * kb4.y); o.w = pk2(s[6 * 65] * kb4.z, s[7 * 65] * kb4.w);
        if (n < d.nvalid) *(GAS v4u*)(d.WT + (size_t)(d.n0 + n) * d.ldt + d.k0 + 8 * c) = o; }
    LDS_WAIT(); asm volatile("" ::: "memory");
}
__device__ __forceinline__ void p0_mod_item(const Args& a, LAS unsigned char* lds, int item, int tid, int lane, int wave) {
    const int l = item >> 7, cb = item & 127, e0 = cb * 96;
    const float* W = a.in[7] + (size_t)l * DM * 3 * DM;
    const float* cp = a.in[5]; const float* cs = a.in[6];
    LAS float* sl = (LAS float*)(lds + wave * 8192);
    f32x4 acc[20];
#pragma unroll
    for (int b = 0; b < 20; ++b) acc[b] = (f32x4){0.f, 0.f, 0.f, 0.f};
    const bool act = lane < 48; const int rs = lane >= 24 ? 1 : 0, c4 = lane - 24 * rs;
    const float* wl = W + (size_t)(wave * 512 + rs) * (3 * DM) + e0 + 4 * (act ? c4 : 0);
    f32x4 nxt[8];
#define MOD_LOAD(t_) do { _Pragma("unroll") for (int j_ = 0; j_ < 8; ++j_) nxt[j_] = act ? *(const f32x4*)(wl + (size_t)(16 * (t_) + 2 * j_) * (3 * DM)) : (f32x4){0.f, 0.f, 0.f, 0.f}; } while (0)
    MOD_LOAD(0);
    for (int ch = 0; ch < 8; ++ch) {
        const int d0 = wave * 512 + ch * 64;
#pragma unroll
        for (int b = 0; b < 20; ++b) { const float c = b < 4 ? cp[b * DM + d0 + lane] : cs[(b - 4) * DM + d0 + lane]; sl[lane * 20 + b] = c / (1.0f + expf(-c)); }
        LDS_WAIT(); asm volatile("" ::: "memory");
        for (int rb = 0; rb < 4; ++rb) {
            f32x4 wv[8];
#pragma unroll
            for (int j = 0; j < 8; ++j) wv[j] = nxt[j];
            const int tn = ch * 4 + rb + 1;
            if (tn < 32) MOD_LOAD(tn);
#pragma unroll
            for (int j = 0; j < 8; ++j) { const LAS f32x4* sp = (const LAS f32x4*)(sl + (16 * rb + 2 * j + rs) * 20);
#pragma unroll
                for (int q = 0; q < 5; ++q) { const f32x4 s4 = sp[q];
#pragma unroll
                    for (int c = 0; c < 4; ++c) acc[q * 4 + c] += wv[j] * s4[c]; } }
        }
        LDS_WAIT(); asm volatile("" ::: "memory");
    }
#undef MOD_LOAD
#pragma unroll
    for (int b = 0; b < 20; ++b)
#pragma unroll
        for (int c = 0; c < 4; ++c) acc[b][c] += __shfl_down(acc[b][c], 24);
    LAS float* red = (LAS float*)(lds + 65536 + wave * 7680);
    if (lane < 24) {
#pragma unroll
        for (int b = 0; b < 20; ++b) *(LAS f32x4*)(red + b * 96 + 4 * lane) = acc[b]; }
    __syncthreads();
    float* modf = (float*)(a.ws + WS_MODF);
    for (int idx = tid; idx < 20 * 96; idx += NWAVES * 64) { float s = 0.f;
#pragma unroll
        for (int w = 0; w < 8; ++w) s += ((LAS float*)(lds + 65536 + w * 7680))[idx];
        const int b = idx / 96, e = idx % 96; modf[(size_t)(l * 20 + b) * (3 * DM) + e0 + e] = s + a.in[8][(size_t)l * 3 * DM + e0 + e]; }
    __syncthreads();
}
__device__ __forceinline__ void p0_prologue(const Args& a, LAS unsigned char* lds, int G, int bid, int tid, int lane, int wave) {
    for (int it = bid; it < 256; it += G) p0_mod_item(a, lds, it, tid, lane, wave);
    VM_WAIT(); __syncthreads();
    if (wave == 0 && lane == 0) { __builtin_amdgcn_fence(__ATOMIC_RELEASE, "agent"); VM_WAIT(); __hip_atomic_fetch_add((unsigned*)(a.ws + WS_CTL) + CW_MOD, 1u, __ATOMIC_RELAXED, __HIP_MEMORY_SCOPE_AGENT); }
    LAS float* scr = (LAS float*)(lds + (wave < 7 ? wave * 16640 : 135168));
    const int gw = bid * NWAVES + wave, NGW = G * NWAVES;
    constexpr int NB_IN = (IN_DIM + 63) / 64, I_IN = 64 * NB_IN, I_OUT = 128 * 64, I_P = 8 * 8;
    constexpr int NITEMS = 2 * I_IN + 2 * I_OUT + 8 * I_P;
#define P0_DECODE(d, it_) do { int r = (it_); \
        if (r < 2 * I_IN) { const int l = r / I_IN; r -= l * I_IN; const int nb = 2 * (r / 128) + (r & 1), kb = 4 * ((r >> 3) & 15) + ((r >> 1) & 3); d = TItem{a.in[9] + (size_t)l * DM * IN_DIM, (bf16*)(a.ws + WS_WIN + l * WIN_L), nullptr, IN_DIM, DM, 64 * kb, 64 * nb, IN_DIM - 64 * nb < 64 ? IN_DIM - 64 * nb : 64}; } \
        else { r -= 2 * I_IN; if (r < 2 * I_OUT) { const int l = r / I_OUT; r -= l * I_OUT; const int nb = 2 * (r / 256) + (r & 1), kb = 4 * ((r >> 3) & 31) + ((r >> 1) & 3); d = TItem{a.in[18] + (size_t)l * DIN * DM, (bf16*)(a.ws + WS_WOUT + l * WOUT_L), a.in[17] + (size_t)l * WSSD, DM, DIN, 64 * kb, 64 * nb, 64}; } \
               else { r -= 2 * I_OUT; const int lg = r / I_P; r -= lg * I_P; d = TItem{a.in[10] + (size_t)lg * 512 * 512, (bf16*)(a.ws + WS_WP) + (size_t)lg * 512 * 512, nullptr, 512, 512, 64 * (r / 8), 64 * (r % 8), 64}; } } } while (0)
    { int it = gw; TItem d{}; float nx[64];
      if (it < NITEMS) { P0_DECODE(d, it); p0_titem_load(d, nx, lane); }
      while (it < NITEMS) {
          float cur[64];
#pragma unroll
          for (int i = 0; i < 64; ++i) cur[i] = nx[i];
          const TItem dc = d; const int itn = it + NGW;
          if (itn < NITEMS) { P0_DECODE(d, itn); p0_titem_load(d, nx, lane); }
          p0_titem_finish(dc, cur, scr, lane);
          it = itn; } }
#undef P0_DECODE
    for (int i = bid * NWAVES * 64 + tid; i < 2 * (NPAD - IN_DIM) * (DM / 8); i += G * NWAVES * 64) { const int l = i / ((NPAD - IN_DIM) * (DM / 8)), r = i % ((NPAD - IN_DIM) * (DM / 8));
        *(GAS v4u*)((bf16*)(a.ws + WS_WIN + l * WIN_L) + (size_t)IN_DIM * DM + (size_t)r * 8) = (v4u){0u, 0u, 0u, 0u}; }
}

__device__ __forceinline__ void row_stats(const f32x4 (&v)[16], float& mean, float& rstd) {
    float s = 0.f;
#pragma unroll
    for (int j = 0; j < 16; ++j) s += (v[j].x + v[j].y) + (v[j].z + v[j].w);
    mean = wave_sum(s) * (1.f / DM); float q = 0.f;
#pragma unroll
    for (int j = 0; j < 16; ++j) { const f32x4 d = v[j] - mean; q += (d.x * d.x + d.y * d.y) + (d.z * d.z + d.w * d.w); }
    rstd = 1.f / sqrtf(wave_sum(q) * (1.f / DM) + LN_EPS);
}
__device__ __forceinline__ int batch_of(int m) { return m < MP ? (m >> 11) : NBP + ((m - MP) >> 5); }
template <typename VP>
__device__ __forceinline__ void mod_row_to_bf16(const f32x4 (&v)[16], VP sh4, VP sc4, bf16* hrow, int lane) {
    float mean, rstd; row_stats(v, mean, rstd);
#pragma unroll
    for (int j = 0; j < 16; ++j) { const f32x4 sh = sh4[lane + 64 * j], sc = sc4[lane + 64 * j];
        const f32x4 o = (v[j] - mean) * rstd * (sc + 1.0f) + sh;
        ((GAS v2u*)hrow)[lane + 64 * j] = (v2u){pk2(o.x, o.y), pk2(o.z, o.w)};
        if ((j & 3) == 3) asm volatile("" ::: "memory"); }
}
__device__ __forceinline__ void lds_fill_vec(LAS unsigned char* lds, int slot, const float* src, int tid) {
#pragma unroll
    for (int i = 0; i < DM / 4 / (NWAVES * 64); ++i) ((LAS f32x4*)(lds + slot * 16384))[tid + i * NWAVES * 64] = ((const f32x4*)src)[tid + i * NWAVES * 64];
}
__device__ __forceinline__ void phase_a(const Args& a, LAS unsigned char* lds, int G, int bid, int lane, int wave) {
    const int gw = bid * NWAVES + wave, NGW = G * NWAVES;
    const float* modf = (const float*)(a.ws + WS_MODF); bf16* H = (bf16*)(a.ws + WS_H);
    if (G == 256) {
        { const float* md = modf + (size_t)(bid >> 6) * 3 * DM; const int tid = wave * 64 + lane;
          lds_fill_vec(lds, 0, md, tid); lds_fill_vec(lds, 1, md + DM, tid); }
        LDS_WAIT(); __syncthreads();
        const LAS f32x4* shl = (const LAS f32x4*)lds; const LAS f32x4* scl = (const LAS f32x4*)(lds + 16384);
        const int nrow = wave < 2 ? 5 : 4;
#define A_ROW(k) ((k) < 4 ? 32 * bid + wave + 8 * (k) : MP + 2 * bid + wave)
#define A_SRC(m) ((m) < MP ? a.in[0] + (size_t)(m) * DM : a.in[1] + (size_t)((m) - MP) * DM)
        f32x4 nx[16];
        { const float* xr = A_SRC(A_ROW(0));
#pragma unroll
          for (int j = 0; j < 16; ++j) nx[j] = ((const f32x4*)xr)[lane + 64 * j]; }
        for (int k = 0; k < 4; ++k) {
            const int m = A_ROW(k);
            f32x4 v[16];
#pragma unroll
            for (int j = 0; j < 16; ++j) v[j] = nx[j];
            if (k + 1 < nrow) { const int mn = A_ROW(k + 1); const float* xr = A_SRC(mn);
#pragma unroll
                for (int j = 0; j < 16; ++j) nx[j] = ((const f32x4*)xr)[lane + 64 * j]; }
            mod_row_to_bf16(v, shl, scl, H + (size_t)m * DM, lane);
        }
        if (wave < 2) { const int m = A_ROW(4); const float* md = modf + (size_t)batch_of(m) * 3 * DM;
            mod_row_to_bf16(nx, (const f32x4*)md, (const f32x4*)(md + DM), H + (size_t)m * DM, lane); }
#undef A_ROW
#undef A_SRC
        return;
    }
    f32x4 nx[16]; int m = gw;
    if (m < M) { const float* xr = m < MP ? a.in[0] + (size_t)m * DM : a.in[1] + (size_t)(m - MP) * DM;
#pragma unroll
        for (int j = 0; j < 16; ++j) nx[j] = ((const f32x4*)xr)[lane + 64 * j]; }
    while (m < M) {
        f32x4 v[16];
#pragma unroll
        for (int j = 0; j < 16; ++j) v[j] = nx[j];
        const int mn = m + NGW;
        if (mn < M) { const float* xr = mn < MP ? a.in[0] + (size_t)mn * DM : a.in[1] + (size_t)(mn - MP) * DM;
#pragma unroll
            for (int j = 0; j < 16; ++j) nx[j] = ((const f32x4*)xr)[lane + 64 * j]; }
        const float* md = modf + (size_t)batch_of(m) * 3 * DM;
        mod_row_to_bf16(v, (const f32x4*)md, (const f32x4*)(md + DM), H + (size_t)m * DM, lane);
        m = mn;
    }
}
template <typename LP, typename VP>
__device__ __forceinline__ void g_process(f32x4 (&v)[16], LP lg4, LP lb4, float* xrow, bool do_h, VP sh4, VP sc4, bf16* hrow, int lane) {
    float mean, rstd; row_stats(v, mean, rstd);
#pragma unroll
    for (int j = 0; j < 16; ++j) { v[j] = (v[j] - mean) * rstd * lg4[lane + 64 * j] + lb4[lane + 64 * j];
        ((GAS f32x4*)xrow)[lane + 64 * j] = v[j];
        if ((j & 3) == 3) asm volatile("" ::: "memory"); }
    if (do_h) mod_row_to_bf16(v, sh4, sc4, hrow, lane);
}
template <bool EVEN>
__device__ __forceinline__ void g_prompt_rows(const Args& a, LAS unsigned char* lds, int l, int G, int bid, int lane, int wave) {
    const int gw = bid * NWAVES + wave, NGW = G * NWAVES;
    const float* modf = (const float*)(a.ws + WS_MODF); bf16* H = (bf16*)(a.ws + WS_H);
    const bf16* R = (const bf16*)(a.ws + WS_R); float* xo = l == 0 ? (float*)(a.ws + WS_X1) : a.out + O_Y;
    const LAS f32x4* lgl = (const LAS f32x4*)lds; const LAS f32x4* lbl = (const LAS f32x4*)(lds + 16384); const LAS f32x4* shl = (const LAS f32x4*)(lds + 32768); const LAS f32x4* scl = (const LAS f32x4*)(lds + 49152);
    v2u nx[16];
    const int nrow = EVEN ? (wave < 2 ? 3 : (wave < 4 ? 5 : 4)) : (MP - gw + NGW - 1) / NGW;
#define G_ROW(k) (EVEN ? 32 * bid + ((k) == 4 ? 24 + (wave - 2) : wave + 8 * (k)) : gw + (k) * NGW)
    int k = 0;
    if (k < nrow) { const int m = G_ROW(0);
#pragma unroll
        for (int j = 0; j < 16; ++j) nx[j] = *(const v2u*)(R + (size_t)m * DM + 4 * (lane + 64 * j)); }
    for (; k < nrow; ++k) {
        const int m = G_ROW(k);
        f32x4 v[16];
#pragma unroll
        for (int j = 0; j < 16; ++j) v[j] = pg8::bf4_to_f32(nx[j].x, nx[j].y);
        if (k + 1 < nrow) { const int mn = G_ROW(k + 1);
#pragma unroll
            for (int j = 0; j < 16; ++j) nx[j] = *(const v2u*)(R + (size_t)mn * DM + 4 * (lane + 64 * j)); }
        if (EVEN) g_process(v, lgl, lbl, xo + (size_t)m * DM, l == 0, shl, scl, H + (size_t)m * DM, lane);
        else { const float* lg = a.in[19] + (size_t)l * DM; const float* lb = a.in[20] + (size_t)l * DM; const float* md = modf + (size_t)(NBT + batch_of(m)) * 3 * DM;
            g_process(v, (const f32x4*)lg, (const f32x4*)lb, xo + (size_t)m * DM, l == 0, (const f32x4*)md, (const f32x4*)(md + DM), H + (size_t)m * DM, lane); } }
#undef G_ROW
}
__device__ __forceinline__ void phase_g(const Args& a, LAS unsigned char* lds, int l, int G, int bid, int lane, int wave) {
    const int gw = bid * NWAVES + wave, NGW = G * NWAVES;
    const float* modf = (const float*)(a.ws + WS_MODF); bf16* H = (bf16*)(a.ws + WS_H);
    const bf16* R = (const bf16*)(a.ws + WS_R); float* xo = l == 0 ? (float*)(a.ws + WS_X1) : a.out + O_Y;
    const float* lg = a.in[19] + (size_t)l * DM; const float* lb = a.in[20] + (size_t)l * DM;
    const bool even = (G == 256);
    const LAS f32x4* lgl = (const LAS f32x4*)lds; const LAS f32x4* lbl = (const LAS f32x4*)(lds + 16384); const LAS f32x4* shl = (const LAS f32x4*)(lds + 32768); const LAS f32x4* scl = (const LAS f32x4*)(lds + 49152);
    if (even) {
        const int tid = wave * 64 + lane;
        lds_fill_vec(lds, 0, lg, tid); lds_fill_vec(lds, 1, lb, tid);
        if (l == 0) { const float* md = modf + (size_t)(NBT + (bid >> 6)) * 3 * DM; lds_fill_vec(lds, 2, md, tid); lds_fill_vec(lds, 3, md + DM, tid); }
        LDS_WAIT(); __syncthreads();
    }
    if (even ? wave < 2 : gw < MS) {
        const int m = even ? MP + 2 * bid + wave : MP + gw; f32x4 v[16];
        const float* xr = (l == 0 ? a.in[1] : (const float*)(a.ws + WS_X1) + (size_t)MP * DM) + (size_t)(m - MP) * DM;
        const float* gr = modf + (size_t)(l * NBT + batch_of(m)) * 3 * DM + 2 * DM; const float* sl = (const float*)(a.ws + WS_SLAB) + (size_t)(m - MP) * DM;
#pragma unroll
        for (int j2 = 0; j2 < 16; j2 += 2) { f32x4 t[2][8], xv[2], gv[2];
#pragma unroll
            for (int jj = 0; jj < 2; ++jj) { xv[jj] = ((const f32x4*)xr)[lane + 64 * (j2 + jj)]; gv[jj] = ((const f32x4*)gr)[lane + 64 * (j2 + jj)];
#pragma unroll
                for (int k2 = 0; k2 < 8; ++k2) t[jj][k2] = ((const f32x4*)(sl + (size_t)k2 * MS * DM))[lane + 64 * (j2 + jj)]; }
#pragma unroll
            for (int jj = 0; jj < 2; ++jj) { const f32x4 o = ((t[jj][0] + t[jj][1]) + (t[jj][2] + t[jj][3])) + ((t[jj][4] + t[jj][5]) + (t[jj][6] + t[jj][7]));
                v[j2 + jj] = xv[jj] * ALPHA + gv[jj] * o; }
            asm volatile("" ::: "memory"); }
        const float* md = modf + (size_t)(NBT + batch_of(m)) * 3 * DM;
        if (even) g_process(v, lgl, lbl, xo + (size_t)m * DM, l == 0, (const f32x4*)md, (const f32x4*)(md + DM), H + (size_t)m * DM, lane);
        else g_process(v, (const f32x4*)lg, (const f32x4*)lb, xo + (size_t)m * DM, l == 0, (const f32x4*)md, (const f32x4*)(md + DM), H + (size_t)m * DM, lane);
    }
    if (even) g_prompt_rows<true>(a, lds, l, G, bid, lane, wave); else g_prompt_rows<false>(a, lds, l, G, bid, lane, wave);
}
__device__ __forceinline__ f32x4 ld_bf4(const bf16* p) { const v2u q = *(const v2u*)p; return (f32x4){bf2f((unsigned short)(q.x & 0xffffu)), bf2f((unsigned short)(q.x >> 16)), bf2f((unsigned short)(q.y & 0xffffu)), bf2f((unsigned short)(q.y >> 16))}; }
__device__ __forceinline__ f32x4 pool_hist(const bf16* pc, const float* st, bool samp, int t) {
    if (t >= 0) return ld_bf4(pc + (size_t)t * WPOOL);
    if (samp) return *(const f32x4*)(st + (size_t)(15 + t) * WPOOL);
    return (f32x4){0.f, 0.f, 0.f, 0.f};
}
__device__ __forceinline__ void c1_elem(const Args& a, int l, int e, v2u& out, bf16*& dst) {
    const int c4 = e % 2560, r = (e / 2560) & 31, ss = e / (2560 * 32);
    const bool samp = ss >= 4; const int b = samp ? ss - 4 : ss, m0 = samp ? MP + b * DSEQ : b * SEQ;
    if (c4 < 512) { const int j0 = 4 * c4, w = 2 << (j0 >> 9);
        const bf16* pc = (const bf16*)(a.ws + WS_UP) + (size_t)m0 * WPOOL + j0; const float* st = a.in[2] + (size_t)(l * NBS + b) * 15 * WPOOL + j0;
        const f32x4 u = ld_bf4(pc + (size_t)r * WPOOL); f32x4 S = u;
        for (int i = 1; i < w; ++i) S += pool_hist(pc, st, samp, r - i);
        const int pos = (samp ? PAST : 0) + r; const float cnt = (float)(pos + 1 < w ? pos + 1 : w);
        const f32x4 p = S / cnt - u;
        out = (v2u){pk2(p.x, p.y), pk2(p.z, p.w)}; dst = (bf16*)(a.ws + WS_POOLED) + (size_t)(m0 + r) * WPOOL + j0;
    } else { const int j0 = 4 * (c4 - 512);
        const float* cw = a.in[12] + (size_t)l * 4 * CONVD + j0; const bf16* pc = (const bf16*)(a.ws + WS_XP) + (size_t)m0 * CONVD + j0; const float* st = a.in[3] + (size_t)(l * NBS + b) * 3 * CONVD + j0;
        f32x4 o = *(const f32x4*)(a.in[13] + (size_t)l * CONVD + j0);
#pragma unroll
        for (int k = 0; k < 4; ++k) { const int t = r - 3 + k;
            const f32x4 x = t >= 0 ? ld_bf4(pc + (size_t)t * CONVD) : (samp ? *(const f32x4*)(st + (size_t)(3 + t) * CONVD) : (f32x4){0.f, 0.f, 0.f, 0.f});
            o += *(const f32x4*)(cw + (size_t)k * CONVD) * x; }
        o.x = silu(o.x); o.y = silu(o.y); o.z = silu(o.z); o.w = silu(o.w);
        out = (v2u){pk2(o.x, o.y), pk2(o.z, o.w)}; dst = (bf16*)(a.ws + WS_XBC) + (size_t)(m0 + r) * CONVD + j0;
    }
}
__device__ __forceinline__ void c_zero_ssq(const Args& a, int G, int bid, int tid) {
    for (int i = bid * NWAVES * 64 + tid; i < M * 16; i += G * NWAVES * 64) ((GAS f32x4*)(a.ws + WS_YG))[i] = (f32x4){0.f, 0.f, 0.f, 0.f};
}
__device__ __forceinline__ void c1_range(const Args& a, int l, int e_lo, int e_hi, int first, int stride) {
    for (int e0 = e_lo + first; e0 < e_hi; e0 += 4 * stride) { v2u res[4]; bf16* dst[4];
#pragma unroll
        for (int u4 = 0; u4 < 4; ++u4) { const int e = e0 + u4 * stride; dst[u4] = nullptr; res[u4] = (v2u){0u, 0u};
            if (e < e_hi) c1_elem(a, l, e, res[u4], dst[u4]); }
#pragma unroll
        for (int u4 = 0; u4 < 4; ++u4) if (dst[u4]) *(GAS v2u*)dst[u4] = res[u4]; }
}
constexpr int C1_PROMPT_ELEMS = 4 * 32 * 2560, C1_ALL_ELEMS = 20 * 32 * 2560, C_ITEMS2 = 252 * 3, C_ITEMS1 = C1_PROMPT_ELEMS / 2048, C_QITEMS = C_ITEMS2 + C_ITEMS1;
__device__ __forceinline__ void c_sample_elems(const Args& a, int l, int G, int bid, int tid) { c1_range(a, l, C1_PROMPT_ELEMS, C1_ALL_ELEMS, bid * NWAVES * 64 + tid, G * NWAVES * 64); }
__device__ __forceinline__ void c_prompt_item(const Args& a, int l, int it, int tid) {
    if (it >= C_ITEMS2) { c1_range(a, l, (it - C_ITEMS2) * 2048, (it - C_ITEMS2 + 1) * 2048, tid, NWAVES * 64); return; }
    {
        const int sq = it / 3, cblk = it % 3, b = sq / 63, t0 = 32 * (1 + sq % 63), m0 = b * SEQ + t0;
        if (cblk == 0) {
            const int j0 = 4 * tid, w = 2 << (j0 >> 9);
            const bf16* p0 = (const bf16*)(a.ws + WS_UP) + (size_t)m0 * WPOOL + j0;
            bf16* po = (bf16*)(a.ws + WS_POOLED) + (size_t)m0 * WPOOL + j0;
            f32x4 S = (f32x4){0.f, 0.f, 0.f, 0.f};
            for (int i = 1; i < w; ++i) S += ld_bf4(p0 - (size_t)i * WPOOL);
            const float inv = 1.0f / (float)w;
            f32x4 nu[8], no[8];
#pragma unroll
            for (int k = 0; k < 8; ++k) { nu[k] = ld_bf4(p0 + (size_t)k * WPOOL); no[k] = ld_bf4(p0 + (ptrdiff_t)(k - w + 1) * WPOOL); }
#pragma unroll
            for (int r0 = 0; r0 < 32; r0 += 8) { f32x4 u[8], o[8];
#pragma unroll
                for (int k = 0; k < 8; ++k) { u[k] = nu[k]; o[k] = no[k]; }
                if (r0 + 8 < 32) {
#pragma unroll
                    for (int k = 0; k < 8; ++k) { nu[k] = ld_bf4(p0 + (size_t)(r0 + 8 + k) * WPOOL); no[k] = ld_bf4(p0 + (ptrdiff_t)(r0 + 8 + k - w + 1) * WPOOL); } }
#pragma unroll
                for (int k = 0; k < 8; ++k) { S += u[k]; const f32x4 p = S * inv - u[k];
                    *(GAS v2u*)(po + (size_t)(r0 + k) * WPOOL) = (v2u){pk2(p.x, p.y), pk2(p.z, p.w)}; S -= o[k]; } }
        } else {
            const int j0 = (cblk - 1) * 4096 + 8 * tid;
            const float* cw = a.in[12] + (size_t)l * 4 * CONVD + j0; const float* cb = a.in[13] + (size_t)l * CONVD + j0;
            f32x4 wt[4][2], bs[2];
#pragma unroll
            for (int hh = 0; hh < 2; ++hh) { bs[hh] = *(const f32x4*)(cb + 4 * hh);
#pragma unroll
                for (int k = 0; k < 4; ++k) wt[k][hh] = *(const f32x4*)(cw + (size_t)k * CONVD + 4 * hh); }
            const bf16* pc = (const bf16*)(a.ws + WS_XP) + (size_t)m0 * CONVD + j0;
            bf16* xo = (bf16*)(a.ws + WS_XBC) + (size_t)m0 * CONVD + j0;
            v4u h3 = *(const v4u*)(pc - 3 * (size_t)CONVD), h2 = *(const v4u*)(pc - 2 * (size_t)CONVD), h1 = *(const v4u*)(pc - (size_t)CONVD);
            f32x4 p3[2] = {pg8::bf4_to_f32(h3.x, h3.y), pg8::bf4_to_f32(h3.z, h3.w)}, p2[2] = {pg8::bf4_to_f32(h2.x, h2.y), pg8::bf4_to_f32(h2.z, h2.w)}, p1[2] = {pg8::bf4_to_f32(h1.x, h1.y), pg8::bf4_to_f32(h1.z, h1.w)};
            v4u nc[4];
#pragma unroll
            for (int k = 0; k < 4; ++k) nc[k] = *(const v4u*)(pc + (size_t)k * CONVD);
#pragma unroll
            for (int r0 = 0; r0 < 32; r0 += 4) { v4u cq[4];
#pragma unroll
                for (int k = 0; k < 4; ++k) cq[k] = nc[k];
                if (r0 + 4 < 32) {
#pragma unroll
                    for (int k = 0; k < 4; ++k) nc[k] = *(const v4u*)(pc + (size_t)(r0 + 4 + k) * CONVD); }
#pragma unroll
                for (int k = 0; k < 4; ++k) { const f32x4 cur[2] = {pg8::bf4_to_f32(cq[k].x, cq[k].y), pg8::bf4_to_f32(cq[k].z, cq[k].w)}; unsigned ow[4];
#pragma unroll
                    for (int hh = 0; hh < 2; ++hh) { f32x4 o = wt[0][hh] * p3[hh] + wt[1][hh] * p2[hh] + wt[2][hh] * p1[hh] + wt[3][hh] * cur[hh] + bs[hh];
                        o.x = silu(o.x); o.y = silu(o.y); o.z = silu(o.z); o.w = silu(o.w);
                        ow[2 * hh] = pk2(o.x, o.y); ow[2 * hh + 1] = pk2(o.z, o.w);
                        p3[hh] = p2[hh]; p2[hh] = p1[hh]; p1[hh] = cur[hh]; }
                    *(GAS v4u*)(xo + (size_t)(r0 + k) * CONVD) = (v4u){ow[0], ow[1], ow[2], ow[3]}; } }
        }
    }
}
typedef short s16x4 __attribute__((ext_vector_type(4)));
typedef short s16x8 __attribute__((ext_vector_type(8)));
constexpr int SSD_XX = 0, SSD_BS = 32768, SSD_CS = 49152, SSD_HB = 65536, SSD_TAB = 135168;
__device__ __forceinline__ unsigned off_b(unsigned row, unsigned ch) { return 256u * row + 16u * (ch ^ (((row & 3u) << 2) | ((row >> 2) & 3u))); }
__device__ __forceinline__ s16x8 tr_frag(LAS unsigned char* img, int lane, int c, int ks) {
    const unsigned g = (unsigned)lane >> 4, qq = ((unsigned)lane & 15u) >> 2, pp = (unsigned)lane & 3u;
    const unsigned a0 = off_b(32u * ks + 8u * g + qq, 2u * c + (pp >> 1)) + 8u * (pp & 1u), a1 = off_b(32u * ks + 8u * g + 4u + qq, 2u * c + (pp >> 1)) + 8u * (pp & 1u);
    const s16x4 lo = __builtin_amdgcn_ds_read_tr16_b64_v4i16((LAS s16x4*)(img + a0)), hi = __builtin_amdgcn_ds_read_tr16_b64_v4i16((LAS s16x4*)(img + a1));
    return __builtin_shufflevector(lo, hi, 0, 1, 2, 3, 4, 5, 6, 7);
}
__device__ __forceinline__ s16x8 row_frag(LAS unsigned char* img, int row, int ch) { return *(const LAS s16x8*)(img + off_b((unsigned)row, (unsigned)ch)); }
__device__ __forceinline__ float ex2(float x) { return __builtin_amdgcn_exp2f(x); }
template <int CTRL, int RM, int BMK> __device__ __forceinline__ float dpp0(float v) { return __builtin_bit_cast(float, __builtin_amdgcn_update_dpp(0, __builtin_bit_cast(int, v), CTRL, RM, BMK, true)); }
__device__ __forceinline__ float wave_scan(float x) {
    float v = x + dpp0<0x111, 0xf, 0xf>(x); v += dpp0<0x112, 0xf, 0xf>(x); v += dpp0<0x113, 0xf, 0xf>(x);
    v += dpp0<0x114, 0xf, 0xe>(v); v += dpp0<0x118, 0xf, 0xc>(v); v += dpp0<0x142, 0xa, 0xf>(v); v += dpp0<0x143, 0xc, 0xf>(v);
    return v;
}
__device__ __forceinline__ unsigned scale_pk(unsigned v, float w) { return pk2(bf2f((unsigned short)(v & 0xffffu)) * w, bf2f((unsigned short)(v >> 16)) * w); }

__device__ __forceinline__ void ssd_unit(const Args& a, LAS unsigned char* lds, int l, int unit, int tid) {
    const int lane = tid & 63, wave = __builtin_amdgcn_readfirstlane(tid >> 6), r16 = lane & 15, q = lane >> 4;
    const int lt = wave & 3, ph = wave >> 2;
    const bool samp = unit >= NBP * 48; const int u2 = samp ? unit - NBP * 48 : unit; const int b = u2 / 48, hp = u2 % 48, h0 = 2 * hp, g = hp / 6;
    const int nchunk = samp ? 1 : SEQ / 64, vr = samp ? DSEQ : 64, mbase = samp ? MP + b * DSEQ : b * SEQ;
    float A2[2], Dk[2];
#pragma unroll
    for (int hd = 0; hd < 2; ++hd) { A2[hd] = -expf(a.in[15][l * NH + h0 + hd]) * 1.44269504089f; Dk[hd] = a.in[16][l * NH + h0 + hd]; }
    const bf16* xbc = (const bf16*)(a.ws + WS_XBC); const bf16* sz = (const bf16*)(a.ws + WS_SZ); bf16* yg = (bf16*)(a.ws + WS_MIXED) + WPOOL; float* ssq = (float*)(a.ws + WS_YG) + g * 8 + hp % 6;
    const float* dtt = (const float*)(a.ws + WS_DTV) + (size_t)(h0 + (wave & 1)) * M + mbase;
    const int xrow = tid >> 3, xch = tid & 7, brow = tid >> 4, bch = tid & 15;
    const int lrow = 16 * lt + r16;
    v4u xr[2], br[2], cr[2]; v2u zr[2][2]; float dtl = 0.f;
    const v4u zero4 = (v4u){0u, 0u, 0u, 0u};
#define SSD_LOAD(c) do { const size_t m0_ = (size_t)mbase + 64 * (size_t)(c); \
        { const bf16* xp_ = xbc + (m0_ + (xrow < vr ? xrow : 0)) * CONVD + h0 * HD + 8 * xch; xr[0] = *(const v4u*)xp_; xr[1] = *(const v4u*)(xp_ + HD); } \
        _Pragma("unroll") for (int i_ = 0; i_ < 2; ++i_) { const int row_ = brow + 32 * i_; const bf16* rp_ = xbc + (m0_ + (row_ < vr ? row_ : 0)) * CONVD + WSSD + g * NS + 8 * bch; \
            br[i_] = *(const v4u*)rp_; cr[i_] = *(const v4u*)(rp_ + 1024); } \
        _Pragma("unroll") for (int hd_ = 0; hd_ < 2; ++hd_) _Pragma("unroll") for (int j_ = 0; j_ < 2; ++j_) \
            zr[hd_][j_] = *(const v2u*)(sz + (m0_ + (lrow < vr ? lrow : 0)) * WSSD + (h0 + hd_) * HD + 16 * (2 * ph + j_) + 4 * q); \
        if (wave < 2) dtl = dtt[64 * (c) + (lane < vr ? lane : 0)]; } while (0)
#define SSD_SCAN(i_) do { if (wave < 2) { LAS float* tb_ = (LAS float*)(lds + SSD_TAB + (2 * (i_) + wave) * 1024); const float d_ = lane < vr ? dtl : 0.f; \
            const float cs_ = wave_scan(d_ * (wave == 0 ? A2[0] : A2[1])); const float tot_ = __builtin_bit_cast(float, __builtin_amdgcn_readlane(__builtin_bit_cast(int, cs_), 63)); \
            const float c31_ = __builtin_bit_cast(float, __builtin_amdgcn_readlane(__builtin_bit_cast(int, cs_), 31)); \
            tb_[lane] = cs_; tb_[64 + lane] = d_; tb_[128 + lane] = d_ * ex2(tot_ - cs_); tb_[192 + lane] = lane < 32 ? d_ * ex2(c31_ - cs_) : 0.f; } } while (0)
#define SSD_STAGE_WRITE(i_) do { \
        _Pragma("unroll") for (int hd_ = 0; hd_ < 2; ++hd_) { const float w_ = ((const LAS float*)(lds + SSD_TAB + (2 * (i_) + hd_) * 1024))[128 + xrow]; const v4u x_ = xrow < vr ? xr[hd_] : zero4; \
            *(LAS v4u*)(lds + SSD_XX + hd_ * 16384 + off_b(xrow, xch)) = x_; \
            *(LAS v4u*)(lds + SSD_XX + hd_ * 16384 + off_b(xrow, 8 + xch)) = (v4u){scale_pk(x_.x, w_), scale_pk(x_.y, w_), scale_pk(x_.z, w_), scale_pk(x_.w, w_)}; } \
        _Pragma("unroll") for (int i2_ = 0; i2_ < 2; ++i2_) { const bool ok_ = brow + 32 * i2_ < vr; \
            *(LAS v4u*)(lds + SSD_BS + off_b(brow + 32 * i2_, bch)) = ok_ ? br[i2_] : zero4; *(LAS v4u*)(lds + SSD_CS + off_b(brow + 32 * i2_, bch)) = ok_ ? cr[i2_] : zero4; } } while (0)
#define SSD_BAR() do { asm volatile("s_waitcnt lgkmcnt(0)" ::: "memory"); __builtin_amdgcn_s_barrier(); asm volatile("" ::: "memory"); } while (0)
    f32x4 Hacc[2][2][2];
#pragma unroll
    for (int hd = 0; hd < 2; ++hd)
#pragma unroll
        for (int i = 0; i < 2; ++i)
#pragma unroll
            for (int j = 0; j < 2; ++j) Hacc[hd][i][j] = samp ? *(const f32x4*)(a.in[4] + ((size_t)((l * NBS + b) * NH + h0 + hd) * HD + 16 * (2 * ph + j) + r16) * NS + 16 * (2 * lt + i) + 4 * q) : (f32x4){0.f, 0.f, 0.f, 0.f};
#define SSD_HWRITE(i_) do { _Pragma("unroll") for (int hd_ = 0; hd_ < 2; ++hd_) { LAS unsigned char* hb_ = lds + SSD_HB + (2 * (i_) + hd_) * 16384; \
        _Pragma("unroll") for (int i2_ = 0; i2_ < 2; ++i2_) _Pragma("unroll") for (int j2_ = 0; j2_ < 2; ++j2_) { const f32x4 v_ = Hacc[hd_][i2_][j2_]; \
            *(LAS v2u*)(hb_ + off_b(16 * (2 * ph + j2_) + r16, 2 * (2 * lt + i2_) + (q >> 1)) + 8 * (q & 1)) = (v2u){pk2(v_.x, v_.y), pk2(v_.z, v_.w)}; } } } while (0)
    SSD_LOAD(0);
    v2u zc[2][2] = {{zr[0][0], zr[0][1]}, {zr[1][0], zr[1][1]}};
    SSD_SCAN(0); SSD_HWRITE(0);
    SSD_BAR();
    SSD_STAGE_WRITE(0);
    SSD_BAR();
    v2u ypk[2][2] = {{(v2u){0u, 0u}, (v2u){0u, 0u}}, {(v2u){0u, 0u}, (v2u){0u, 0u}}}; float ssk[2] = {0.f, 0.f};
    for (int c = 0; c < nchunk; ++c) {
        const bool more = c + 1 < nchunk;
        if (c > 0 && lrow < vr) {
#pragma unroll
            for (int hd = 0; hd < 2; ++hd)
#pragma unroll
                for (int j = 0; j < 2; ++j) *(GAS v2u*)(yg + ((size_t)mbase + 64 * (c - 1) + lrow) * DIN + (h0 + hd) * HD + 16 * (2 * ph + j) + 4 * q) = ypk[hd][j];
            if (q == 0) __hip_atomic_fetch_add(ssq + ((size_t)mbase + 64 * (c - 1) + lrow) * 64, ssk[0] + ssk[1], __ATOMIC_RELAXED, __HIP_MEMORY_SCOPE_AGENT); }
        if (more) SSD_LOAD(c + 1);
        LAS unsigned char* hbc = lds + SSD_HB + 2 * (c & 1) * 16384; const LAS float* tb = (const LAS float*)(lds + SSD_TAB + 2 * (c & 1) * 1024);
#define SB() __builtin_amdgcn_sched_barrier(0)
        s16x8 cf[4]; float acl[2], cdv[2];
#pragma unroll
        for (int kk = 0; kk < 4; ++kk) cf[kk] = row_frag(lds + SSD_CS, lrow, 4 * kk + q);
        f32x4 acc[2][2] = {{(f32x4){0.f, 0.f, 0.f, 0.f}, (f32x4){0.f, 0.f, 0.f, 0.f}}, {(f32x4){0.f, 0.f, 0.f, 0.f}, (f32x4){0.f, 0.f, 0.f, 0.f}}};
#pragma unroll
        for (int hd = 0; hd < 2; ++hd) { s16x8 hf[2][4];
            SB();
            acl[hd] = tb[hd * 256 + lrow]; cdv[hd] = tb[hd * 256 + 63];
#pragma unroll
            for (int j = 0; j < 2; ++j)
#pragma unroll
                for (int kk = 0; kk < 4; ++kk) hf[j][kk] = row_frag(hbc + hd * 16384, 16 * (2 * ph + j) + r16, 4 * kk + q);
            SB();
#pragma unroll
            for (int kk = 0; kk < 4; ++kk)
#pragma unroll
                for (int j = 0; j < 2; ++j) acc[hd][j] = __builtin_amdgcn_mfma_f32_16x16x32_bf16(hf[j][kk], cf[kk], acc[hd][j], 0, 0, 0);
            const float el = ex2(acl[hd]); acc[hd][0] = acc[hd][0] * el; acc[hd][1] = acc[hd][1] * el; }
#pragma unroll
        for (int k2 = 0; k2 < 2; ++k2) if (k2 <= (lt >> 1)) {
            const int sx = 32 * k2 + 8 * (r16 >> 2) + (r16 & 3), s0 = 32 * k2 + 8 * q;
            s16x8 bx[4], by[4], xf[2][2];
            SB();
#pragma unroll
            for (int kk = 0; kk < 4; ++kk) { bx[kk] = row_frag(lds + SSD_BS, sx, 4 * kk + q); by[kk] = row_frag(lds + SSD_BS, sx + 4, 4 * kk + q); }
            SB();
            f32x4 gx = (f32x4){0.f, 0.f, 0.f, 0.f}, gy = gx;
#pragma unroll
            for (int kk = 0; kk < 4; ++kk) { gx = __builtin_amdgcn_mfma_f32_16x16x32_bf16(bx[kk], cf[kk], gx, 0, 0, 0); gy = __builtin_amdgcn_mfma_f32_16x16x32_bf16(by[kk], cf[kk], gy, 0, 0, 0); }
#pragma unroll
            for (int hd = 0; hd < 2; ++hd)
#pragma unroll
                for (int j = 0; j < 2; ++j) xf[hd][j] = tr_frag(lds + SSD_XX + hd * 16384, lane, 2 * ph + j, k2);
#pragma unroll
            for (int hd = 0; hd < 2; ++hd) { f32x4 mx, my;
                if (k2 != (lt >> 1)) {
                    const float rowf = ex2(acl[hd] - tb[hd * 256 + 31]);
                    const f32x4 c0 = *(const LAS f32x4*)(tb + hd * 256 + 192 + s0), c1 = *(const LAS f32x4*)(tb + hd * 256 + 192 + s0 + 4);
                    mx = gx * (c0 * rowf); my = gy * (c1 * rowf);
                } else {
                const f32x4 as0 = *(const LAS f32x4*)(tb + hd * 256 + s0), as1 = *(const LAS f32x4*)(tb + hd * 256 + s0 + 4), d0 = *(const LAS f32x4*)(tb + hd * 256 + 64 + s0), d1 = *(const LAS f32x4*)(tb + hd * 256 + 64 + s0 + 4);
#pragma unroll
                for (int e = 0; e < 4; ++e) { mx[e] = (s0 + e <= lrow) ? gx[e] * ex2(acl[hd] - as0[e]) * d0[e] : 0.f; my[e] = (s0 + 4 + e <= lrow) ? gy[e] * ex2(acl[hd] - as1[e]) * d1[e] : 0.f; }
                }
                const s16x8 gms = __builtin_bit_cast(s16x8, (v4u){pk2(mx[0], mx[1]), pk2(mx[2], mx[3]), pk2(my[0], my[1]), pk2(my[2], my[3])});
#pragma unroll
                for (int j = 0; j < 2; ++j) acc[hd][j] = __builtin_amdgcn_mfma_f32_16x16x32_bf16(xf[hd][j], gms, acc[hd][j], 0, 0, 0); }
        }
        v2u xwv[2][2]; s16x8 bt[2], xs[2][2];
        SB();
#pragma unroll
        for (int hd = 0; hd < 2; ++hd)
#pragma unroll
            for (int j = 0; j < 2; ++j) { const int p0 = 16 * (2 * ph + j) + 4 * q; xwv[hd][j] = *(const LAS v2u*)(lds + SSD_XX + hd * 16384 + off_b(lrow, p0 >> 3) + 2 * (p0 & 7)); xs[hd][j] = tr_frag(lds + SSD_XX + hd * 16384, lane, 4 + 2 * ph + j, 0); }
#pragma unroll
        for (int i = 0; i < 2; ++i) bt[i] = tr_frag(lds + SSD_BS, lane, 2 * lt + i, 0);
        SB();
#pragma unroll
        for (int hd = 0; hd < 2; ++hd) { float ss = 0.f;
#pragma unroll
            for (int j = 0; j < 2; ++j) { const v2u xw = xwv[hd][j];
                f32x4 y = acc[hd][j] + Dk[hd] * (f32x4){bf2f((unsigned short)(xw.x & 0xffffu)), bf2f((unsigned short)(xw.x >> 16)), bf2f((unsigned short)(xw.y & 0xffffu)), bf2f((unsigned short)(xw.y >> 16))};
                y = y * (f32x4){bf2f((unsigned short)(zc[hd][j].x & 0xffffu)), bf2f((unsigned short)(zc[hd][j].x >> 16)), bf2f((unsigned short)(zc[hd][j].y & 0xffffu)), bf2f((unsigned short)(zc[hd][j].y >> 16))};
                ss += (y.x * y.x + y.y * y.y) + (y.z * y.z + y.w * y.w);
                ypk[hd][j] = (v2u){pk2(y.x, y.y), pk2(y.z, y.w)}; }
            ss += __shfl_xor(ss, 16); ss += __shfl_xor(ss, 32); ssk[hd] = ss; }
#pragma unroll
        for (int hd = 0; hd < 2; ++hd) { const float cd = ex2(cdv[hd]);
#pragma unroll
            for (int i = 0; i < 2; ++i)
#pragma unroll
                for (int j = 0; j < 2; ++j) Hacc[hd][i][j] = Hacc[hd][i][j] * cd; }
#pragma unroll
        for (int hd = 0; hd < 2; ++hd)
#pragma unroll
            for (int i = 0; i < 2; ++i)
#pragma unroll
                for (int j = 0; j < 2; ++j) Hacc[hd][i][j] = __builtin_amdgcn_mfma_f32_16x16x32_bf16(bt[i], xs[hd][j], Hacc[hd][i][j], 0, 0, 0);
        SB();
#pragma unroll
        for (int i = 0; i < 2; ++i) bt[i] = tr_frag(lds + SSD_BS, lane, 2 * lt + i, 1);
#pragma unroll
        for (int hd = 0; hd < 2; ++hd)
#pragma unroll
            for (int j = 0; j < 2; ++j) xs[hd][j] = tr_frag(lds + SSD_XX + hd * 16384, lane, 4 + 2 * ph + j, 1);
        SB();
#pragma unroll
        for (int hd = 0; hd < 2; ++hd)
#pragma unroll
            for (int i = 0; i < 2; ++i)
#pragma unroll
                for (int j = 0; j < 2; ++j) Hacc[hd][i][j] = __builtin_amdgcn_mfma_f32_16x16x32_bf16(bt[i], xs[hd][j], Hacc[hd][i][j], 0, 0, 0);
#undef SB
        if (more) { SSD_HWRITE((c + 1) & 1); SSD_SCAN((c + 1) & 1); }
        SSD_BAR();
        if (more) { SSD_STAGE_WRITE((c + 1) & 1);
#pragma unroll
            for (int hd = 0; hd < 2; ++hd) { zc[hd][0] = zr[hd][0]; zc[hd][1] = zr[hd][1]; }
            SSD_BAR(); }
    }
    if (lrow < vr) {
#pragma unroll
        for (int hd = 0; hd < 2; ++hd)
#pragma unroll
            for (int j = 0; j < 2; ++j) *(GAS v2u*)(yg + ((size_t)mbase + 64 * (nchunk - 1) + lrow) * DIN + (h0 + hd) * HD + 16 * (2 * ph + j) + 4 * q) = ypk[hd][j];
        if (q == 0) __hip_atomic_fetch_add(ssq + ((size_t)mbase + 64 * (nchunk - 1) + lrow) * 64, ssk[0] + ssk[1], __ATOMIC_RELAXED, __HIP_MEMORY_SCOPE_AGENT); }
#pragma unroll
    for (int hd = 0; hd < 2; ++hd) { float* so = a.out + (samp ? O_SS : O_SP) + (size_t)((l * (samp ? NBS : NBP) + b) * NH + h0 + hd) * HD * NS;
#pragma unroll
        for (int i = 0; i < 2; ++i)
#pragma unroll
            for (int j = 0; j < 2; ++j) *(GAS f32x4*)(so + (size_t)(16 * (2 * ph + j) + r16) * NS + 16 * (2 * lt + i) + 4 * q) = Hacc[hd][i][j]; }
#undef SSD_LOAD
#undef SSD_SCAN
#undef SSD_STAGE_WRITE
#undef SSD_HWRITE
#undef SSD_BAR
}
__device__ __forceinline__ void ktab_build(const float* ssq, LAS float* tab, int row0, int sbase, int gfirst, int tid) {
    const int r = tid >> 1, g0 = 4 * (tid & 1);
    const float* p = ssq + (size_t)(row0 + r) * 64;
    float sprev = 1.f;
#pragma unroll
    for (int gg = -1; gg < 4; ++gg) { const int g = g0 + gg; if (g < 0) continue;
        const f32x4* q4 = (const f32x4*)(p + 8 * g); const f32x4 t = q4[0] + q4[1];
        const float sg = 1.f / sqrtf(((t.x + t.y) + (t.z + t.w)) * (1.f / 768.f) + RMS_EPS);
        if (gg >= 0) { tab[g * 256 + r] = sprev / sg; if (g >= gfirst) tab[(sbase + g - gfirst) * 256 + r] = sg; }
        sprev = sg; }
}

constexpr int CW_SAMP = 8192;
__device__ __forceinline__ void sample_norm(const Args& a, int l, int G, int bid, int lane, int wave) {
    const float* ssq = (const float*)(a.ws + WS_YG); bf16* mx = (bf16*)(a.ws + WS_MIXED);
    for (int rr = bid; rr < MS / 2; rr += G) {
        const int m = MP + 2 * rr + (wave >> 2);
#pragma unroll
        for (int gg = 0; gg < 2; ++gg) { const int g = 2 * (wave & 3) + gg;
            const float part = lane < 8 ? ssq[(size_t)m * 64 + 8 * g + lane] : 0.f;
            const float rstd = 1.f / sqrtf(wave_sum(part) * (1.f / 768.f) + RMS_EPS);
            unsigned long long* p = (unsigned long long*)(mx + (size_t)m * DIN + WPOOL + g * 768) + lane;
#pragma unroll
            for (int j = 0; j < 3; ++j) { const unsigned long long q = p[64 * j]; const f32x4 v = pg8::bf4_to_f32((unsigned)q, (unsigned)(q >> 32)) * rstd;
                __hip_atomic_store(p + 64 * j, (unsigned long long)pk2(v.x, v.y) | ((unsigned long long)pk2(v.z, v.w) << 32), __ATOMIC_RELAXED, __HIP_MEMORY_SCOPE_AGENT); } }
    }
    VM_WAIT(); __syncthreads();
    if (wave == 0 && lane == 0) __hip_atomic_fetch_add((unsigned*)(a.ws + WS_CTL) + CW_SAMP, 1u, __ATOMIC_RELAXED, __HIP_MEMORY_SCOPE_AGENT);
}
__device__ __forceinline__ void sample_wait(const Args& a, unsigned target, int lane, int wave) {
    if (wave == 0) { unsigned* cnt = (unsigned*)(a.ws + WS_CTL) + CW_SAMP; unsigned sp = 0;
        while ((unsigned)__builtin_amdgcn_readfirstlane(__hip_atomic_load(cnt, __ATOMIC_RELAXED, __HIP_MEMORY_SCOPE_AGENT)) < target) { __builtin_amdgcn_s_sleep(2); if (++sp > (1u << 22)) break; }
        __builtin_amdgcn_fence(__ATOMIC_ACQUIRE, "agent"); VM_WAIT(); }
    __syncthreads();
}

constexpr int CW_PDONE = 8448, CW_ADONE = 8576, CW_CQ = 8704;
constexpr int PROJ_UNITS1 = (MP / 256) * 72, PROJ_UNITS2 = (MP / 256) + 2 * 73;
constexpr int CW_PQ = 8832, POOL_TILES = (M / 256) * 2 * 4;
struct OneTile {
    int t;
    __device__ bool next(int i, pg8::Unit& u) const { if (i != 0) return false; const int per = (M / 256) * 2, r = t % per; u.g = t / per; u.pm = r % (M / 256); u.pn = r / (M / 256); return true; }
    __device__ __forceinline__ void a_ready(const pg8::Unit&) const {}
    __device__ __forceinline__ void done(const pg8::Unit&) const {}
};
struct ProjOrder {
    pg8::StaticOrder so; int G, c, ilast; volatile LAS unsigned* lcnt; unsigned* pdone; unsigned ltarget;
    __device__ void init(int G_, int c_, volatile LAS unsigned* lcnt_, unsigned* pdone_, unsigned ltarget_) { so.init(MP, 72 * 256, G_, c_); G = G_; c = c_; ilast = (PROJ_UNITS1 - 1 - c_) / G_; lcnt = lcnt_; pdone = pdone_; ltarget = ltarget_; }
    __device__ bool next(int i, pg8::Unit& u) const {
        const long L = (long)i * G + c;
        if (L < PROJ_UNITS1) return so.next(i, u);
        const int t = (int)(L - PROJ_UNITS1); if (t >= PROJ_UNITS2) return false;
        if (t < MP / 256) { u.pm = t; u.pn = 72; } else { const int r = t - MP / 256; u.pm = MP / 256 + (r & 1); u.pn = r >> 1; }
        u.g = 0; return true;
    }
    __device__ __forceinline__ void a_ready(const pg8::Unit&) const {}
    __device__ __forceinline__ void done(const pg8::Unit& u) const {
        if (u.ui == ilast) {
            asm volatile("s_waitcnt vmcnt(0)" ::: "memory");
            if (fresh_lane() == 0) {
                const unsigned old = __hip_atomic_fetch_add((LAS unsigned*)lcnt, 1u, __ATOMIC_RELAXED, __HIP_MEMORY_SCOPE_WORKGROUP);
                if (old + 1u == ltarget) {
                    __builtin_amdgcn_fence(__ATOMIC_RELEASE, "agent"); asm volatile("s_waitcnt vmcnt(0)" ::: "memory");
                    __hip_atomic_fetch_add(pdone, 1u, __ATOMIC_RELAXED, __HIP_MEMORY_SCOPE_AGENT); } } }
    }
};
__device__ __forceinline__ void wait_count(unsigned* cnt, unsigned target, int wave) {
    if (wave == 0) { unsigned sp = 0;
        while ((unsigned)__builtin_amdgcn_readfirstlane(__hip_atomic_load(cnt, __ATOMIC_RELAXED, __HIP_MEMORY_SCOPE_AGENT)) < target) { __builtin_amdgcn_s_sleep(2); if (++sp > (1u << 22)) break; }
        __builtin_amdgcn_fence(__ATOMIC_ACQUIRE, "agent"); VM_WAIT(); }
    __syncthreads();
}

__global__ void __launch_bounds__(NWAVES * 64, 2) trunk_fwd(Args args) {
    extern __shared__ __attribute__((aligned(16))) unsigned char lds_raw[];
    LAS unsigned char* lds = (LAS unsigned char*)lds_raw;
    volatile LAS unsigned* MISC = (volatile LAS unsigned*)(lds + MISC_OFF);
    const int wave = __builtin_amdgcn_readfirstlane((int)threadIdx.x >> 6);
    const int tid = wave * 64 + fresh_lane();
    const int G = gridDim.x, bid = blockIdx.x;
    unsigned* ctl = (unsigned*)(args.ws + WS_CTL);
    for (int u = tid; u < (LDS_BYTES - LDSCTL_OFF) / 4; u += NWAVES * 64) ((LAS unsigned*)(lds + LDSCTL_OFF))[u] = 0u;
    __syncthreads();
    const int lo = args.ph_lo, hi = args.ph_hi;
    XcdBarrier bar; bar.bar = ctl + CW_BAR; bar.x = 0; bar.st = MISC + 8; bar.w0 = (wave == 0);
    if (hi - lo > 1) bar = xcd_barrier_post(ctl + CW_BAR, MISC + 8, wave == 0);
#ifndef PROBE_MASK
#define PROBE_MASK 0
#endif
#define REP(kind) for (int _r = 0; _r < (((PROBE_MASK) >> (kind)) & 1 ? 2 : 1); ++_r)
#define IN(k) (lo <= (k) && (k) < hi)
#define BOTH(k) (IN(k) && IN((k) + 1))
#define SEAM(k) do { if (BOTH(k)) xcd_barrier(bar); } while (0)
#ifndef PROBE_SEL
#define PROBE_SEL 0
#endif
#ifndef PROBE_MULT
#define PROBE_MULT 4
#endif
#if PROBE_SEL > 0
    volatile LAS unsigned long long* tsw = (volatile LAS unsigned long long*)(lds + MISC_OFF + 64);
    if (bid == 0 && wave == 0 && fresh_lane() == 0) { tsw[0] = __builtin_amdgcn_s_memrealtime(); tsw[1] = 0ull; }
#define STAMP(kind) do { if (bid == 0 && wave == 0 && fresh_lane() == 0) { const unsigned long long t_ = __builtin_amdgcn_s_memrealtime(); if ((PROBE_SEL >> (kind)) & 1) tsw[1] = tsw[1] + (t_ - tsw[0]); tsw[0] = t_; } } while (0)
#else
#define STAMP(kind) do { } while (0)
#endif

    if (IN(0)) { const int l0 = fresh_lane(); p0_prologue(args, lds, G, bid, wave * 64 + l0, l0, wave); STAMP(0);
                 wait_count(ctl + CW_MOD, (unsigned)G, wave);
                 phase_a(args, lds, G, bid, fresh_lane(), wave); SEAM(0); STAMP(1); }
    for (int l = 0; l < 2; ++l) {
        const int pb = 1 + 4 * l;
#define TL (wave * 64 + fresh_lane())
        if (IN(pb)) {
            pg8::Gemm g{(const pg8::bf16_t*)(args.ws + WS_H), (const pg8::bf16_t*)(args.ws + WS_WIN + (size_t)l * WIN_L), M, NPAD, DM, DM, DM, 0, 0};
            ProjOrder S; S.init(G, bid, MISC + 25, ctl + CW_PDONE + 64 * l, 8u * (unsigned)(l + 1));
            EpiProj E{args.ws, args.out, args.in[14] + (size_t)l * NH, l};
            pg8::gemm_phase<EpiProj, ProjOrder, true, true>(lds, g, S, E, TL);
            if (wave == 0 && fresh_lane() == 0) { __builtin_amdgcn_fence(__ATOMIC_RELEASE, "agent"); asm volatile("s_waitcnt vmcnt(0)" ::: "memory");
                __hip_atomic_fetch_add(ctl + CW_ADONE + 64 * l, 1u, __ATOMIC_RELAXED, __HIP_MEMORY_SCOPE_AGENT); }
            c_zero_ssq(args, G, bid, TL);
            wait_count(ctl + CW_PDONE + 64 * l, (unsigned)G, wave);
            for (;;) {
                if (wave == 0 && fresh_lane() == 0) MISC[24] = __hip_atomic_fetch_add(ctl + CW_CQ + 64 * l, 1u, __ATOMIC_RELAXED, __HIP_MEMORY_SCOPE_AGENT);
                __syncthreads();
                const int it = __builtin_amdgcn_readfirstlane((int)MISC[24]);
                __syncthreads();
                if (it >= C_QITEMS) break;
                c_prompt_item(args, l, it, TL); }
            wait_count(ctl + CW_ADONE + 64 * l, (unsigned)G, wave);
            c_sample_elems(args, l, G, bid, TL);
            SEAM(pb); STAMP(2);
        }
        if (IN(pb + 1)) {
            REP(5) for (int k = 0; ; ++k) {
                int u;
                if (G == 256) { if (k >= (bid < 192 ? 1 : 12)) break;
                    const int xg = (bid & 7) * 4 + (bid >> 3) / 6;
                    u = bid < 192 ? (xg >> 3) * 48 + (xg & 7) * 6 + (bid >> 3) % 6 : NBP * 48 + (bid - 192) * 12 + k; }
                else { u = bid + k * G; if (u >= (NBP + NBS) * 48) break; }
                ssd_unit(args, lds, l, u, TL); }
            __syncthreads();
            { pg8::Gemm g{(const pg8::bf16_t*)(args.ws + WS_POOLED), (const pg8::bf16_t*)(args.ws + WS_WP) + (size_t)l * 4 * 512 * 512, M, 512, 512, WPOOL, 512, 512, (size_t)512 * 512};
              pg8::EpiPool E{(pg8::bf16_t*)(args.ws + WS_MIXED), DIN, (const pg8::bf16_t*)(args.ws + WS_SG), WPOOL, args.in[11] + (size_t)l * WPOOL};
              for (;;) {
                  if (wave == 0 && fresh_lane() == 0) MISC[24] = __hip_atomic_fetch_add(ctl + CW_PQ + 64 * l, 1u, __ATOMIC_RELAXED, __HIP_MEMORY_SCOPE_AGENT);
                  __syncthreads();
                  const int tq = (int)MISC[24];
                  __syncthreads();
                  if (tq >= POOL_TILES) break;
                  OneTile S{tq};
                  pg8::gemm_phase<pg8::EpiPool, OneTile, true, true>(lds, g, S, E, TL);
                  __syncthreads(); } }
            SEAM(pb + 1); STAMP(4);
        }
        if (IN(pb + 2)) {   sample_norm(args, l, G, bid, fresh_lane(), wave);
            { pg8::Gemm g{(const pg8::bf16_t*)(args.ws + WS_MIXED), (const pg8::bf16_t*)(args.ws + WS_WOUT + (size_t)l * WOUT_L), MP, DM, DIN, DIN, DIN, 0, 0};
              pg8::StaticOrder S; S.init(MP, DM, G, bid);
              pg8::EpiResid E{(pg8::bf16_t*)(args.ws + WS_R), DM, l == 0 ? args.in[0] : (const float*)(args.ws + WS_X1), (const float*)(args.ws + WS_MODF) + (size_t)l * NBT * 3 * DM + 2 * DM, 3 * DM, ALPHA, lds};
              { const int tt = TL; pg8::Unit u0;
                for (int ui = 0; ui < 2; ++ui) if (S.next(ui, u0)) ktab_build((const float*)(args.ws + WS_YG), (LAS float*)(lds + pg8::KTAB_OFF) + ui * 9 * 256, u0.pm * 256, 8, 7, tt);
                __syncthreads(); }
              pg8::gemm_phase<pg8::EpiResid, pg8::StaticOrder, true, true>(lds, g, S, E, TL);
#if (PROBE_MASK >> 7) & 1
              __syncthreads(); pg8::gemm_phase<pg8::EpiResid, pg8::StaticOrder, true, true>(lds, g, S, E, TL);
#endif
            }
            __syncthreads();
            { pg8::Gemm g{(const pg8::bf16_t*)(args.ws + WS_MIXED) + (size_t)MP * DIN, (const pg8::bf16_t*)(args.ws + WS_WOUT + (size_t)l * WOUT_L), MS, DM, DIN / 8, DIN, DIN, (size_t)(DIN / 8), (size_t)(DIN / 8)};
              pg8::GroupOrder S; S.init(MS, DM, 8, G, bid);
              pg8::EpiSlab E{(float*)(args.ws + WS_SLAB), DM, (size_t)MS * DM};
              sample_wait(args, (unsigned)G * (unsigned)(l + 1), fresh_lane(), wave);
              pg8::gemm_phase<pg8::EpiSlab, pg8::GroupOrder, true, true>(lds, g, S, E, TL); }
            SEAM(pb + 2); STAMP(6);
        }
        if (IN(pb + 3)) { REP(8) phase_g(args, lds, l, G, bid, fresh_lane(), wave); if (pb + 3 < NPHASE - 1) SEAM(pb + 3); STAMP(7); }
    }
#if PROBE_SEL > 0
    if (bid == 0 && wave == 0 && fresh_lane() == 0) { const unsigned long long t_end = __builtin_amdgcn_s_memrealtime() + (unsigned long long)PROBE_MULT * tsw[1]; while (__builtin_amdgcn_s_memrealtime() < t_end) __builtin_amdgcn_s_sleep(8); }
#endif
#undef IN
#undef BOTH
#undef SEAM
}

#ifndef MK_SPLIT
#define MK_SPLIT 0
#endif
extern "C" void kernel_launch(void* const* d_in, const int* in_sizes, int n_in, void* d_out, int out_size, void* d_ws, size_t ws_size, hipStream_t stream) {
    static int grid = 0;
    if (grid == 0) {
        if (n_in != 21 || (size_t)out_size != O_END || ws_size < WS_END) { fprintf(stderr, "kernel_launch: unexpected shapes: n_in %d out %d ws %zu; nothing launched\n", n_in, out_size, ws_size); grid = -1; return; }
        int dev = 0, cus = 0, per_cu = 0;
        if (hipGetDevice(&dev) != hipSuccess || hipDeviceGetAttribute(&cus, hipDeviceAttributeMultiprocessorCount, dev) != hipSuccess) { grid = -1; return; }
        if (hipFuncSetAttribute((const void*)trunk_fwd, hipFuncAttributeMaxDynamicSharedMemorySize, LDS_BYTES) != hipSuccess) { fprintf(stderr, "kernel_launch: hipFuncSetAttribute failed\n"); grid = -1; return; }
        if (hipOccupancyMaxActiveBlocksPerMultiprocessor(&per_cu, (const void*)trunk_fwd, NWAVES * 64, LDS_BYTES) != hipSuccess || per_cu < 1) { fprintf(stderr, "kernel_launch: occupancy query says %d blocks per CU\n", per_cu); (void)hipGetLastError(); grid = -1; return; }
        grid = cus;
    }
    if (grid < 0) return;
    if (hipMemsetAsync((char*)d_ws + WS_CTL, 0, CTL_ZERO_BYTES, stream) != hipSuccess) return;
    Args a{};
    for (int i = 0; i < 21; ++i) a.in[i] = (const float*)d_in[i];
    a.out = (float*)d_out; a.ws = (unsigned char*)d_ws;
#if MK_SPLIT
    for (int ph = 0; ph < NPHASE; ++ph) { a.ph_lo = ph; a.ph_hi = ph + 1; hipLaunchKernelGGL(trunk_fwd, dim3(grid), dim3(NWAVES * 64), LDS_BYTES, stream, a); }
#else
    a.ph_lo = 0; a.ph_hi = NPHASE; hipLaunchKernelGGL(trunk_fwd, dim3(grid), dim3(NWAVES * 64), LDS_BYTES, stream, a);
#endif
}
```
